# Optimizing an MI355X kernel written in HIP

```python
import jax, jax.numpy as jnp
from jax import lax
import numpy as np

D_MODEL = 1024
BATCH = 4
SEQ = 4096
DEPTH = 4

SB_HEADS = 8
SB_HEAD_DIM = 64
D_ATTN = SB_HEADS * SB_HEAD_DIM
Q_BLOCK = 128
D_RNN = D_MODEL // 2
RG_BLOCKS = 8
RG_BLOCK_DIM = D_RNN // RG_BLOCKS
CONV_WIDTH = 4
RG_C = 8.0
IN_COLS = 3 * D_ATTN + 2 * D_RNN + 2 * D_MODEL
SPLIT_POINTS = (D_ATTN, 2 * D_ATTN, 3 * D_ATTN, 3 * D_ATTN + D_RNN,
                3 * D_ATTN + 2 * D_RNN, 3 * D_ATTN + 2 * D_RNN + D_MODEL)
N_GROUPS = 4
EXPERTS_PER_GROUP = 4
N_EXPERTS = N_GROUPS * EXPERTS_PER_GROUP
TOP_K_IN_GROUP = 2
D_EXPERT = 512
PLE_DIM = 256
EPS = 1e-6

kernel_name = "hybrid_sb_rglru_hmoe_trunk"


def rms_norm(x, g):
    xf = x.astype(jnp.float32)
    y = xf * lax.rsqrt(jnp.mean(xf * xf, axis=-1, keepdims=True) + EPS)
    return (y * g.astype(jnp.float32)).astype(x.dtype)


def stick_breaking_attention(q, k, v):
    B, S, _ = q.shape
    nb = S // Q_BLOCK
    scale = SB_HEAD_DIM ** -0.5
    q = q.reshape(B, S, SB_HEADS, SB_HEAD_DIM).transpose(0, 2, 1, 3)
    k = k.reshape(B, S, SB_HEADS, SB_HEAD_DIM).transpose(0, 2, 1, 3)
    v = v.reshape(B, S, SB_HEADS, SB_HEAD_DIM).transpose(0, 2, 1, 3)
    q_blocks = q.reshape(B, SB_HEADS, nb, Q_BLOCK, SB_HEAD_DIM).transpose(2, 0, 1, 3, 4)
    key_pos = jnp.arange(S)

    def one_block(args):
        q_blk, start = args
        z = jnp.einsum('bhqd,bhkd->bhqk', q_blk, k).astype(jnp.float32) * scale
        q_pos = start + jnp.arange(Q_BLOCK)
        causal = key_pos[None, :] < q_pos[:, None]
        log_not = jnp.where(causal, jax.nn.log_sigmoid(-z), 0.0)
        suffix = lax.cumsum(log_not, axis=3, reverse=True) - log_not
        w = jnp.where(causal, jnp.exp(jax.nn.log_sigmoid(z) + suffix), 0.0)
        return jnp.einsum('bhqk,bhkd->bhqd', w.astype(v.dtype), v)

    starts = jnp.arange(nb) * Q_BLOCK
    o = lax.map(one_block, (q_blocks, starts))
    return o.transpose(1, 0, 3, 2, 4).reshape(B, S, D_ATTN)


def _linear_recurrence(c1, c2):
    a1, b1 = c1
    a2, b2 = c2
    return (a1 * a2, a2 * b1 + b2)


def rg_lru_branch(xr, xg, conv_w, conv_b, w_a, b_a, w_x, b_x, lam):
    B, S, _ = xr.shape
    xpad = jnp.pad(xr, ((0, 0), (CONV_WIDTH - 1, 0), (0, 0)))
    xc = conv_b
    for j in range(CONV_WIDTH):
        xc = xc + conv_w[j] * xpad[:, j:j + S]
    blocks = xc.reshape(B, S, RG_BLOCKS, RG_BLOCK_DIM)
    r = jax.nn.sigmoid(jnp.einsum('bsgi,gij->bsgj', blocks, w_a).reshape(B, S, D_RNN) + b_a)
    ig = jax.nn.sigmoid(jnp.einsum('bsgi,gij->bsgj', blocks, w_x).reshape(B, S, D_RNN) + b_x)
    log_a = -RG_C * jax.nn.softplus(-lam.astype(jnp.float32)) * r.astype(jnp.float32)
    a = jnp.exp(log_a)
    b = jnp.sqrt(-jnp.expm1(2.0 * log_a)) * (ig * xc).astype(jnp.float32)
    _, h = lax.associative_scan(_linear_recurrence, (a, b), axis=1)
    return h.astype(xr.dtype) * jax.nn.gelu(xg)


def hierarchical_moe(h, w_group, b_group, w_expert, b_expert, w_gate, w_up, w_down):
    B, S, D = h.shape
    ht = h.reshape(B * S, D)
    g_logits = (ht @ w_group + b_group).astype(jnp.float32)
    p_group = jax.nn.softmax(g_logits, axis=-1)
    g_idx = jnp.argmax(g_logits, axis=-1)
    gate_group = jnp.take_along_axis(p_group, g_idx[:, None], axis=1)[:, 0]
    e_logits = (ht @ w_expert + b_expert).astype(jnp.float32)
    e_logits = e_logits.reshape(-1, N_GROUPS, EXPERTS_PER_GROUP)
    sel = jnp.take_along_axis(e_logits, g_idx[:, None, None], axis=1)[:, 0]
    top_vals, top_idx = lax.top_k(sel, TOP_K_IN_GROUP)
    w_in_group = jax.nn.softmax(top_vals, axis=-1)
    within = jnp.einsum('tk,tke->te', w_in_group,
                        jax.nn.one_hot(top_idx, EXPERTS_PER_GROUP, dtype=jnp.float32))
    combine = (jax.nn.one_hot(g_idx, N_GROUPS, dtype=jnp.float32)[:, :, None]
               * within[:, None, :] * gate_group[:, None, None])
    combine = combine.reshape(-1, N_EXPERTS).astype(h.dtype)
    y = jnp.zeros_like(ht)
    for e in range(N_EXPERTS):
        he = jax.nn.silu(ht @ w_gate[e]) * (ht @ w_up[e])
        y = y + combine[:, e:e + 1] * (he @ w_down[e])
    return y.reshape(B, S, D)


def setup_inputs(seed: int = 0) -> dict:
    key = jax.random.key(seed)
    ks = jax.random.split(key, 32)

    def nrm(k, shape, scale):
        return jax.random.normal(k, shape, jnp.float32) * scale

    u = jax.random.uniform(ks[11], (DEPTH, D_RNN), jnp.float32, minval=0.9, maxval=0.999)
    s = u ** (1.0 / RG_C)
    rg_lambda = jnp.log(s) - jnp.log1p(-s)
    return {
        "x": nrm(ks[0], (BATCH, SEQ, D_MODEL), 1.0),
        "p": nrm(ks[1], (DEPTH, BATCH, SEQ, PLE_DIM), 1.0),
        "norm_mix": 1.0 + nrm(ks[2], (DEPTH, D_MODEL), 0.05),
        "w_in": nrm(ks[3], (DEPTH, D_MODEL, IN_COLS), D_MODEL ** -0.5),
        "conv_w": nrm(ks[4], (DEPTH, CONV_WIDTH, D_RNN), CONV_WIDTH ** -0.5),
        "conv_b": nrm(ks[5], (DEPTH, D_RNN), 0.01),
        "w_rg_a": nrm(ks[6], (DEPTH, RG_BLOCKS, RG_BLOCK_DIM, RG_BLOCK_DIM), RG_BLOCK_DIM ** -0.5),
        "b_rg_a": nrm(ks[7], (DEPTH, D_RNN), 0.01),
        "w_rg_x": nrm(ks[8], (DEPTH, RG_BLOCKS, RG_BLOCK_DIM, RG_BLOCK_DIM), RG_BLOCK_DIM ** -0.5),
        "b_rg_x": nrm(ks[9], (DEPTH, D_RNN), 0.01),
        "rg_lambda": rg_lambda,
        "w_attn_o": nrm(ks[12], (DEPTH, D_ATTN, D_MODEL), D_ATTN ** -0.5),
        "w_rnn_o": nrm(ks[13], (DEPTH, D_RNN, D_MODEL), D_RNN ** -0.5),
        "w_out": nrm(ks[14], (DEPTH, D_MODEL, D_MODEL), D_MODEL ** -0.5),
        "norm_moe": 1.0 + nrm(ks[15], (DEPTH, D_MODEL), 0.05),
        "w_router_group": nrm(ks[16], (DEPTH, D_MODEL, N_GROUPS), D_MODEL ** -0.5),
        "b_router_group": nrm(ks[17], (DEPTH, N_GROUPS), 0.01),
        "w_router_expert": nrm(ks[18], (DEPTH, D_MODEL, N_EXPERTS), D_MODEL ** -0.5),
        "b_router_expert": nrm(ks[19], (DEPTH, N_EXPERTS), 0.01),
        "w_exp_gate": nrm(ks[20], (DEPTH, N_EXPERTS, D_MODEL, D_EXPERT), D_MODEL ** -0.5),
        "w_exp_up": nrm(ks[21], (DEPTH, N_EXPERTS, D_MODEL, D_EXPERT), D_MODEL ** -0.5),
        "w_exp_down": nrm(ks[22], (DEPTH, N_EXPERTS, D_EXPERT, D_MODEL), D_EXPERT ** -0.5),
        "norm_ple": 1.0 + nrm(ks[23], (DEPTH, D_MODEL), 0.05),
        "w_ple_gate": nrm(ks[24], (DEPTH, D_MODEL, D_MODEL), D_MODEL ** -0.5),
        "w_ple_proj": nrm(ks[25], (DEPTH, PLE_DIM, D_MODEL), PLE_DIM ** -0.5),
        "norm_final": 1.0 + nrm(ks[26], (D_MODEL,), 0.05),
    }


def reference(x, p, norm_mix, w_in, conv_w, conv_b, w_rg_a, b_rg_a, w_rg_x, b_rg_x,
              rg_lambda, w_attn_o, w_rnn_o, w_out, norm_moe, w_router_group,
              b_router_group, w_router_expert, b_router_expert, w_exp_gate, w_exp_up,
              w_exp_down, norm_ple, w_ple_gate, w_ple_proj, norm_final):
    for i in range(DEPTH):
        h = rms_norm(x, norm_mix[i])
        proj = h @ w_in[i]
        q, k, v, xr, xg, gate_attn, gate_rnn = jnp.split(proj, SPLIT_POINTS, axis=-1)
        y_attn = stick_breaking_attention(q, k, v) @ w_attn_o[i]
        y_rnn = rg_lru_branch(xr, xg, conv_w[i], conv_b[i], w_rg_a[i], b_rg_a[i],
                              w_rg_x[i], b_rg_x[i], rg_lambda[i]) @ w_rnn_o[i]
        merged = jax.nn.sigmoid(gate_attn) * y_attn + jax.nn.sigmoid(gate_rnn) * y_rnn
        x = x + merged @ w_out[i]
        h = rms_norm(x, norm_moe[i])
        x = x + hierarchical_moe(h, w_router_group[i], b_router_group[i],
                                 w_router_expert[i], b_router_expert[i],
                                 w_exp_gate[i], w_exp_up[i], w_exp_down[i])
        gate = jax.nn.sigmoid(rms_norm(x, norm_ple[i]) @ w_ple_gate[i])
        x = x + gate * (p[i] @ w_ple_proj[i])
    return rms_norm(x, norm_final)
```

```cpp
#include <hip/hip_runtime.h>
#include <cstdio>
#include <cstdint>

#ifndef REP_PHASE
#define REP_PHASE -1
#endif
#define REPN(k) ((REP_PHASE == (k)) ? 2 : 1)
#ifndef MK_N_LAUNCHES
#define MK_N_LAUNCHES 1
#endif

#define LAS __attribute__((address_space(3)))
#define GAS __attribute__((address_space(1)))
typedef unsigned short bf16_t;
typedef short bf16x8 __attribute__((ext_vector_type(8)));
typedef float f32x4 __attribute__((ext_vector_type(4)));
typedef float f32x2 __attribute__((ext_vector_type(2)));
typedef float f32x16 __attribute__((ext_vector_type(16)));
typedef unsigned u32x4 __attribute__((ext_vector_type(4)));
typedef unsigned u32x2 __attribute__((ext_vector_type(2)));

constexpr int NB = 4, SEQ = 4096, T = NB * SEQ, D = 1024, DA = 512, DR = 512, NIN = 4608, NE = 16, DE = 512, PLED = 256, DEPTH = 4, NHEAD = 8;
constexpr float EPS = 1e-6f;
constexpr float LOG2E = 1.4426950408889634f;
constexpr float QSCALE = 0.125f * LOG2E;
constexpr int LCAP = 16384;

__device__ __forceinline__ unsigned cvt_pk_bf16(float lo, float hi) { unsigned r; asm volatile("v_cvt_pk_bf16_f32 %0, %1, %2" : "=v"(r) : "v"(lo), "v"(hi)); return r; }
__device__ __forceinline__ u32x4 zero4() { unsigned z; asm volatile("v_mov_b32 %0, 0" : "=v"(z)); return (u32x4){z, z, z, z}; }
__device__ __forceinline__ float bf2f(unsigned short h) { return __uint_as_float(((unsigned)h) << 16); }
__device__ __forceinline__ float bflo(unsigned w) { return __uint_as_float(w << 16); }
__device__ __forceinline__ float bfhi(unsigned w) { return __uint_as_float(w & 0xffff0000u); }
__device__ __forceinline__ float fexp2(float x) { return __builtin_amdgcn_exp2f(x); }
__device__ __forceinline__ float frcp(float x) { return __builtin_amdgcn_rcpf(x); }
__device__ __forceinline__ float sigmoidf_(float x) { return frcp(1.0f + fexp2(-LOG2E * x)); }
__device__ __forceinline__ float gelu_tanh_(float x) { const float u = 1.5957691216057308f * (x + 0.044715f * x * x * x); return x * sigmoidf_(u); }
template <int CTRL> __device__ __forceinline__ float dpp_f(float v) { return __int_as_float(__builtin_amdgcn_update_dpp(0, __float_as_int(v), CTRL, 0xF, 0xF, false)); }
__device__ __forceinline__ float wave_sum(float v) {
    v += dpp_f<0xB1>(v);
    v += dpp_f<0x4E>(v);
    v += dpp_f<0x141>(v);
    v += dpp_f<0x140>(v);
    const float a = __int_as_float(__builtin_amdgcn_readlane(__float_as_int(v), 0)), b = __int_as_float(__builtin_amdgcn_readlane(__float_as_int(v), 16));
    const float c = __int_as_float(__builtin_amdgcn_readlane(__float_as_int(v), 32)), d = __int_as_float(__builtin_amdgcn_readlane(__float_as_int(v), 48));
    return (a + b) + (c + d);
}

namespace pg8 {
constexpr int BM = 256, BK = 64, HALF = 128, HTB = HALF * BK * 2, STAGE_BYTES = 8 * HTB, NXCD = 8, WGM = 8;
__host__ __device__ __forceinline__ int lds_byte(int r, int c) { const int st = (r >> 4) * 2 + (c >> 5), rr = r & 15, cc = c & 31, ob = rr * 64 + cc * 2; return st * 1024 + (ob ^ (((ob >> 9) & 1) << 5)); }
__host__ __device__ __forceinline__ void stage_rc(int b, int& R, int& C) { const int st = b / 1024, sb = b % 1024, swz = sb ^ (((sb >> 9) & 1) << 5); R = (st >> 1) * 16 + swz / 64; C = (st & 1) * 32 + (swz % 64) / 2; }
__host__ __device__ __forceinline__ int perm32(int rho) { const int n = rho >> 4, i = rho & 15; return 8 * (i >> 2) + 4 * n + (i & 3); }

struct Unit { int pm, pn, e, pos0, ne; };
struct Gemm { const bf16_t* A; const bf16_t* Bt; int lda, ldb, K; };

struct StaticOrder {
    int nM, nN, nwg, G, c;
    __device__ __forceinline__ void init(int M, int N, int G_, int c_) { nM = M / BM; nN = N / BM; nwg = nM * nN; G = G_; c = c_; }
    __device__ __forceinline__ bool next(int i, Unit& u) const {
        const long L = (long)i * G + c; if (L >= nwg) return false;
        int wgid = (int)L; { const int q = nwg / NXCD, r = nwg % NXCD, xcd = wgid % NXCD, off = wgid / NXCD; wgid = (xcd < r ? xcd * (q + 1) : r * (q + 1) + (xcd - r) * q) + off; }
        const int nig = WGM * nN, gid = wgid / nig, fm = gid * WGM, gsz = (nM - fm) < WGM ? (nM - fm) : WGM;
        u.pm = fm + ((wgid % nig) % gsz); u.pn = (wgid % nig) / gsz; u.e = 0; u.pos0 = i; u.ne = 0; return true;
    }
    static constexpr bool GATHER = false;
    __device__ __forceinline__ int arow(const Unit& u, int r) const { return u.pm * BM + r; }
    __device__ __forceinline__ int arow0(const Unit& u) const { return u.pm * BM; }
    __device__ __forceinline__ int brow(const Unit& u) const { return u.pn * BM; }
    __device__ __forceinline__ int koff(const Unit&) const { return 0; }
};

template <class Epi, class Sched>
__device__ __forceinline__ void gemm_phase(LAS unsigned char* lds, const Gemm g, const Sched& S, const Epi& E, int tid_) {
    asm volatile("" : "+v"(tid_));
    const int tid = tid_, wid = __builtin_amdgcn_readfirstlane(tid >> 6), lane = tid & 63, wr = wid >> 2, wc = wid & 3, fr = lane & 15, fq = lane >> 4;
    int nt = g.K / BK; asm volatile("" : "+s"(nt));
    unsigned voffB[2];
#pragma unroll
    for (int i = 0; i < 2; ++i) { int R, C; stage_rc(tid * 16 + i * 8192, R, C); const int Rb = Epi::PERM ? ((R & ~31) + perm32(R & 31)) : R;
        voffB[i] = (unsigned)(Rb * g.ldb + C) * 2u; }
    const size_t kstep = (size_t)(BK * 2);
    const size_t hstepB = (size_t)HALF * g.ldb * 2;
    const unsigned ldsw = (unsigned)wid * 1024u;
    const int aoff = lds_byte(wr * 64 + fr, fq * 8), boff = lds_byte(wc * 32 + fr, fq * 8);
#define PG8_SA(b, h) (((b) * 2 + (h)) * HTB)
#define PG8_SB(b, h) ((4 + (b) * 2 + (h)) * HTB)
#define PG8_STAGE(bufoff, gbase, voff) do { _Pragma("unroll") for (int _i = 0; _i < 2; ++_i) \
        __builtin_amdgcn_global_load_lds((const unsigned*)((const char*)(gbase) + (voff)[_i]), (LAS unsigned*)(lds + (bufoff) + ldsw + _i * 8192), 16, 0, 0); } while (0)
#define PG8_LDA(dst, b, h) do { _Pragma("unroll") for (int m = 0; m < 4; ++m) _Pragma("unroll") for (int k = 0; k < 2; ++k) dst[m][k] = *(const LAS bf16x8*)(lds + PG8_SA(b, h) + aoff + m * 2048 + k * 1024); } while (0)
#define PG8_LDB(dst, b, h) do { _Pragma("unroll") for (int n = 0; n < 2; ++n) _Pragma("unroll") for (int k = 0; k < 2; ++k) dst[n][k] = *(const LAS bf16x8*)(lds + PG8_SB(b, h) + boff + n * 2048 + k * 1024); } while (0)
#define PG8_MMA(ai, bj, At, Bt) do { __builtin_amdgcn_s_setprio(1); _Pragma("unroll") for (int m = 0; m < 4; ++m) _Pragma("unroll") for (int n = 0; n < 2; ++n) _Pragma("unroll") for (int k = 0; k < 2; ++k) \
        acc[ai][bj][m][n] = __builtin_amdgcn_mfma_f32_16x16x32_bf16(Bt[n][k], At[m][k], acc[ai][bj][m][n], 0, 0, 0); __builtin_amdgcn_s_setprio(0); } while (0)
#define PG8_WAIT_V(n) asm volatile("s_waitcnt vmcnt(" #n ")" ::: "memory")
#define PG8_WAIT_L(n) asm volatile("s_waitcnt lgkmcnt(" #n ")" ::: "memory")
#define PG8_BAR __builtin_amdgcn_s_barrier()
#define PG8_SCHED __builtin_amdgcn_sched_barrier(0)
#define PG8_AOFF(dst, u) do { _Pragma("unroll") for (int _i = 0; _i < 2; ++_i) { int _R, _C; stage_rc(tid * 16 + _i * 8192, _R, _C); _Pragma("unroll") for (int _h = 0; _h < 2; ++_h) \
        dst[_h][_i] = ((unsigned)S.arow(u, _h * HALF + _R) * (unsigned)g.lda + (unsigned)_C) * 2u; } } while (0)
#define PG8_LOFF(dst) do { _Pragma("unroll") for (int _i = 0; _i < 2; ++_i) { int _R, _C; stage_rc(tid * 16 + _i * 8192, _R, _C); _Pragma("unroll") for (int _h = 0; _h < 2; ++_h) \
        dst[_h][_i] = ((unsigned)(_h * HALF + _R) * (unsigned)g.lda + (unsigned)_C) * 2u; } } while (0)
    Unit cur, nxt; int ui = 0;
    if (!S.next(0, cur)) return;
    f32x4 acc[2][2][4][2];
    if constexpr (Epi::INIT_ACC) E.init(acc, cur, wr, wc, fr, fq);
    else {
#pragma unroll
    for (int a = 0; a < 2; ++a)
#pragma unroll
        for (int b = 0; b < 2; ++b)
#pragma unroll
            for (int m = 0; m < 4; ++m)
#pragma unroll
                for (int n = 0; n < 2; ++n) acc[a][b][m][n] = (f32x4){0.f, 0.f, 0.f, 0.f};
    }
    bf16x8 At[4][2], B0[2][2], B1[2][2];
    constexpr bool GA = Sched::GATHER;
    unsigned ca[2][2], na[2][2];
    const char* cA = (const char*)g.A; const char* nA = cA;
    if constexpr (GA) { PG8_AOFF(ca, cur); }
    else { PG8_LOFF(ca); cA = (const char*)g.A + ((size_t)S.arow0(cur) * g.lda + S.koff(cur)) * 2; }
    const char* cB = (const char*)g.Bt + ((size_t)S.brow(cur) * g.ldb + S.koff(cur)) * 2;
    PG8_STAGE(PG8_SB(0, 0), cB, voffB); PG8_STAGE(PG8_SB(0, 1), cB + hstepB, voffB); PG8_STAGE(PG8_SA(0, 0), cA, ca[0]); PG8_STAGE(PG8_SA(0, 1), cA, ca[1]);
    if (wr == 1) PG8_BAR;
    PG8_WAIT_V(2); PG8_BAR;
    PG8_STAGE(PG8_SB(1, 0), cB + kstep, voffB); PG8_STAGE(PG8_SA(1, 0), cA + kstep, ca[0]); PG8_STAGE(PG8_SB(1, 1), cB + hstepB + kstep, voffB);
    PG8_WAIT_V(6); PG8_BAR;
    for (;;) {
        const bool has_next = S.next(ui + 1, nxt);
        const char* nB = cB; nA = cA;
        if (has_next) { nB = (const char*)g.Bt + ((size_t)S.brow(nxt) * g.ldb + S.koff(nxt)) * 2;
            if constexpr (GA) { PG8_AOFF(na, nxt); } else { nA = (const char*)g.A + ((size_t)S.arow0(nxt) * g.lda + S.koff(nxt)) * 2; } }
        else { if constexpr (GA) {
#pragma unroll
            for (int h = 0; h < 2; ++h)
#pragma unroll
                for (int i = 0; i < 2; ++i) na[h][i] = ca[h][i]; } }
        for (int t = 0; t < nt; t += 2) {
            const bool last = (t == nt - 2);
            if constexpr (Epi::HAS_MID) { if (2 * t == nt) { int mfr = fr, mfq = fq; asm volatile("" : "+v"(mfr), "+v"(mfq)); E.mid(acc, cur, wr, wc, mfr, mfq); } }
            const char* a1 = cA + (size_t)(t + 1) * kstep;
            const char* a2 = last ? nA : cA + (size_t)(t + 2) * kstep; const char* b2 = last ? nB : cB + (size_t)(t + 2) * kstep;
            const char* a3 = a2 + kstep; const char* b3 = b2 + kstep;
            unsigned o2[2][2];
#pragma unroll
            for (int h = 0; h < 2; ++h)
#pragma unroll
                for (int i = 0; i < 2; ++i) { if constexpr (GA) o2[h][i] = last ? na[h][i] : ca[h][i]; else o2[h][i] = ca[h][i]; }
            PG8_LDB(B0, 0, 0); PG8_LDB(B1, 0, 1); PG8_SCHED; PG8_LDA(At, 0, 0); PG8_STAGE(PG8_SA(1, 1), a1, ca[1]);
            PG8_WAIT_V(8); PG8_WAIT_L(0); PG8_BAR; PG8_MMA(0, 0, At, B0); PG8_MMA(0, 1, At, B1); PG8_BAR; PG8_SCHED;
            PG8_LDA(At, 0, 1); PG8_STAGE(PG8_SB(0, 0), b2, voffB); PG8_STAGE(PG8_SB(0, 1), b2 + hstepB, voffB); PG8_STAGE(PG8_SA(0, 0), a2, o2[0]);
            PG8_WAIT_V(8); PG8_WAIT_L(0); PG8_BAR; PG8_MMA(1, 0, At, B0); PG8_MMA(1, 1, At, B1); PG8_BAR; PG8_SCHED;
            PG8_LDB(B0, 1, 0); PG8_LDB(B1, 1, 1); PG8_SCHED; PG8_LDA(At, 1, 0); PG8_STAGE(PG8_SA(0, 1), a2, o2[1]);
            PG8_WAIT_V(8); PG8_WAIT_L(0); PG8_BAR; PG8_MMA(0, 0, At, B0); PG8_MMA(0, 1, At, B1); PG8_BAR; PG8_SCHED;
            PG8_LDA(At, 1, 1); PG8_STAGE(PG8_SB(1, 0), b3, voffB); PG8_STAGE(PG8_SB(1, 1), b3 + hstepB, voffB); PG8_STAGE(PG8_SA(1, 0), a3, o2[0]);
            PG8_WAIT_V(8); PG8_WAIT_L(0); PG8_BAR; PG8_MMA(1, 0, At, B0); PG8_MMA(1, 1, At, B1); PG8_BAR; PG8_SCHED;
        }
        if (wr == 0) PG8_BAR;
        { int efr = fr, efq = fq; asm volatile("" : "+v"(efr), "+v"(efq));
          E(acc, cur, wr, wc, efr, efq); }
        if (!has_next) break;
        if constexpr (Epi::INIT_ACC) E.init(acc, nxt, wr, wc, fr, fq);
        else {
#pragma unroll
        for (int a = 0; a < 2; ++a)
#pragma unroll
            for (int b = 0; b < 2; ++b)
#pragma unroll
                for (int m = 0; m < 4; ++m)
#pragma unroll
                    for (int n = 0; n < 2; ++n) acc[a][b][m][n] = (f32x4){0.f, 0.f, 0.f, 0.f};
        }
        cur = nxt; cB = nB; cA = nA; ++ui;
        if constexpr (GA) {
#pragma unroll
            for (int h = 0; h < 2; ++h)
#pragma unroll
                for (int i = 0; i < 2; ++i) ca[h][i] = na[h][i]; }
        if (wr == 1) PG8_BAR;
    }
    PG8_WAIT_V(0);
    PG8_BAR;
#undef PG8_SA
#undef PG8_SB
#undef PG8_STAGE
#undef PG8_LDA
#undef PG8_LDB
#undef PG8_MMA
#undef PG8_WAIT_V
#undef PG8_WAIT_L
#undef PG8_BAR
#undef PG8_SCHED
#undef PG8_AOFF
#undef PG8_LOFF
}
}
using pg8::Unit;

constexpr size_t MiB = 1u << 20;
constexpr size_t WS_CTL = 0, CTL_ZERO_BYTES = 1 * MiB;
constexpr size_t WS_RTAB = 1 * MiB + 262144;
constexpr size_t WS_MISC = 1 * MiB;
constexpr size_t WS_WIN = 2 * MiB, WS_WGT = 11 * MiB, WS_WAO = 12 * MiB, WS_WRO = 13 * MiB, WS_WOUT = 14 * MiB, WS_WPG = 16 * MiB, WS_WPP = 18 * MiB;
constexpr size_t WS_WGU = 20 * MiB, WS_WDN = 52 * MiB;
constexpr size_t WS_WPGL = 551 * MiB;
constexpr size_t WSET = 66 * MiB;
#define WOFF(L) ((size_t)((L) & 1) * WSET)
constexpr size_t WS_SSQ = 134 * MiB;
constexpr size_t WS_XB = 135 * MiB, WS_PB = 167 * MiB, WS_PP = 199 * MiB;
constexpr size_t WS_Q = 327 * MiB, WS_K = 343 * MiB, WS_VT = 359 * MiB, WS_XR = 375 * MiB, WS_XG = 391 * MiB, WS_GA = 407 * MiB, WS_GR = 439 * MiB, WS_XC = 471 * MiB;
constexpr size_t WS_DB = 487 * MiB, WS_AO = 519 * MiB, WS_RI = 535 * MiB, WS_PART = 551 * MiB, WS_MG = 583 * MiB, WS_SUM = 615 * MiB;
constexpr size_t WS_ACT = 327 * MiB, WS_Y0 = WS_DB, WS_Y1 = WS_AO, WS_TOK = 616 * MiB, WS_WL = 617 * MiB, WS_RS = 618 * MiB;
constexpr size_t WS_XBW = WS_MG;
constexpr size_t WS_END = 619 * MiB;
constexpr int CW_BAR = 4096, CW_CNT = 16384;

constexpr int RING_BYTES = 131072, LDSCTL_OFF = RING_BYTES, MISC_OFF = LDSCTL_OFF + 320, LDS_BYTES = 147456;
constexpr int TSTART_OFF = LDSCTL_OFF + 512;
constexpr int RSTD_OFF = LDSCTL_OFF + 2048, RSTD_UNITS = 5;

#define XB_TMO      128
#define XB_XCNT(j)  (256  + 64 * (j))
#define XB_XSUB(j)  (1280 + 64 * (j))
#define XB_XGEN(j)  (2304 + 64 * (j))
#define XB_TOP      3328
#define XB_TOPGEN   3392
#define XCD_BAR_WORDS 3456
#define XB_SPIN_CAP (1u << 18)
__device__ __forceinline__ unsigned xb_ld(unsigned* p)              { return __hip_atomic_load(p, __ATOMIC_RELAXED, __HIP_MEMORY_SCOPE_AGENT); }
__device__ __forceinline__ unsigned xb_add(unsigned* p, unsigned v) { return __hip_atomic_fetch_add(p, v, __ATOMIC_RELAXED, __HIP_MEMORY_SCOPE_AGENT); }
__device__ __forceinline__ unsigned xb_xcc_id() { return (unsigned)__builtin_amdgcn_s_getreg((3 << 11) | 20) & 0xFu; }
#define XB_SPIN(cond, bar) do { unsigned _sp = 0; while (cond) { __builtin_amdgcn_s_sleep(1); \
    if ((++_sp & 255u) == 0u) { if (xb_ld(&(bar)[XB_TMO])) break; if (_sp > XB_SPIN_CAP) { atomicAdd(&(bar)[XB_TMO], 1u); break; } } } } while (0)
struct XcdBarrier { unsigned* bar; unsigned x; volatile LAS unsigned* st; };
__device__ __forceinline__ XcdBarrier xcd_barrier_post(unsigned* bar, volatile LAS unsigned* st) {
    XcdBarrier b; b.bar = bar; b.x = xb_xcc_id(); b.st = st;
    if (threadIdx.x == 0) (void)xb_add(&bar[XB_XCNT(b.x)], 1u);
    return b;
}
__device__ __forceinline__ void xcd_barrier_complete(unsigned* bar, unsigned x, unsigned& nloc, unsigned& nx) {
    const unsigned G = gridDim.x * gridDim.y * gridDim.z;
    unsigned sum, cnt, mine, sp = 0u;
    for (;;) {
        sum = 0u; cnt = 0u; mine = 0u;
#pragma unroll
        for (unsigned j = 0; j < 16; ++j) { const unsigned c = xb_ld(&bar[XB_XCNT(j)]); sum += c; cnt += (c > 0u) ? 1u : 0u; mine = (j == x) ? c : mine; }
        if (sum == G) break;
        __builtin_amdgcn_s_sleep(1);
        if ((++sp & 255u) == 0u) { if (xb_ld(&bar[XB_TMO])) break; if (sp > XB_SPIN_CAP) { atomicAdd(&bar[XB_TMO], 1u); break; } }
    }
    nloc = mine > 0u ? mine : 1u; nx = cnt > 0u ? cnt : 1u;
}
__device__ __forceinline__ void xcd_barrier(const XcdBarrier& b, int mode = 0) {
    const bool local = mode != 0;
    asm volatile("s_waitcnt vmcnt(0)" ::: "memory");
    __syncthreads();
    if (threadIdx.x == 0) {
        unsigned* bar = b.bar;
        __builtin_amdgcn_s_waitcnt(0);
        unsigned nloc = b.st[0], nx = b.st[1];
        if (nloc == 0u) { xcd_barrier_complete(bar, b.x, nloc, nx); b.st[0] = nloc; b.st[1] = nx; }
        const unsigned old = xb_add(&bar[XB_XSUB(b.x)], 1u);
        const unsigned gen = old / nloc;
        if (old + 1u == (gen + 1u) * nloc) {
            if (!local) {
            __builtin_amdgcn_fence(__ATOMIC_RELEASE, "agent");
            asm volatile("s_waitcnt vmcnt(0)" ::: "memory");
            const unsigned og = xb_add(&bar[XB_TOP], 1u);
            const unsigned tg = og / nx;
            if (og + 1u == (tg + 1u) * nx) xb_add(&bar[XB_TOPGEN], 1u);
            else XB_SPIN(xb_ld(&bar[XB_TOPGEN]) == tg, bar);
            }
            else if (mode == 2) {
                if ((b.x & 1u) == 0u) { __builtin_amdgcn_fence(__ATOMIC_RELEASE, "agent"); asm volatile("s_waitcnt vmcnt(0)" ::: "memory"); }
                else XB_SPIN(xb_ld(&bar[XB_XGEN(b.x - 1u)]) <= gen, bar);
            }
            __builtin_amdgcn_fence(__ATOMIC_ACQUIRE, "agent");
            xb_add(&bar[XB_XGEN(b.x)], 1u);
            asm volatile("s_waitcnt vmcnt(0)" ::: "memory");
        } else {
            XB_SPIN(xb_ld(&bar[XB_XGEN(b.x)]) == gen, bar);
            __builtin_amdgcn_fence(__ATOMIC_ACQUIRE, "agent");
            asm volatile("s_waitcnt vmcnt(0)" ::: "memory");
        }
    }
    __syncthreads();
}

struct Args { const float* in[26]; float* out; unsigned char* ws; int ph_lo, ph_hi; };
struct Frame {
    LAS unsigned char* lds;
    unsigned* ctl;
    unsigned char* ws;
    int tid, lane, wave, G, bid;
    float* out;
};
struct XSpan { int base, first, stride, count; };
__device__ __forceinline__ XSpan xspan(int G, int bid, int n) { XSpan s; if ((G & 7) == 0) { s.base = (bid & 7) * (n >> 3); s.first = bid >> 3; s.stride = G >> 3; s.count = n >> 3; } else { s.base = 0; s.first = bid; s.stride = G; s.count = n; } return s; }
constexpr int PTAB_OFF = LDSCTL_OFF + 1024;
__device__ __forceinline__ const float* inp(const Frame& F, int k) {
    const unsigned long long v = ((const LAS unsigned long long*)(F.lds + PTAB_OFF))[k];
    const unsigned lo = __builtin_amdgcn_readfirstlane((unsigned)v), hi = __builtin_amdgcn_readfirstlane((unsigned)(v >> 32));
    return (const float*)(const GAS float*)(((unsigned long long)hi << 32) | lo);
}
#define LDS_WAIT() asm volatile("s_waitcnt lgkmcnt(0)" ::: "memory")

__device__ __forceinline__ float row_rstd(const float* SSQ, int row) {
    const f32x4* p = (const f32x4*)(SSQ + (size_t)row * 16); const f32x4 a = p[0], b = p[1], c = p[2], d = p[3];
    const float s = (((a[0] + a[1]) + (a[2] + a[3])) + ((b[0] + b[1]) + (b[2] + b[3]))) + (((c[0] + c[1]) + (c[2] + c[3])) + ((d[0] + d[1]) + (d[2] + d[3])));
    return 1.0f / sqrtf(s * (1.0f / D) + EPS);
}
typedef f32x4 AccT[2][2][4][2];

struct EpiWin {
    static constexpr bool PERM = true, INIT_ACC = false, HAS_MID = false;
    const float* SSQ; const LAS float* RL; bf16_t *Q, *K, *VT, *XR, *XG, *GA, *GR;
    __device__ __forceinline__ void operator()(const AccT& acc, const Unit& u, int wr, int wc, int fr, int fq) const {
        const int pn = u.pn, row0 = u.pm * 256 + wr * 64 + fr, cl = wc * 32 + 8 * fq;
        float rsv[2][4];
        if (u.pos0 < RSTD_UNITS) {
#pragma unroll
            for (int ai = 0; ai < 2; ++ai)
#pragma unroll
                for (int m = 0; m < 4; ++m) rsv[ai][m] = RL[u.pos0 * 256 + ai * 128 + wr * 64 + m * 16 + fr];
        } else { const int l = fr + 16 * fq; const float r0 = row_rstd(SSQ, u.pm * 256 + wr * 64 + l), r1 = row_rstd(SSQ, u.pm * 256 + 128 + wr * 64 + l);
#pragma unroll
          for (int m = 0; m < 4; ++m) { rsv[0][m] = __shfl(r0, 16 * m + fr); rsv[1][m] = __shfl(r1, 16 * m + fr); } }
        if (pn == 4 || pn == 5) {
            const int cb = (pn - 4) * 256;
#pragma unroll
            for (int ai = 0; ai < 2; ++ai)
#pragma unroll
                for (int m = 0; m < 4; ++m) { const int row = row0 + ai * 128 + m * 16; const float rs = rsv[ai][m];
                    const int b = row >> 12, ts = row & (SEQ - 1), o = ts & 15;
                    const int kin = (ts & 16) + ((o & 3) | (((o >> 3) & 1) << 2) | (((o >> 2) & 1) << 3));
                    const size_t tb = ((size_t)b * NHEAD * (SEQ / 32) + (ts >> 5)) * 2048 + kin;
#pragma unroll
                    for (int bj = 0; bj < 2; ++bj)
#pragma unroll
                        for (int n = 0; n < 2; ++n) { const f32x4 v = acc[ai][bj][m][n] * rs; const int c = cb + bj * 128 + cl + 4 * n;
#pragma unroll
                            for (int q = 0; q < 4; ++q) { const int cc = c + q; VT[tb + (size_t)(cc >> 6) * ((SEQ / 32) * 2048) + (cc & 63) * 32] = (bf16_t)(cvt_pk_bf16(v[q], 0.f) & 0xffffu); } } }
            return;
        }
        if (pn < 4) {
            bf16_t* base = Q + (size_t)(pn >> 1) * (size_t)((WS_K - WS_Q) / 2); const float sc = (pn < 2) ? QSCALE : 1.f; const int c0 = (pn & 1) * 256;
#pragma unroll
            for (int ai = 0; ai < 2; ++ai)
#pragma unroll
                for (int m = 0; m < 4; ++m) { const int row = row0 + ai * 128 + m * 16; const float rs = rsv[ai][m] * sc; const int b = row >> 12, ts = row & (SEQ - 1);
#pragma unroll
                    for (int bj = 0; bj < 2; ++bj) { const f32x4 v0 = acc[ai][bj][m][0] * rs, v1 = acc[ai][bj][m][1] * rs; const int c = c0 + bj * 128 + cl;
                        u32x4 w; w.x = cvt_pk_bf16(v0[0], v0[1]); w.y = cvt_pk_bf16(v0[2], v0[3]); w.z = cvt_pk_bf16(v1[0], v1[1]); w.w = cvt_pk_bf16(v1[2], v1[3]);
                        *(u32x4*)(base + (((size_t)b * NHEAD + (c >> 6)) * SEQ + ts) * 64 + (c & 63)) = w; }
                    asm volatile("" ::: "memory"); }
            return;
        }
        int act = 0, pitch = 512, c0; float sc = 1.f; size_t boff;
        if (pn < 8) { boff = WS_XR - WS_Q; c0 = (pn - 6) * 256; }
        else if (pn < 10) { boff = WS_XG - WS_Q; c0 = (pn - 8) * 256; act = 1; }
        else if (pn < 14) { boff = WS_GA - WS_Q; c0 = (pn - 10) * 256; act = 2; pitch = 1024; }
        else { boff = WS_GR - WS_Q; c0 = (pn - 14) * 256; act = 2; pitch = 1024; }
        bf16_t* base = (bf16_t*)((unsigned char*)Q + boff);
#pragma unroll
        for (int ai = 0; ai < 2; ++ai)
#pragma unroll
            for (int m = 0; m < 4; ++m) { const int row = row0 + ai * 128 + m * 16; const float rs = rsv[ai][m] * sc;
#pragma unroll
                for (int bj = 0; bj < 2; ++bj) { f32x4 v0 = acc[ai][bj][m][0] * rs, v1 = acc[ai][bj][m][1] * rs;
                    if (act == 1) {
#pragma unroll
                        for (int q = 0; q < 4; ++q) { v0[q] = gelu_tanh_(v0[q]); v1[q] = gelu_tanh_(v1[q]); }
                    } else if (act == 2) {
#pragma unroll
                        for (int q = 0; q < 4; ++q) { v0[q] = sigmoidf_(v0[q]); v1[q] = sigmoidf_(v1[q]); }
                    }
                    u32x4 w; w.x = cvt_pk_bf16(v0[0], v0[1]); w.y = cvt_pk_bf16(v0[2], v0[3]); w.z = cvt_pk_bf16(v1[0], v1[1]); w.w = cvt_pk_bf16(v1[2], v1[3]);
                    *(u32x4*)(base + (size_t)row * pitch + c0 + bj * 128 + cl) = w; }
                asm volatile("" ::: "memory"); }
    }
};

struct EpiGates {
    static constexpr bool PERM = true, INIT_ACC = false, HAS_MID = false;
    const bf16_t* XC; const float *ba, *bx, *cA; unsigned* DB;
    __device__ __forceinline__ void operator()(const AccT& acc, const Unit& u, int wr, int wc, int fr, int fq) const {
        const int row0 = u.pm * 256 + wr * 64 + fr, ch0 = u.pn * 128 + wc * 32 + 8 * fq;
        float vba[8], vbx[8], vca[8];
#pragma unroll
        for (int q = 0; q < 8; ++q) { vba[q] = ba[ch0 + q]; vbx[q] = bx[ch0 + q]; vca[q] = cA[ch0 + q]; }
        u32x4 xwv[2][4];
#pragma unroll
        for (int ai = 0; ai < 2; ++ai)
#pragma unroll
            for (int m = 0; m < 4; ++m) xwv[ai][m] = *(const u32x4*)(XC + (size_t)(row0 + ai * 128 + m * 16) * DR + ch0);
#pragma unroll
        for (int ai = 0; ai < 2; ++ai)
#pragma unroll
            for (int m = 0; m < 4; ++m) { const int row = row0 + ai * 128 + m * 16;
                const u32x4 xw = xwv[ai][m];
                float xc[8] = {bflo(xw.x), bfhi(xw.x), bflo(xw.y), bfhi(xw.y), bflo(xw.z), bfhi(xw.z), bflo(xw.w), bfhi(xw.w)};
                unsigned od[8];
#pragma unroll
                for (int q = 0; q < 8; ++q) { const float pa = acc[ai][0][m][q >> 2][q & 3], px = acc[ai][1][m][q >> 2][q & 3];
                    const float r = sigmoidf_(pa + vba[q]), ig = sigmoidf_(px + vbx[q]);
                    const float la = vca[q] * r;
                    const float om1 = (la > -0.25f) ? (-la * (1.f + 0.5f * la * (1.f + (1.f / 3.f) * la * (1.f + 0.25f * la * (1.f + 0.2f * la))))) : (1.f - fexp2(LOG2E * la));
                    const float om2 = om1 * (2.f - om1);
                    od[q] = cvt_pk_bf16(om1, __builtin_amdgcn_sqrtf(om2) * (ig * xc[q])); }
                *(u32x4*)(DB + (size_t)row * DR + ch0) = (u32x4){od[0], od[1], od[2], od[3]}; *(u32x4*)(DB + (size_t)row * DR + ch0 + 4) = (u32x4){od[4], od[5], od[6], od[7]};
                asm volatile("" ::: "memory"); }
    }
};

struct EpiMerge {
    static constexpr bool PERM = true, INIT_ACC = false, HAS_MID = false;
    const bf16_t *GA, *GR; bf16_t *PART, *MG;
    __device__ __forceinline__ void operator()(const AccT& acc, const Unit& u, int wr, int wc, int fr, int fq) const {
        const int row0 = u.pm * 256 + wr * 64 + fr, c00 = u.pn * 256 + wc * 32 + 8 * fq;
        const bf16_t* G = GA + (size_t)u.e * (size_t)((WS_GR - WS_GA) / 2);
        bf16_t* OUT = PART + (size_t)u.e * (size_t)((WS_MG - WS_PART) / 2);
#pragma unroll
        for (int ai = 0; ai < 2; ++ai)
#pragma unroll
            for (int mp = 0; mp < 2; ++mp) {
                u32x4 gw[2][2], pw[2][2];
#pragma unroll
                for (int mm = 0; mm < 2; ++mm)
#pragma unroll
                    for (int bj = 0; bj < 2; ++bj) { const size_t o = (size_t)(row0 + ai * 128 + (2 * mp + mm) * 16) * D + c00 + bj * 128;
                        gw[mm][bj] = *(const u32x4*)(G + o); pw[mm][bj] = u.e ? *(const u32x4*)(PART + o) : zero4(); }
#pragma unroll
                for (int mm = 0; mm < 2; ++mm)
#pragma unroll
                    for (int bj = 0; bj < 2; ++bj) { const int m = 2 * mp + mm; const size_t o = (size_t)(row0 + ai * 128 + m * 16) * D + c00 + bj * 128;
                        const u32x4 g = gw[mm][bj], p = pw[mm][bj];
                        const f32x4 g0 = {bflo(g.x), bfhi(g.x), bflo(g.y), bfhi(g.y)}, g1 = {bflo(g.z), bfhi(g.z), bflo(g.w), bfhi(g.w)};
                        const f32x4 v0 = g0 * acc[ai][bj][m][0] + (f32x4){bflo(p.x), bfhi(p.x), bflo(p.y), bfhi(p.y)}, v1 = g1 * acc[ai][bj][m][1] + (f32x4){bflo(p.z), bfhi(p.z), bflo(p.w), bfhi(p.w)};
                        u32x4 w; w.x = cvt_pk_bf16(v0[0], v0[1]); w.y = cvt_pk_bf16(v0[2], v0[3]); w.z = cvt_pk_bf16(v1[0], v1[1]); w.w = cvt_pk_bf16(v1[2], v1[3]);
                        *(u32x4*)(OUT + o) = w; }
                asm volatile("" ::: "memory"); }
    }
};
struct EpiMerge2 {
    static constexpr bool PERM = true, INIT_ACC = false, HAS_MID = true;
    const bf16_t *GA, *GR; bf16_t* MG;
    __device__ __forceinline__ void mid(AccT& acc, const Unit& u, int wr, int wc, int fr, int fq) const {
        const int row0 = u.pm * 256 + wr * 64 + fr, c00 = u.pn * 256 + wc * 32 + 8 * fq;
#pragma unroll
        for (int ai = 0; ai < 2; ++ai)
#pragma unroll
            for (int mp = 0; mp < 2; ++mp) {
                u32x4 ga[2][2], gr[2][2];
#pragma unroll
                for (int mm = 0; mm < 2; ++mm)
#pragma unroll
                    for (int bj = 0; bj < 2; ++bj) { const size_t o = (size_t)(row0 + ai * 128 + (2 * mp + mm) * 16) * D + c00 + bj * 128; ga[mm][bj] = *(const u32x4*)(GA + o); gr[mm][bj] = *(const u32x4*)(GR + o); }
#pragma unroll
                for (int mm = 0; mm < 2; ++mm)
#pragma unroll
                    for (int bj = 0; bj < 2; ++bj) { const int m = 2 * mp + mm; const u32x4 a = ga[mm][bj], r = gr[mm][bj];
                        const f32x4 r0 = {frcp(fmaxf(bflo(r.x), 1e-30f)), frcp(fmaxf(bfhi(r.x), 1e-30f)), frcp(fmaxf(bflo(r.y), 1e-30f)), frcp(fmaxf(bfhi(r.y), 1e-30f))};
                        const f32x4 r1 = {frcp(fmaxf(bflo(r.z), 1e-30f)), frcp(fmaxf(bfhi(r.z), 1e-30f)), frcp(fmaxf(bflo(r.w), 1e-30f)), frcp(fmaxf(bfhi(r.w), 1e-30f))};
                        acc[ai][bj][m][0] = acc[ai][bj][m][0] * ((f32x4){bflo(a.x), bfhi(a.x), bflo(a.y), bfhi(a.y)} * r0);
                        acc[ai][bj][m][1] = acc[ai][bj][m][1] * ((f32x4){bflo(a.z), bfhi(a.z), bflo(a.w), bfhi(a.w)} * r1); }
                asm volatile("" ::: "memory"); }
    }
    __device__ __forceinline__ void operator()(const AccT& acc, const Unit& u, int wr, int wc, int fr, int fq) const {
        const int row0 = u.pm * 256 + wr * 64 + fr, c00 = u.pn * 256 + wc * 32 + 8 * fq;
#pragma unroll
        for (int ai = 0; ai < 2; ++ai)
#pragma unroll
            for (int mp = 0; mp < 2; ++mp) {
                u32x4 gr[2][2];
#pragma unroll
                for (int mm = 0; mm < 2; ++mm)
#pragma unroll
                    for (int bj = 0; bj < 2; ++bj) gr[mm][bj] = *(const u32x4*)(GR + (size_t)(row0 + ai * 128 + (2 * mp + mm) * 16) * D + c00 + bj * 128);
#pragma unroll
                for (int mm = 0; mm < 2; ++mm)
#pragma unroll
                    for (int bj = 0; bj < 2; ++bj) { const int m = 2 * mp + mm; const u32x4 r = gr[mm][bj];
                        const f32x4 v0 = acc[ai][bj][m][0] * (f32x4){fmaxf(bflo(r.x), 1e-30f), fmaxf(bfhi(r.x), 1e-30f), fmaxf(bflo(r.y), 1e-30f), fmaxf(bfhi(r.y), 1e-30f)};
                        const f32x4 v1 = acc[ai][bj][m][1] * (f32x4){fmaxf(bflo(r.z), 1e-30f), fmaxf(bfhi(r.z), 1e-30f), fmaxf(bflo(r.w), 1e-30f), fmaxf(bfhi(r.w), 1e-30f)};
                        u32x4 w; w.x = cvt_pk_bf16(v0[0], v0[1]); w.y = cvt_pk_bf16(v0[2], v0[3]); w.z = cvt_pk_bf16(v1[0], v1[1]); w.w = cvt_pk_bf16(v1[2], v1[3]);
                        *(u32x4*)(MG + (size_t)(row0 + ai * 128 + m * 16) * D + c00 + bj * 128) = w; }
                asm volatile("" ::: "memory"); }
    }
};
struct GateOrder : pg8::StaticOrder {
    __device__ __forceinline__ int koff(const Unit& u) const { return 256 * (u.pn >> 1); }
};
struct PairOrder : pg8::StaticOrder {
    __device__ __forceinline__ bool next(int i, Unit& u) const { const bool ok = pg8::StaticOrder::next(i >> 1, u); u.e = i & 1; return ok; }
    __device__ __forceinline__ int arow(const Unit& u, int r) const { return u.e * T + u.pm * 256 + r; }
    __device__ __forceinline__ int arow0(const Unit& u) const { return u.e * T + u.pm * 256; }
    __device__ __forceinline__ int brow(const Unit& u) const { return u.e * 1024 + u.pn * 256; }
};
struct PPOrder : pg8::StaticOrder {
    __device__ __forceinline__ int arow(const Unit& u, int r) const { return u.pm * 256 + r; }
    __device__ __forceinline__ int arow0(const Unit& u) const { return u.pm * 256; }
    __device__ __forceinline__ int brow(const Unit& u) const { return (u.pm >> 6) * 1024 + u.pn * 256; }
};
struct PPSub {
    int lay, first, stride, vend;
    static constexpr bool GATHER = false;
    __device__ __forceinline__ bool next(int i, Unit& u) const { const int v = first + i * stride; if (first < 0 || v >= vend) return false;
        u.pm = lay * 64 + (v >> 2); u.pn = v & 3; u.e = 0; u.pos0 = i; u.ne = 0; return true; }
    __device__ __forceinline__ int arow(const Unit& u, int r) const { return u.pm * 256 + r; }
    __device__ __forceinline__ int arow0(const Unit& u) const { return u.pm * 256; }
    __device__ __forceinline__ int brow(const Unit& u) const { return (u.pm >> 6) * 1024 + u.pn * 256; }
    __device__ __forceinline__ int koff(const Unit&) const { return 0; }
};
struct EpiResid {
    static constexpr bool PERM = false, INIT_ACC = true, HAS_MID = false;
    const float* XI; float* XO;
    __device__ __forceinline__ void init(AccT& acc, const Unit& u, int wr, int wc, int fr, int fq) const {
        const int row0 = u.pm * 256 + wr * 64 + fr, c00 = u.pn * 256 + wc * 32 + 4 * fq;
#pragma unroll
        for (int ai = 0; ai < 2; ++ai)
#pragma unroll
            for (int m = 0; m < 4; ++m) { const size_t ro = (size_t)(row0 + ai * 128 + m * 16) * D;
#pragma unroll
                for (int bj = 0; bj < 2; ++bj)
#pragma unroll
                    for (int n = 0; n < 2; ++n) acc[ai][bj][m][n] = *(const f32x4*)(XI + ro + c00 + bj * 128 + n * 16); }
    }
    __device__ __forceinline__ void operator()(const AccT& acc, const Unit& u, int wr, int wc, int fr, int fq) const {
        const int row0 = u.pm * 256 + wr * 64 + fr, c00 = u.pn * 256 + wc * 32 + 4 * fq;
#pragma unroll
        for (int ai = 0; ai < 2; ++ai)
#pragma unroll
            for (int m = 0; m < 4; ++m) { const size_t ro = (size_t)(row0 + ai * 128 + m * 16) * D;
#pragma unroll
                for (int bj = 0; bj < 2; ++bj)
#pragma unroll
                    for (int n = 0; n < 2; ++n) *(f32x4*)(XO + ro + c00 + bj * 128 + n * 16) = acc[ai][bj][m][n]; }
    }
};
struct EpiBf16 {
    static constexpr bool PERM = true, INIT_ACC = false, HAS_MID = false;
    bf16_t* O; int ldc;
    __device__ __forceinline__ void operator()(const AccT& acc, const Unit& u, int wr, int wc, int fr, int fq) const {
        const int row0 = u.pm * 256 + wr * 64 + fr, c00 = u.pn * 256 + wc * 32 + 8 * fq;
#pragma unroll
        for (int ai = 0; ai < 2; ++ai)
#pragma unroll
            for (int m = 0; m < 4; ++m) { const int row = row0 + ai * 128 + m * 16;
#pragma unroll
                for (int bj = 0; bj < 2; ++bj) { const f32x4 v0 = acc[ai][bj][m][0], v1 = acc[ai][bj][m][1];
                    u32x4 w; w.x = cvt_pk_bf16(v0[0], v0[1]); w.y = cvt_pk_bf16(v0[2], v0[3]); w.z = cvt_pk_bf16(v1[0], v1[1]); w.w = cvt_pk_bf16(v1[2], v1[3]);
                    *(u32x4*)(O + (size_t)row * ldc + c00 + bj * 128) = w; }
                asm volatile("" ::: "memory"); }
    }
};
struct EpiGU {
    static constexpr bool PERM = true, INIT_ACC = false, HAS_MID = false;
    const float* RS; bf16_t* ACT;
    __device__ __forceinline__ void operator()(const AccT& acc, const Unit& u, int wr, int wc, int fr, int fq) const {
        const int r0 = wr * 64 + fr, c0 = u.pn * 128 + wc * 32 + 8 * fq;
        float rsv[2][4];
#pragma unroll
        for (int ai = 0; ai < 2; ++ai)
#pragma unroll
            for (int m = 0; m < 4; ++m) rsv[ai][m] = RS[(size_t)u.e * LCAP + u.pos0 + r0 + ai * 128 + m * 16];
#pragma unroll
        for (int ai = 0; ai < 2; ++ai)
#pragma unroll
            for (int m = 0; m < 4; ++m) { const int r = r0 + ai * 128 + m * 16; const float rs = rsv[ai][m];
                float o[8];
#pragma unroll
                for (int q = 0; q < 8; ++q) { const float gg = rs * acc[ai][0][m][q >> 2][q & 3], uu = rs * acc[ai][1][m][q >> 2][q & 3]; o[q] = gg * sigmoidf_(gg) * uu; }
                u32x4 w; w.x = cvt_pk_bf16(o[0], o[1]); w.y = cvt_pk_bf16(o[2], o[3]); w.z = cvt_pk_bf16(o[4], o[5]); w.w = cvt_pk_bf16(o[6], o[7]);
                *(u32x4*)(ACT + (size_t)(u.pm * 256 + r) * DE + c0) = w;
                asm volatile("" ::: "memory"); }
    }
};
struct EpiDown {
    static constexpr bool PERM = true, INIT_ACC = false, HAS_MID = false;
    const unsigned* TOK; const float* WL; bf16_t *Y0, *Y1;
    __device__ __forceinline__ void operator()(const AccT& acc, const Unit& u, int wr, int wc, int fr, int fq) const {
        const int r0 = wr * 64 + fr, c00 = u.pn * 256 + wc * 32 + 8 * fq;
        unsigned tkv[2][4]; float wgv[2][4];
#pragma unroll
        for (int ai = 0; ai < 2; ++ai)
#pragma unroll
            for (int m = 0; m < 4; ++m) { const int p = u.pos0 + r0 + ai * 128 + m * 16; const bool ok = p < u.ne; tkv[ai][m] = ok ? TOK[(size_t)u.e * LCAP + p] : 0u; wgv[ai][m] = ok ? WL[(size_t)u.e * LCAP + p] : 0.f; }
#pragma unroll
        for (int ai = 0; ai < 2; ++ai)
#pragma unroll
            for (int m = 0; m < 4; ++m) { const int p = u.pos0 + r0 + ai * 128 + m * 16;
                if (p < u.ne) { const unsigned tk = tkv[ai][m]; const float wg = wgv[ai][m];
                    bf16_t* dst = ((tk >> 31) ? Y1 : Y0) + (size_t)(tk & 0x7fffffffu) * D + c00;
#pragma unroll
                    for (int bj = 0; bj < 2; ++bj) { const f32x4 v0 = acc[ai][bj][m][0] * wg, v1 = acc[ai][bj][m][1] * wg;
                        u32x4 w; w.x = cvt_pk_bf16(v0[0], v0[1]); w.y = cvt_pk_bf16(v0[2], v0[3]); w.z = cvt_pk_bf16(v1[0], v1[1]); w.w = cvt_pk_bf16(v1[2], v1[3]);
                        *(u32x4*)(dst + bj * 128) = w; } }
                asm volatile("" ::: "memory"); }
    }
};
struct EpiPle {
    static constexpr bool PERM = false, INIT_ACC = false, HAS_MID = false;
    const float* rstd; const bf16_t* PP; const float* X; float* XO; bf16_t* XB; float* SSQ;
    __device__ __forceinline__ void operator()(const AccT& acc, const Unit& u, int wr, int wc, int fr, int fq) const {
        const int row0 = u.pm * 256 + wr * 64 + fr, c00 = u.pn * 256 + wc * 32 + 4 * fq;
        u32x2 gp[2][4][2][2];
#pragma unroll
        for (int ai = 0; ai < 2; ++ai) {
            float rsv[4]; u32x2 ppv[4][2][2];
#pragma unroll
            for (int m = 0; m < 4; ++m) { const int row = row0 + ai * 128 + m * 16; rsv[m] = rstd[row];
#pragma unroll
                for (int bj = 0; bj < 2; ++bj)
#pragma unroll
                    for (int n = 0; n < 2; ++n) ppv[m][bj][n] = *(const u32x2*)(PP + (size_t)row * D + c00 + bj * 128 + n * 16); }
#pragma unroll
            for (int m = 0; m < 4; ++m)
#pragma unroll
                for (int bj = 0; bj < 2; ++bj)
#pragma unroll
                    for (int n = 0; n < 2; ++n) { const u32x2 pw = ppv[m][bj][n]; const f32x4 a = acc[ai][bj][m][n] * rsv[m];
                        gp[ai][m][bj][n].x = cvt_pk_bf16(sigmoidf_(a[0]) * bflo(pw.x), sigmoidf_(a[1]) * bfhi(pw.x));
                        gp[ai][m][bj][n].y = cvt_pk_bf16(sigmoidf_(a[2]) * bflo(pw.y), sigmoidf_(a[3]) * bfhi(pw.y)); }
            asm volatile("" ::: "memory"); }
#pragma unroll
        for (int ai = 0; ai < 2; ++ai) {
            f32x4 xv[4][2][2];
#pragma unroll
            for (int m = 0; m < 4; ++m)
#pragma unroll
                for (int bj = 0; bj < 2; ++bj)
#pragma unroll
                    for (int n = 0; n < 2; ++n) xv[m][bj][n] = *(const f32x4*)(X + (size_t)(row0 + ai * 128 + m * 16) * D + c00 + bj * 128 + n * 16);
#pragma unroll
            for (int m = 0; m < 4; ++m) { const int row = row0 + ai * 128 + m * 16; const size_t ro = (size_t)row * D; float sq = 0.f;
#pragma unroll
                for (int bj = 0; bj < 2; ++bj)
#pragma unroll
                    for (int n = 0; n < 2; ++n) { const int c = c00 + bj * 128 + n * 16; const u32x2 g = gp[ai][m][bj][n];
                        const f32x4 xn = xv[m][bj][n] + (f32x4){bflo(g.x), bfhi(g.x), bflo(g.y), bfhi(g.y)};
                        *(f32x4*)(XO + ro + c) = xn; sq += (xn[0] * xn[0] + xn[1] * xn[1]) + (xn[2] * xn[2] + xn[3] * xn[3]);
                        u32x2 xw; xw.x = cvt_pk_bf16(xn[0], xn[1]); xw.y = cvt_pk_bf16(xn[2], xn[3]); *(u32x2*)(XB + ro + c) = xw; }
                sq += __shfl_xor(sq, 16); sq += __shfl_xor(sq, 32);
                if (fq == 0) SSQ[(size_t)row * 16 + u.pn * 4 + wc] = sq; }
            asm volatile("" ::: "memory"); }
    }
};

template <bool GATHER_> struct GroupSched {
    static constexpr bool GATHER = GATHER_;
    const LAS int* tab; int G, c; const unsigned* TOK;
    __device__ __forceinline__ bool next(int i, Unit& u) const {
        const int ntile = tab[16]; int j, pn;
        if ((G & 7) == 0) { const int q = i * (G >> 3) + (c >> 3); j = ((q >> 2) << 3) + (c & 7); pn = q & 3; } else { const int Lu = i * G + c; j = Lu >> 2; pn = Lu & 3; }
        if (j >= ntile) return false;
        int e = 0;
#pragma unroll
        for (int k = 1; k < 16; ++k) e += (j >= tab[k]) ? 1 : 0;
        e = __builtin_amdgcn_readfirstlane(e);
        u.pm = j; u.pn = pn; u.e = e; u.pos0 = __builtin_amdgcn_readfirstlane((j - tab[e]) * 256); u.ne = __builtin_amdgcn_readfirstlane(tab[17 + e]); return true;
    }
    __device__ __forceinline__ int arow0(const Unit& u) const { return u.pm * 256; }
    __device__ __forceinline__ int arow(const Unit& u, int r) const {
        const int p = u.pos0 + r;
        return (p < u.ne) ? (int)(TOK[(size_t)u.e * LCAP + p] & 0x7fffffffu) : 0;
    }
    __device__ __forceinline__ int brow(const Unit& u) const { return u.e * 1024 + u.pn * 256; }
    __device__ __forceinline__ int koff(const Unit&) const { return 0; }
};

__device__ __forceinline__ void group_light(int G, int bid, int ntile, int& nl, int& li) {
    if ((G & 7) == 0) { const int W = G >> 3, maxu = (4 * ((ntile + 7) >> 3) + W - 1) / W; int tot = 0, mine = -1;
        for (int x = 0; x < 8; ++x) { const int ntx = (ntile + 7 - x) >> 3; int h = 4 * ntx - (maxu - 1) * W; h = h < 0 ? 0 : (h > W ? W : h);
            if (x == (bid & 7)) mine = ((bid >> 3) >= h) ? tot + (bid >> 3) - h : -1;
            tot += W - h; }
        nl = tot; li = mine; }
    else { const int nun = 4 * ntile, maxu = (nun + G - 1) / G, nheavy = nun - (maxu - 1) * G; nl = G - nheavy; li = bid - nheavy; }
    if (nl < 64) { nl = G; li = bid; }
}

struct TrDesc { const float* W; bf16_t* WT; int N, ldt, kofs, nbase, mode, rowoff, k0, n0, gsel; };
__device__ __forceinline__ void tr_load(const TrDesc& d, int lane, f32x4 (&v)[8]) {
    const float* p = d.W + (size_t)(d.k0 + (lane >> 3)) * d.N + d.n0 + 4 * (lane & 7);
#pragma unroll
    for (int i = 0; i < 8; ++i) v[i] = __builtin_nontemporal_load((const f32x4*)(p + (size_t)(8 * i) * d.N));
}
__device__ __forceinline__ void tr_store(const TrDesc& d, int lane, const f32x4 (&v)[8], LAS float* scr, const LAS float* gains) {
#pragma unroll
    for (int i = 0; i < 8; ++i) *(LAS f32x4*)(scr + (8 * i + (lane >> 3)) * 36 + 4 * (lane & 7)) = v[i];
    LDS_WAIT(); asm volatile("" ::: "memory");
    const int n = lane & 31;
    const LAS float* gl = gains + d.gsel * 1024 + d.k0;
#pragma unroll
    for (int j = 0; j < 4; ++j) { const int c = (lane >> 5) + 2 * j; const LAS float* s = scr + (8 * c) * 36 + n; const LAS float* gq = gl + 8 * c;
        float t[8];
#pragma unroll
        for (int q = 0; q < 8; ++q) t[q] = s[q * 36] * gq[q];
        u32x4 o; o.x = cvt_pk_bf16(t[0], t[1]); o.y = cvt_pk_bf16(t[2], t[3]); o.z = cvt_pk_bf16(t[4], t[5]); o.w = cvt_pk_bf16(t[6], t[7]);
        const int nn = d.nbase + d.n0 + n; const int drow = (d.mode ? (256 * (nn >> 7) + (nn & 127)) : nn) + d.rowoff;
        *(u32x4*)(d.WT + (size_t)drow * d.ldt + d.kofs + d.k0 + 8 * c) = o; }
    LDS_WAIT(); asm volatile("" ::: "memory");
}
constexpr int I_IN = 16 * 144, I_AO = 8 * 32, I_OUT = 16 * 32, I_PP = 4 * 32, I_EG = 16 * 16 * 16, I_ED = 16 * 8 * 32, I_RG = 16;
constexpr int TR_NITEMS = I_IN + 2 * I_AO + 2 * I_OUT + 2 * I_EG + I_ED + 2 * I_RG;
constexpr int TR_S1 = 5400, TR_S2 = 11000;
struct Frame;
__device__ __forceinline__ void tr_decode(const Frame& F, int L, int it, TrDesc& d);

__device__ __forceinline__ void route_tables(Frame& F, int L, int first, int stride) {
    const float* wrg = inp(F, 15) + (size_t)L * D * 4; const float* wre = inp(F, 17) + (size_t)L * D * 16; const float* gm = inp(F, 14) + L * D;
    unsigned char* img = F.ws + WS_RTAB + (size_t)(L & 1) * 81920;
    for (int en = first * 64 + F.lane; en < 32 * 64 + 32 * 16; en += stride * 64) {
        int ks, kg, n; unsigned char *ph, *pl;
        if (en < 2048) { ks = en >> 6; const int l = en & 63; kg = l >> 4; n = l & 15; ph = img + en * 16; pl = img + 32768 + en * 16; }
        else { const int r = en - 2048; ks = r >> 4; kg = (r >> 2) & 3; n = 16 + (r & 3); ph = img + 65536 + r * 16; pl = img + 65536 + 8192 + r * 16; }
        const int k0 = 32 * ks + 8 * kg; float v[8];
#pragma unroll
        for (int j = 0; j < 8; ++j) { const int k = k0 + j; const float w = (n < 4) ? wrg[k * 4 + n] : wre[k * 16 + (n - 4)]; v[j] = w * gm[k]; }
        unsigned hw[4];
#pragma unroll
        for (int j = 0; j < 4; ++j) hw[j] = cvt_pk_bf16(v[2 * j], v[2 * j + 1]);
        u32x4 lo;
        lo.x = cvt_pk_bf16(v[0] - bflo(hw[0]), v[1] - bfhi(hw[0])); lo.y = cvt_pk_bf16(v[2] - bflo(hw[1]), v[3] - bfhi(hw[1]));
        lo.z = cvt_pk_bf16(v[4] - bflo(hw[2]), v[5] - bfhi(hw[2])); lo.w = cvt_pk_bf16(v[6] - bflo(hw[3]), v[7] - bfhi(hw[3]));
        *(u32x4*)ph = (u32x4){hw[0], hw[1], hw[2], hw[3]}; *(u32x4*)pl = lo; }
}
__device__ __forceinline__ void prep_weights(Frame& F, int L, int it_lo, int it_hi, int first, int stride) {
    LAS float* scr = (LAS float*)(F.lds + F.wave * 9216);
    LAS float* gains = (LAS float*)(F.lds + 8 * 9216);
    const int lane = F.lane; unsigned char* ws = F.ws;
    { const float* g1 = inp(F, 2) + L * D; const float* g2 = inp(F, 14) + L * D; const float* g3 = inp(F, 22) + L * D;
      __syncthreads();
      for (int i = F.tid; i < 1024; i += 512) { gains[i] = 1.0f; gains[1024 + i] = g1[i]; gains[2048 + i] = g2[i]; gains[3072 + i] = g3[i]; }
      __syncthreads(); }
    { int it = it_lo + first; TrDesc d, dn; f32x4 v[8], vn[8]; const int nitems = it_hi;
      if (it < nitems) { tr_decode(F, L, it, d); tr_load(d, lane, v); }
      while (it < nitems) { const int itn = it + stride;
          if (itn < nitems) { tr_decode(F, L, itn, dn); tr_load(dn, lane, vn); }
          tr_store(d, lane, v, scr, gains);
          d = dn;
#pragma unroll
          for (int i = 0; i < 8; ++i) v[i] = vn[i];
          it = itn; } }
    if (it_lo == 0) for (int row = first; row < 1024; row += stride) { const int g = (((row >> 8) * 128) + (row & 127)) >> 6;
        if ((lane >> 3) != g) *(u32x4*)((bf16_t*)(ws + WOFF(L) + WS_WGT) + (size_t)row * DR + 8 * lane) = zero4(); }
    if (it_lo == 0) route_tables(F, L, first, stride);
    if (it_lo == 0 && first == 0) { float* cA = (float*)(ws + WS_MISC + 196608 + (L & 1) * 2048); const float* lam = inp(F, 10) + L * DR;
        for (int c = lane; c < DR; c += 64) { const float l = lam[c]; const float sp = (l > 0.f) ? log1pf(expf(-l)) : (-l + log1pf(expf(l))); cA[c] = -8.0f * sp; } }
    __syncthreads();
}
__device__ __forceinline__ void prep_phase(Frame& F) {
    const int gw = F.bid * 8 + F.wave, NGW = F.G * 8, lane = F.lane;
    unsigned char* ws = F.ws;
    prep_weights(F, 0, 0, TR_NITEMS + 4 * I_PP, gw, NGW);
    { const float* x = inp(F, 0); bf16_t* xb = (bf16_t*)(ws + WS_XBW); float* SSQ = (float*)(ws + WS_SSQ);
      for (int m = gw; m < T; m += NGW) { const f32x4* xr = (const f32x4*)(x + (size_t)m * D) + lane; f32x4 v[4]; float s = 0.f;
#pragma unroll
          for (int j = 0; j < 4; ++j) { v[j] = xr[64 * j]; s += (v[j][0] * v[j][0] + v[j][1] * v[j][1]) + (v[j][2] * v[j][2] + v[j][3] * v[j][3]); }
          s = wave_sum(s); if (lane < 16) SSQ[(size_t)m * 16 + lane] = (lane == 0) ? s : 0.f;
          u32x2* o = (u32x2*)(xb + (size_t)m * D) + lane;
#pragma unroll
          for (int j = 0; j < 4; ++j) { u32x2 w; w.x = cvt_pk_bf16(v[j][0], v[j][1]); w.y = cvt_pk_bf16(v[j][2], v[j][3]); o[64 * j] = w; } } }
    { const float* p = inp(F, 1); bf16_t* pb = (bf16_t*)(ws + WS_PB); const size_t n8 = (size_t)DEPTH * T * PLED / 8;
        for (size_t i = (size_t)F.bid * 512 + F.tid; i < n8; i += (size_t)F.G * 512) { const f32x4 a = *(const f32x4*)(p + i * 8), b = *(const f32x4*)(p + i * 8 + 4);
            u32x4 w; w.x = cvt_pk_bf16(a[0], a[1]); w.y = cvt_pk_bf16(a[2], a[3]); w.z = cvt_pk_bf16(b[0], b[1]); w.w = cvt_pk_bf16(b[2], b[3]); *(u32x4*)(pb + i * 8) = w; } }
}
__device__ __forceinline__ void tr_decode(const Frame& F, int L, int it, TrDesc& d) {
    unsigned char* ws = F.ws; int r = it;
    d.kofs = 0; d.nbase = 0; d.mode = 0; d.rowoff = 0; d.gsel = 0;
    int nblk;
    if (r < I_IN) { d.W = inp(F, 3) + (size_t)L * D * NIN; d.N = NIN; d.WT = (bf16_t*)(ws + WOFF(L) + WS_WIN); d.ldt = D; d.gsel = 1; nblk = 144; }
    else if ((r -= I_IN) < I_AO) { d.W = inp(F, 11) + (size_t)L * DA * D; d.N = D; d.WT = (bf16_t*)(ws + WOFF(L) + WS_WAO); d.ldt = D; nblk = 32; }
    else if ((r -= I_AO) < I_AO) { d.W = inp(F, 12) + (size_t)L * DR * D; d.N = D; d.WT = (bf16_t*)(ws + WOFF(L) + WS_WAO); d.ldt = D; d.kofs = DA; nblk = 32; }
    else if ((r -= I_AO) < I_OUT) { d.W = inp(F, 13) + (size_t)L * D * D; d.N = D; d.WT = (bf16_t*)(ws + WOFF(L) + WS_WOUT); d.ldt = D; nblk = 32; }
    else if ((r -= I_OUT) < I_OUT) { d.W = inp(F, 23) + (size_t)L * D * D; d.N = D; d.WT = (bf16_t*)(ws + WS_WPGL) + (size_t)L * D * D; d.ldt = D; d.gsel = 3; nblk = 32; }
    else if ((r -= I_OUT) < I_EG) { const int e = r >> 8; r &= 255; d.W = inp(F, 19) + ((size_t)L * NE + e) * D * DE; d.N = DE; d.WT = (bf16_t*)(ws + WOFF(L) + WS_WGU) + (size_t)e * 1024 * 1024; d.ldt = D; d.mode = 1; d.gsel = 2; nblk = 16; }
    else if ((r -= I_EG) < I_EG) { const int e = r >> 8; r &= 255; d.W = inp(F, 20) + ((size_t)L * NE + e) * D * DE; d.N = DE; d.WT = (bf16_t*)(ws + WOFF(L) + WS_WGU) + (size_t)e * 1024 * 1024; d.ldt = D; d.mode = 1; d.rowoff = 128; d.gsel = 2; nblk = 16; }
    else if ((r -= I_EG) < I_ED) { const int e = r >> 8; r &= 255; d.W = inp(F, 21) + ((size_t)L * NE + e) * DE * D; d.N = D; d.WT = (bf16_t*)(ws + WOFF(L) + WS_WDN) + (size_t)e * 1024 * 512; d.ldt = DE; nblk = 32; }
    else if ((r -= I_ED) < I_RG) { const int g = r >> 1; r &= 1; d.W = inp(F, 6) + ((size_t)L * 8 + g) * 4096; d.N = 64; d.WT = (bf16_t*)(ws + WOFF(L) + WS_WGT); d.ldt = DR; d.kofs = 64 * g; d.nbase = 64 * g; d.mode = 1; nblk = 2; }
    else if ((r -= I_RG) < I_RG) { const int g = r >> 1; r &= 1; d.W = inp(F, 8) + ((size_t)L * 8 + g) * 4096; d.N = 64; d.WT = (bf16_t*)(ws + WOFF(L) + WS_WGT); d.ldt = DR; d.kofs = 64 * g; d.nbase = 64 * g; d.mode = 1; d.rowoff = 128; nblk = 2; }
    else { r -= I_RG; const int l = r / I_PP; r -= l * I_PP; d.W = inp(F, 24) + (size_t)l * PLED * D; d.N = D; d.WT = (bf16_t*)(ws + WS_WPP) + (size_t)l * 1024 * PLED; d.ldt = PLED; nblk = 32; }
    d.k0 = 64 * (r / nblk); d.n0 = 32 * (r % nblk);
}

__device__ __forceinline__ void conv_phase(Frame& F, int L) {
    const bf16_t* XR = (const bf16_t*)(F.ws + WS_XR); bf16_t* XC = (bf16_t*)(F.ws + WS_XC);
    const float* cw = inp(F, 4) + (size_t)L * 4 * DR; const float* cb = inp(F, 5) + L * DR;
    const int c0 = (F.tid & 63) * 8;
    float w[4][8], bsv[8];
#pragma unroll
    for (int q = 0; q < 8; ++q) { bsv[q] = cb[c0 + q];
#pragma unroll
        for (int j = 0; j < 4; ++j) w[j][q] = cw[j * DR + c0 + q]; }
    const XSpan sp = xspan(F.G, F.bid, T / 64);
    for (int it = sp.first; it < sp.count; it += sp.stride) { const int task = (sp.base + it) * 8 + (F.tid >> 6); const int t0 = task * 8, ts0 = t0 & (SEQ - 1);
        u32x4 xw[11];
#pragma unroll
        for (int i = 0; i < 11; ++i) xw[i] = (ts0 - 3 + i >= 0) ? *(const u32x4*)(XR + (size_t)(t0 - 3 + i) * DR + c0) : zero4();
#pragma unroll
        for (int r = 0; r < 8; ++r) { float o[8];
#pragma unroll
            for (int q = 0; q < 8; ++q) o[q] = bsv[q];
#pragma unroll
            for (int j = 0; j < 4; ++j) { const u32x4 z = xw[r + j];
                const float xv[8] = {bflo(z.x), bfhi(z.x), bflo(z.y), bfhi(z.y), bflo(z.z), bfhi(z.z), bflo(z.w), bfhi(z.w)};
#pragma unroll
                for (int q = 0; q < 8; ++q) o[q] += w[j][q] * xv[q]; }
            u32x4 ow; ow.x = cvt_pk_bf16(o[0], o[1]); ow.y = cvt_pk_bf16(o[2], o[3]); ow.z = cvt_pk_bf16(o[4], o[5]); ow.w = cvt_pk_bf16(o[6], o[7]);
            *(u32x4*)(XC + (size_t)(t0 + r) * DR + c0) = ow; } }
}

__device__ __forceinline__ void attn_unit(const bf16_t* Q, const bf16_t* K, const bf16_t* VT, bf16_t* O, int b, int h, int jb, int lane) {
    const int r32 = lane & 31, hi = lane >> 5;
    const size_t rowb = (size_t)b * SEQ; const int q0 = jb * 32;
    bf16x8 qr[4];
    const size_t hb = ((size_t)b * NHEAD + h) * SEQ;
    const bf16_t* VTh = VT + ((size_t)b * NHEAD + h) * (SEQ / 32) * 2048;
    { const bf16_t* qp = Q + (hb + q0 + r32) * 64 + hi * 8;
#pragma unroll
      for (int d0 = 0; d0 < 4; ++d0) qr[d0] = *(const bf16x8*)(qp + 16 * d0); }
    f32x16 o0, o1;
#pragma unroll
    for (int r = 0; r < 16; ++r) { o0[r] = 0.f; o1[r] = 0.f; }
    float Pc = 1.0f;
    bf16x8 kfn[4], vfn[2][2];
#define ATT_LOAD(kb_) do { const bf16_t* kp_ = K + (hb + (kb_) + r32) * 64 + hi * 8; \
        _Pragma("unroll") for (int d0 = 0; d0 < 4; ++d0) kfn[d0] = *(const bf16x8*)(kp_ + 16 * d0); \
        const bf16_t* vp_ = VTh + (size_t)((kb_) >> 5) * 2048 + r32 * 32 + 8 * hi; \
        _Pragma("unroll") for (int s = 0; s < 2; ++s) _Pragma("unroll") for (int db = 0; db < 2; ++db) vfn[s][db] = *(const bf16x8*)(vp_ + db * 1024 + 16 * s); } while (0)
    ATT_LOAD(q0);
    for (int kb = q0; kb >= 0; kb -= 32) {
        bf16x8 kf[4], vf[2][2];
#pragma unroll
        for (int d0 = 0; d0 < 4; ++d0) kf[d0] = kfn[d0];
#pragma unroll
        for (int s = 0; s < 2; ++s)
#pragma unroll
            for (int db = 0; db < 2; ++db) vf[s][db] = vfn[s][db];
        if (kb >= 32) ATT_LOAD(kb - 32);
        f32x16 p;
#pragma unroll
        for (int r = 0; r < 16; ++r) p[r] = 0.f;
#pragma unroll
        for (int d0 = 0; d0 < 4; ++d0) p = __builtin_amdgcn_mfma_f32_32x32x16_bf16(kf[d0], qr[d0], p, 0, 0, 0);
        float rr[16], be[16];
        const bool diag = (kb == q0);
#pragma unroll
        for (int r = 0; r < 16; ++r) { const int kr = (r & 3) + 8 * (r >> 2) + 4 * hi;
            const float e = fexp2(p[r]); const float t = frcp(1.0f + e);
            const bool valid = (!diag) || (kr < r32);
            rr[r] = valid ? t : 1.0f; be[r] = valid ? (1.0f - t) : 0.0f; }
        float sfx[16], Gg[4];
#pragma unroll
        for (int g = 0; g < 4; ++g) { sfx[4 * g + 3] = 1.0f; sfx[4 * g + 2] = rr[4 * g + 3]; sfx[4 * g + 1] = sfx[4 * g + 2] * rr[4 * g + 2]; sfx[4 * g] = sfx[4 * g + 1] * rr[4 * g + 1]; Gg[g] = sfx[4 * g] * rr[4 * g]; }
        float Gl[4], Gh[4];
#pragma unroll
        for (int g = 0; g < 4; ++g) { const unsigned gb = __float_as_uint(Gg[g]); auto x = __builtin_amdgcn_permlane32_swap(gb, gb, false, false); Gl[g] = __uint_as_float(x[0]); Gh[g] = __uint_as_float(x[1]); }
        float Eh[4], El[4]; float c = Pc;
#pragma unroll
        for (int g = 3; g >= 0; --g) { Eh[g] = c; c *= Gh[g]; El[g] = c; c *= Gl[g]; }
        Pc = c;
        float w[16];
#pragma unroll
        for (int g = 0; g < 4; ++g) { const float Eg = hi ? Eh[g] : El[g];
#pragma unroll
            for (int cc = 0; cc < 4; ++cc) w[4 * g + cc] = be[4 * g + cc] * (sfx[4 * g + cc] * Eg); }
        u32x4 w0, w1;
        w0.x = cvt_pk_bf16(w[0], w[1]); w0.y = cvt_pk_bf16(w[2], w[3]); w0.z = cvt_pk_bf16(w[4], w[5]); w0.w = cvt_pk_bf16(w[6], w[7]);
        w1.x = cvt_pk_bf16(w[8], w[9]); w1.y = cvt_pk_bf16(w[10], w[11]); w1.z = cvt_pk_bf16(w[12], w[13]); w1.w = cvt_pk_bf16(w[14], w[15]);
        const bf16x8 wf0 = __builtin_bit_cast(bf16x8, w0), wf1 = __builtin_bit_cast(bf16x8, w1);
        o0 = __builtin_amdgcn_mfma_f32_32x32x16_bf16(vf[0][0], wf0, o0, 0, 0, 0);
        o1 = __builtin_amdgcn_mfma_f32_32x32x16_bf16(vf[0][1], wf0, o1, 0, 0, 0);
        o0 = __builtin_amdgcn_mfma_f32_32x32x16_bf16(vf[1][0], wf1, o0, 0, 0, 0);
        o1 = __builtin_amdgcn_mfma_f32_32x32x16_bf16(vf[1][1], wf1, o1, 0, 0, 0);
        if (__all(Pc < 1e-30f)) break;
    }
#undef ATT_LOAD
    bf16_t* op = O + (rowb + q0 + r32) * D + h * 64 + 4 * hi;
#pragma unroll
    for (int g = 0; g < 4; ++g) { u32x2 a, b2; a.x = cvt_pk_bf16(o0[4 * g], o0[4 * g + 1]); a.y = cvt_pk_bf16(o0[4 * g + 2], o0[4 * g + 3]); b2.x = cvt_pk_bf16(o1[4 * g], o1[4 * g + 1]); b2.y = cvt_pk_bf16(o1[4 * g + 2], o1[4 * g + 3]);
        *(u32x2*)(op + 8 * g) = a; *(u32x2*)(op + 32 + 8 * g) = b2; }
}
__device__ __forceinline__ void attn_phase(Frame& F) {
    const bf16_t* Q = (const bf16_t*)(F.ws + WS_Q); const bf16_t* K = (const bf16_t*)(F.ws + WS_K); const bf16_t* VT = (const bf16_t*)(F.ws + WS_VT); bf16_t* O = (bf16_t*)(F.ws + WS_AO);
    const bool pl = (F.G & 7) == 0 && NB * 2 == 8;
    const int first = pl ? (F.bid >> 3) * 8 + F.wave : F.bid * 8 + F.wave, stride = pl ? (F.G >> 3) * 8 : F.G * 8, count = pl ? NHEAD * (SEQ / 64) : NB * NHEAD * (SEQ / 32);
    for (int u = first; u < count; u += stride) {
        const int jb = pl ? (F.bid & 1) * (SEQ / 64) + (u & (SEQ / 64 - 1)) : (u & 127), bh = pl ? ((F.bid & 7) >> 1) * NHEAD + u / (SEQ / 64) : (u >> 7);
        attn_unit(Q, K, VT, O, bh >> 3, bh & 7, jb, F.lane); }
}

__device__ __forceinline__ void scan1_unit(Frame& F, int b, int ck, int cg) {
    const unsigned* DB = (const unsigned*)(F.ws + WS_DB); float* SA = (float*)(F.ws + WS_SUM); float* SH = SA + NB * 64 * DR;
    const int c = cg * 64 + F.lane; const size_t r0 = (size_t)b * SEQ + ck * 64;
    unsigned w[64];
#pragma unroll
    for (int t = 0; t < 64; ++t) w[t] = DB[(r0 + t) * DR + c];
    float A = 1.f, H = 0.f;
#pragma unroll
    for (int t = 0; t < 64; ++t) { const float a = 1.0f - bflo(w[t]); A *= a; H = a * H + bfhi(w[t]); }
    SA[(size_t)(b * 64 + ck) * DR + c] = A; SH[(size_t)(b * 64 + ck) * DR + c] = H;
}
__device__ __forceinline__ void scan2_phase(Frame& F) {
    const unsigned* DB = (const unsigned*)(F.ws + WS_DB); const float* SA = (const float*)(F.ws + WS_SUM); const float* SH = SA + NB * 64 * DR;
    const bf16_t* XG = (const bf16_t*)(F.ws + WS_XG); bf16_t* RI = (bf16_t*)(F.ws + WS_AO);
    LAS bf16_t* stg = (LAS bf16_t*)(F.lds + F.wave * 9216);
    const int lane = F.lane; const XSpan sp = xspan(F.G, F.bid, NB * 64);
    for (int it = sp.first; it < sp.count; it += sp.stride) { const int u = (sp.base + it) * 8 + F.wave; const int cg = u & 7, ck = (u >> 3) & 63, b = u >> 9; const int c = cg * 64 + lane; const size_t r0 = (size_t)b * SEQ + ck * 64;
        unsigned w[64]; u32x4 xg[8]; const int tr = lane >> 3, cq = (lane & 7) * 8;
#pragma unroll
        for (int t = 0; t < 64; ++t) w[t] = DB[(r0 + t) * DR + c];
#pragma unroll
        for (int i = 0; i < 8; ++i) xg[i] = *(const u32x4*)(XG + (r0 + tr + 8 * i) * DR + cg * 64 + cq);
        float H = 0.f;
        { const float* sa = SA + (size_t)(b * 64) * DR + c; const float* sh = SH + (size_t)(b * 64) * DR + c;
          for (int j0 = 0; j0 < ck; j0 += 32) { float ta[32], th[32];
#pragma unroll
              for (int j = 0; j < 32; ++j) { const int jj = (j0 + j < ck) ? (j0 + j) : 0; ta[j] = sa[(size_t)jj * DR]; th[j] = sh[(size_t)jj * DR]; }
#pragma unroll
              for (int j = 0; j < 32; ++j) if (j0 + j < ck) H = ta[j] * H + th[j]; } }
        {
#pragma unroll
          for (int i = 0; i < 8; ++i) *(LAS u32x4*)(stg + (tr + 8 * i) * 72 + cq) = xg[i];
          LDS_WAIT(); asm volatile("" ::: "memory"); }
#pragma unroll
        for (int t = 0; t < 64; ++t) { const float a = 1.0f - bflo(w[t]); H = a * H + bfhi(w[t]);
            const float g = bf2f(stg[t * 72 + lane]); stg[t * 72 + lane] = (bf16_t)(cvt_pk_bf16(H * g, 0.f) & 0xffffu); }
        LDS_WAIT(); asm volatile("" ::: "memory");
        {
#pragma unroll
          for (int i = 0; i < 8; ++i) { const u32x4 o = *(const LAS u32x4*)(stg + (tr + 8 * i) * 72 + cq); *(u32x4*)(RI + (r0 + tr + 8 * i) * D + DA + cg * 64 + cq) = o; }
          LDS_WAIT(); asm volatile("" ::: "memory"); } }
}

__device__ __forceinline__ void route_load_tables(Frame& F, int L) {
    const int tid = F.tid;
    const u32x4* srcp = (const u32x4*)(F.ws + WS_RTAB + (size_t)(L & 1) * 81920); u32x4 tv[10];
#pragma unroll
    for (int i = 0; i < 10; ++i) tv[i] = srcp[tid + 512 * i];
#pragma unroll
    for (int i = 0; i < 10; ++i) *(LAS u32x4*)(F.lds + (tid + 512 * i) * 16) = tv[i];
}
__device__ __forceinline__ void route_phase(Frame& F, int L, int CL) {
    LAS unsigned char* T0h = F.lds;
    LAS unsigned char* T0l = F.lds + 32768;
    LAS unsigned char* T1h = F.lds + 65536;
    LAS unsigned char* T1l = F.lds + 65536 + 8192;
    LAS int* cnt = (LAS int*)(F.lds + 81920); LAS int* bas = cnt + 16; LAS float* tinfo = (LAS float*)(F.lds + 81920 + 128);
    LAS float* lgs0 = (LAS float*)(F.lds + 86016); LAS float* lgs = lgs0 + F.wave * 528;
    const float* wrg = inp(F, 15) + (size_t)L * D * 4; const float* brg = inp(F, 16) + L * 4; const float* wre = inp(F, 17) + (size_t)L * D * 16; const float* bre = inp(F, 18) + L * 16;
    const float* gm = inp(F, 14) + L * D; const float* x = F.out;
    bf16_t* xb = (bf16_t*)(F.ws + WS_XB); unsigned* TOK = (unsigned*)(F.ws + WS_TOK); float* WLs = (float*)(F.ws + WS_WL); float* RS = (float*)(F.ws + WS_RS);
    unsigned* gcnt = F.ctl + CW_CNT + CL * 16 * 64;
    const int lane = F.lane, tid = F.tid;
    const int row = lane & 15, kg = lane >> 4;
    const XSpan sp = xspan(F.G, F.bid, T / 64);
    for (int it = sp.first; it < sp.count; it += sp.stride) { const int blk = sp.base + it;
        if (tid < 16) cnt[tid] = 0;
        __syncthreads();
        const int t0 = blk * 64 + (F.wave & 3) * 16;
        const float* xp = x + (size_t)(t0 + row) * D + 8 * kg;
        bf16_t* xbp = xb + (size_t)(t0 + row) * D + 8 * kg;
        f32x4 acc0 = {0.f, 0.f, 0.f, 0.f}, acc1 = {0.f, 0.f, 0.f, 0.f}; float ss = 0.f;
        { const int ks0 = (F.wave >> 2) * 16;
            f32x4 xa[16], xc[16];
#pragma unroll
            for (int i = 0; i < 16; ++i) { xa[i] = *(const f32x4*)(xp + 32 * (ks0 + i)); xc[i] = *(const f32x4*)(xp + 32 * (ks0 + i) + 4); }
#pragma unroll
            for (int i = 0; i < 16; ++i) { const int ks = ks0 + i; const f32x4 a = xa[i], c = xc[i];
                ss += ((a[0] * a[0] + a[1] * a[1]) + (a[2] * a[2] + a[3] * a[3])) + ((c[0] * c[0] + c[1] * c[1]) + (c[2] * c[2] + c[3] * c[3]));
                u32x4 h; h.x = cvt_pk_bf16(a[0], a[1]); h.y = cvt_pk_bf16(a[2], a[3]); h.z = cvt_pk_bf16(c[0], c[1]); h.w = cvt_pk_bf16(c[2], c[3]);
                u32x4 l; l.x = cvt_pk_bf16(a[0] - bflo(h.x), a[1] - bfhi(h.x)); l.y = cvt_pk_bf16(a[2] - bflo(h.y), a[3] - bfhi(h.y));
                l.z = cvt_pk_bf16(c[0] - bflo(h.z), c[1] - bfhi(h.z)); l.w = cvt_pk_bf16(c[2] - bflo(h.w), c[3] - bfhi(h.w));
                *(u32x4*)(xbp + 32 * ks) = h;
                const bf16x8 ah = __builtin_bit_cast(bf16x8, h), al = __builtin_bit_cast(bf16x8, l);
                const bf16x8 b0h = *(const LAS bf16x8*)(T0h + (ks * 64 + lane) * 16), b0l = *(const LAS bf16x8*)(T0l + (ks * 64 + lane) * 16);
                const int o1 = (ks * 16 + kg * 4 + (row & 3)) * 16;
                const bf16x8 b1h = *(const LAS bf16x8*)(T1h + o1), b1l = *(const LAS bf16x8*)(T1l + o1);
                acc0 = __builtin_amdgcn_mfma_f32_16x16x32_bf16(ah, b0h, acc0, 0, 0, 0); acc0 = __builtin_amdgcn_mfma_f32_16x16x32_bf16(ah, b0l, acc0, 0, 0, 0); acc0 = __builtin_amdgcn_mfma_f32_16x16x32_bf16(al, b0h, acc0, 0, 0, 0);
                acc1 = __builtin_amdgcn_mfma_f32_16x16x32_bf16(ah, b1h, acc1, 0, 0, 0); acc1 = __builtin_amdgcn_mfma_f32_16x16x32_bf16(ah, b1l, acc1, 0, 0, 0); acc1 = __builtin_amdgcn_mfma_f32_16x16x32_bf16(al, b1h, acc1, 0, 0, 0); }
        }
        ss += __shfl_xor(ss, 16); ss += __shfl_xor(ss, 32);
        {
#pragma unroll
            for (int i = 0; i < 4; ++i) { lgs[(4 * kg + i) * 32 + row] = acc0[i]; if (row < 4) lgs[(4 * kg + i) * 32 + 16 + row] = acc1[i]; } }
        if (lane < 16) lgs[512 + lane] = ss;
        __syncthreads();
        if (tid < 64) { const int tk = tid;
            const LAS float* lr = lgs0 + (tk >> 4) * 528 + (tk & 15) * 32; const LAS float* lr2 = lr + 4 * 528;
            const float rstd = 1.0f / sqrtf((lgs0[(tk >> 4) * 528 + 512 + (tk & 15)] + lgs0[((tk >> 4) + 4) * 528 + 512 + (tk & 15)]) * (1.0f / D) + EPS);
            float lg[4];
#pragma unroll
            for (int j = 0; j < 4; ++j) lg[j] = rstd * (lr[j] + lr2[j]) + brg[j];
            int gi = 0; float gmx = lg[0];
#pragma unroll
            for (int j = 1; j < 4; ++j) if (lg[j] > gmx) { gmx = lg[j]; gi = j; }
            float den = 0.f;
#pragma unroll
            for (int j = 0; j < 4; ++j) den += expf(lg[j] - gmx);
            const float gate_group = 1.0f / den;
            float sel[4];
#pragma unroll
            for (int i = 0; i < 4; ++i) sel[i] = rstd * (lr[4 + gi * 4 + i] + lr2[4 + gi * 4 + i]) + bre[gi * 4 + i];
            int i1 = 0; float v1 = sel[0];
#pragma unroll
            for (int i = 1; i < 4; ++i) if (sel[i] > v1) { v1 = sel[i]; i1 = i; }
            int i2 = -1; float v2 = 0.f;
#pragma unroll
            for (int i = 0; i < 4; ++i) if (i != i1 && (i2 < 0 || sel[i] > v2)) { v2 = sel[i]; i2 = i; }
            const float ex = expf(v2 - v1); const float w1 = 1.0f / (1.0f + ex), w2 = ex / (1.0f + ex);
            const int e1 = gi * 4 + i1, e2 = gi * 4 + i2;
            const int p1 = __hip_atomic_fetch_add(cnt + e1, 1, __ATOMIC_RELAXED, __HIP_MEMORY_SCOPE_WORKGROUP);
            const int p2 = __hip_atomic_fetch_add(cnt + e2, 1, __ATOMIC_RELAXED, __HIP_MEMORY_SCOPE_WORKGROUP);
            LAS float* ti = tinfo + tk * 8;
            ti[0] = __int_as_float(e1); ti[1] = __int_as_float(p1); ti[2] = gate_group * w1; ti[3] = __int_as_float(e2); ti[4] = __int_as_float(p2); ti[5] = gate_group * w2; ti[6] = rstd; }
        __syncthreads();
        if (tid < 16) { const int c = cnt[tid]; int b0 = 0; if (c > 0) b0 = (int)__hip_atomic_fetch_add(gcnt + tid * 64, (unsigned)c, __ATOMIC_RELAXED, __HIP_MEMORY_SCOPE_AGENT); bas[tid] = b0; }
        __syncthreads();
        if (tid < 64) { const LAS float* ti = tinfo + tid * 8; const int t = blk * 64 + tid;
            const int e1 = __float_as_int(ti[0]), p1 = __float_as_int(ti[1]), e2 = __float_as_int(ti[3]), p2 = __float_as_int(ti[4]);
            const size_t i1 = (size_t)e1 * LCAP + bas[e1] + p1, i2 = (size_t)e2 * LCAP + bas[e2] + p2;
            TOK[i1] = (unsigned)t; WLs[i1] = ti[2]; RS[i1] = ti[6];
            TOK[i2] = (unsigned)t | 0x80000000u; WLs[i2] = ti[5]; RS[i2] = ti[6]; }
        __syncthreads();
    }
}
__device__ __forceinline__ void group_table(Frame& F, int L) {
    LAS int* tab = (LAS int*)(F.lds + TSTART_OFF);
    if (F.tid < 16) tab[17 + F.tid] = (int)__hip_atomic_load(F.ctl + CW_CNT + (L * 16 + F.tid) * 64, __ATOMIC_RELAXED, __HIP_MEMORY_SCOPE_AGENT);
    __syncthreads();
    if (F.tid == 0) { int a = 0;
        for (int e = 0; e < 16; ++e) { tab[e] = a; a += (tab[17 + e] + 255) >> 8; }
        tab[16] = a; }
    __syncthreads();
}
__device__ __forceinline__ void s3_phase(Frame& F) {
    float* x = F.out; const bf16_t* Y0 = (const bf16_t*)(F.ws + WS_Y0); const bf16_t* Y1 = (const bf16_t*)(F.ws + WS_Y1); bf16_t* xb = (bf16_t*)(F.ws + WS_XB); float* rstd3 = (float*)(F.ws + WS_MISC + 131072);
    const int lane = F.lane; const XSpan sp = xspan(F.G, F.bid, T / 64);
    for (int it2 = 2 * sp.first; it2 < 2 * sp.count; it2 += ((it2 & 1) ? 2 * sp.stride - 1 : 1)) {
        const int m0 = (sp.base + (it2 >> 1)) * 64 + F.wave * 8 + (it2 & 1) * 4;
        f32x4 v[4][4]; u32x2 ya[4][4], yb[4][4];
#pragma unroll
        for (int r = 0; r < 4; ++r) { const int m = m0 + r; {
#pragma unroll
            for (int j = 0; j < 4; ++j) { v[r][j] = ((const f32x4*)(x + (size_t)m * D) + lane)[64 * j]; ya[r][j] = ((const u32x2*)(Y0 + (size_t)m * D) + lane)[64 * j]; yb[r][j] = ((const u32x2*)(Y1 + (size_t)m * D) + lane)[64 * j]; } } }
#pragma unroll
        for (int r = 0; r < 4; ++r) { const int m = m0 + r; { float s = 0.f;
#pragma unroll
            for (int j = 0; j < 4; ++j) { const u32x2 a = ya[r][j], b = yb[r][j]; f32x4 t = v[r][j];
                t[0] += bflo(a.x) + bflo(b.x); t[1] += bfhi(a.x) + bfhi(b.x); t[2] += bflo(a.y) + bflo(b.y); t[3] += bfhi(a.y) + bfhi(b.y);
                v[r][j] = t; s += (t[0] * t[0] + t[1] * t[1]) + (t[2] * t[2] + t[3] * t[3]); }
            s = wave_sum(s); if (lane == 0) rstd3[m] = 1.0f / sqrtf(s * (1.0f / D) + EPS);
            f32x4* xr = (f32x4*)(x + (size_t)m * D) + lane; u32x2* o = (u32x2*)(xb + (size_t)m * D) + lane;
#pragma unroll
            for (int j = 0; j < 4; ++j) { xr[64 * j] = v[r][j]; u32x2 w; w.x = cvt_pk_bf16(v[r][j][0], v[r][j][1]); w.y = cvt_pk_bf16(v[r][j][2], v[r][j][3]); o[64 * j] = w; } } } }
}
__device__ __forceinline__ void final_phase(Frame& F) {
    float* x = F.out; const float* g = inp(F, 25);
    const int lane = F.lane;
    f32x4 gg[4];
#pragma unroll
    for (int j = 0; j < 4; ++j) gg[j] = *((const f32x4*)g + lane + 64 * j);
    const XSpan sp = xspan(F.G, F.bid, T / 64);
    for (int it2 = 2 * sp.first; it2 < 2 * sp.count; it2 += ((it2 & 1) ? 2 * sp.stride - 1 : 1)) { f32x4 v[4][4];
        const int m0 = (sp.base + (it2 >> 1)) * 64 + F.wave * 8 + (it2 & 1) * 4;
#pragma unroll
        for (int r = 0; r < 4; ++r) { const int m = m0 + r; {
#pragma unroll
            for (int j = 0; j < 4; ++j) v[r][j] = ((const f32x4*)(x + (size_t)m * D) + lane)[64 * j]; } }
#pragma unroll
        for (int r = 0; r < 4; ++r) { const int m = m0 + r; { float s = 0.f;
#pragma unroll
            for (int j = 0; j < 4; ++j) s += (v[r][j][0] * v[r][j][0] + v[r][j][1] * v[r][j][1]) + (v[r][j][2] * v[r][j][2] + v[r][j][3] * v[r][j][3]);
            const float rs = 1.0f / sqrtf(wave_sum(s) * (1.0f / D) + EPS); f32x4* xr = (f32x4*)(x + (size_t)m * D) + lane;
#pragma unroll
            for (int j = 0; j < 4; ++j) xr[64 * j] = v[r][j] * rs * gg[j]; } } }
}

constexpr int NPH = 13;
constexpr int PH_TOTAL = DEPTH * NPH + 1;
__global__ void __launch_bounds__(512, 2) trunk_fwd(Args args) {
    extern __shared__ __attribute__((aligned(16))) unsigned char lds[];
    Frame F;
    F.lds = (LAS unsigned char*)lds; F.ws = args.ws; F.ctl = (unsigned*)(args.ws + WS_CTL); F.out = args.out;
    F.tid = threadIdx.x; F.lane = F.tid & 63; F.wave = __builtin_amdgcn_readfirstlane(F.tid >> 6); F.G = gridDim.x;
    F.bid = blockIdx.x;
    const int wave0 = F.wave, grid0 = gridDim.x; int bid0 = blockIdx.x; bool xloc = false;
    for (int u = F.tid; u < (LDS_BYTES - LDSCTL_OFF) / 4; u += 512) ((LAS unsigned*)(F.lds + LDSCTL_OFF))[u] = 0u;
    __syncthreads();
    if (F.tid < 26) ((LAS unsigned long long*)(F.lds + PTAB_OFF))[F.tid] = (unsigned long long)args.in[F.tid];
    __syncthreads();
    XcdBarrier bar; bar.bar = F.ctl + CW_BAR; bar.x = 0; bar.st = nullptr;
#if MK_N_LAUNCHES == 1
    { volatile LAS unsigned* st = (volatile LAS unsigned*)(F.lds + MISC_OFF) + 8; unsigned* bw = F.ctl + CW_BAR;
      bar.bar = bw; bar.x = xb_xcc_id(); bar.st = st;
      if (F.tid == 0) { const unsigned rank = xb_add(&bw[XB_XCNT(bar.x)], 1u); unsigned nloc, nx; xcd_barrier_complete(bw, bar.x, nloc, nx); st[0] = nloc; st[1] = nx;
          bool eq = (grid0 % 8 == 0) && (nx == 8u); unsigned pre = 0u;
          for (unsigned j = 0; j < 16; ++j) { const unsigned c = xb_ld(&bw[XB_XCNT(j)]); if (j < 8) eq = eq && (c == (unsigned)grid0 / 8u); else eq = eq && (c == 0u); if (j < bar.x) pre += c; }
          st[2] = eq ? rank * 8u + bar.x : pre + rank; st[3] = eq ? 1u : 0u; }
      __syncthreads();
      bid0 = (int)__builtin_amdgcn_readfirstlane(st[2]); xloc = __builtin_amdgcn_readfirstlane(st[3]) != 0u; F.bid = bid0; }
#endif
    const int lo = args.ph_lo, hi = args.ph_hi;
#define IN(k) (lo <= (k) && (k) < hi)
#if MK_N_LAUNCHES == 1
#define SEAM(k) do { if (IN(k) && IN((k) + 1)) { xcd_barrier(bar); if (REP_PHASE == 99) xcd_barrier(bar); } } while (0)
#define SEAML(k) do { if (IN(k) && IN((k) + 1)) { xcd_barrier(bar, xloc ? 1 : 0); } } while (0)
#define SEAMP(k) do { if (IN(k) && IN((k) + 1)) { xcd_barrier(bar, xloc ? 2 : 0); } } while (0)
#else
#define SEAM(k) do { } while (0)
#define SEAML(k) do { } while (0)
#define SEAMP(k) do { } while (0)
#endif
    unsigned char* const ws0 = args.ws;
    for (int L = 0; L < DEPTH; ++L) {
        const int P = L * NPH;
        unsigned char* ws;
#define OPQ() do { unsigned long long wq_ = (unsigned long long)ws0; asm volatile("" : "+s"(wq_) :: "memory"); ws = (unsigned char*)(GAS unsigned char*)wq_; int l_; asm volatile("v_mbcnt_lo_u32_b32 %0, -1, 0\n\tv_mbcnt_hi_u32_b32 %0, -1, %0" : "=v"(l_)); int w_ = wave0, b_ = bid0, g_ = grid0; asm volatile("" : "+s"(w_), "+s"(b_), "+s"(g_)); F.lane = l_; F.wave = w_; F.tid = w_ * 64 + l_; F.bid = b_; F.G = g_; } while (0)
#define BG_PREP(nun_, lo_, hi_) do { const int nun__ = (nun_), maxu__ = (nun__ + F.G - 1) / F.G, nheavy__ = nun__ - (maxu__ - 1) * F.G; int nl__ = F.G - nheavy__, li__ = F.bid - nheavy__; \
            if (nl__ < 64) { nl__ = F.G; li__ = F.bid; } if (REP_PHASE != 77 && li__ >= 0) { OPQ(); F.ws = ws; prep_weights(F, L + 1, (lo_), (hi_), li__ * 8 + F.wave, nl__ * 8); } } while (0)
        if (IN(P + 0) && L == 0) { OPQ(); F.ws = ws; prep_phase(F); SEAM(P + 0); }
        if (REP_PHASE == 77 && IN(P + 0) && L > 0) { OPQ(); F.ws = ws; prep_weights(F, L, 0, TR_NITEMS, F.bid * 8 + F.wave, F.G * 8); xcd_barrier(bar); }
        if (IN(P + 1)) { OPQ();
            pg8::Gemm g{(const bf16_t*)(ws + WS_XBW), (const bf16_t*)(ws + WOFF(L) + WS_WIN), D, D, D}; pg8::StaticOrder S; S.init(T, NIN, F.G, F.bid);
            { LAS float* rl = (LAS float*)(F.lds + RSTD_OFF); const float* SSQ = (const float*)(ws + WS_SSQ); Unit u; float rv[RSTD_UNITS];
              if (F.tid < 256) {
#pragma unroll
                  for (int i = 0; i < RSTD_UNITS; ++i) rv[i] = S.next(i, u) ? row_rstd(SSQ, u.pm * 256 + F.tid) : 0.f;
#pragma unroll
                  for (int i = 0; i < RSTD_UNITS; ++i) rl[i * 256 + F.tid] = rv[i]; }
              __syncthreads(); }
            EpiWin E{(const float*)(ws + WS_SSQ), (const LAS float*)(F.lds + RSTD_OFF), (bf16_t*)(ws + WS_Q), (bf16_t*)(ws + WS_K), (bf16_t*)(ws + WS_VT), (bf16_t*)(ws + WS_XR), (bf16_t*)(ws + WS_XG), (bf16_t*)(ws + WS_GA), (bf16_t*)(ws + WS_GR)};
            for (int rep = 0; rep < REPN(1); ++rep) pg8::gemm_phase(F.lds, g, S, E, F.tid);
            if (L + 1 < DEPTH) { for (int rep = 0; rep < REPN(93); ++rep) BG_PREP(T / 256 * (NIN / 256), 0, TR_S1); }
            if (L == 0) { OPQ();
                pg8::Gemm g2{(const bf16_t*)(ws + WS_PB), (const bf16_t*)(ws + WS_WPP), PLED, PLED, PLED}; PPSub S2{0, F.bid, F.G, 256};
                EpiBf16 E2{(bf16_t*)(ws + WS_PP), D};
                pg8::gemm_phase(F.lds, g2, S2, E2, F.tid); }
            SEAMP(P + 1); }
        if (IN(P + 2)) { for (int rep = 0; rep < REPN(2); ++rep) { OPQ(); F.ws = ws; conv_phase(F, L); } for (int rep = 0; rep < REPN(20); ++rep) { OPQ(); F.ws = ws; attn_phase(F); } SEAML(P + 2); }
        if (IN(P + 3)) { OPQ();
            pg8::Gemm g{(const bf16_t*)(ws + WS_XC), (const bf16_t*)(ws + WOFF(L) + WS_WGT), DR, DR, 256}; GateOrder S; S.init(T, 1024, F.G, F.bid);
            EpiGates E{(const bf16_t*)(ws + WS_XC), inp(F, 7) + L * DR, inp(F, 9) + L * DR, (const float*)(ws + WS_MISC + 196608 + (L & 1) * 2048), (unsigned*)(ws + WS_DB)};
            for (int rep = 0; rep < REPN(3); ++rep) pg8::gemm_phase(F.lds, g, S, E, F.tid);
            asm volatile("s_waitcnt vmcnt(0)" ::: "memory"); __syncthreads();
            { OPQ(); F.ws = ws; Unit u;
              for (int i = 0; S.next(i, u); ++i) scan1_unit(F, u.pm >> 4, (u.pm & 15) * 4 + (F.wave & 3), 2 * u.pn + (F.wave >> 2)); }
            SEAMP(P + 3); }
        if (IN(P + 5)) { for (int rep = 0; rep < REPN(5); ++rep) { OPQ(); F.ws = ws; scan2_phase(F); } SEAML(P + 5); }
        if (IN(P + 6)) { OPQ();
            pg8::Gemm g{(const bf16_t*)(ws + WS_AO), (const bf16_t*)(ws + WOFF(L) + WS_WAO), D, D, D}; pg8::StaticOrder S; S.init(T, D, F.G, F.bid);
            EpiMerge2 E{(const bf16_t*)(ws + WS_GA), (const bf16_t*)(ws + WS_GR), (bf16_t*)(ws + WS_MG)};
            for (int rep = 0; rep < REPN(6); ++rep) pg8::gemm_phase(F.lds, g, S, E, F.tid);
            SEAML(P + 6); }
        if (IN(P + 7)) { OPQ();
            pg8::Gemm g{(const bf16_t*)(ws + WS_MG), (const bf16_t*)(ws + WOFF(L) + WS_WOUT), D, D, D}; pg8::StaticOrder S; S.init(T, D, F.G, F.bid);
            EpiResid E{(L == 0) ? inp(F, 0) : F.out, F.out};
            pg8::gemm_phase(F.lds, g, S, E, F.tid);
            if (IN(P + 8)) { OPQ(); F.ws = ws; route_load_tables(F, L); }
            SEAML(P + 7); }
        if (IN(P + 8)) { if (!IN(P + 7)) { OPQ(); F.ws = ws; route_load_tables(F, L); __syncthreads(); }
            if (REP_PHASE == 8) { OPQ(); F.ws = ws; route_phase(F, L, L + 4); SEAM(P + 8); } OPQ(); F.ws = ws; route_phase(F, L, L); SEAM(P + 8); }
        if (IN(P + 9)) { OPQ();
            group_table(F, L);
            pg8::Gemm g{(const bf16_t*)(ws + WS_XB), (const bf16_t*)(ws + WOFF(L) + WS_WGU), D, D, D};
            GroupSched<true> S{(const LAS int*)(F.lds + TSTART_OFF), F.G, F.bid, (const unsigned*)(ws + WS_TOK)};
            EpiGU E{(const float*)(ws + WS_RS), (bf16_t*)(ws + WS_ACT)};
            for (int rep = 0; rep < REPN(9); ++rep) pg8::gemm_phase(F.lds, g, S, E, F.tid);
            if (L + 1 < DEPTH) { int nl, li; group_light(F.G, F.bid, ((const LAS int*)(F.lds + TSTART_OFF))[16], nl, li); if (li >= 0) { OPQ(); F.ws = ws; prep_weights(F, L + 1, TR_S1, TR_S2, li * 8 + F.wave, nl * 8);
                    OPQ(); pg8::Gemm g2{(const bf16_t*)(ws + WS_PB), (const bf16_t*)(ws + WS_WPP), PLED, PLED, PLED}; PPSub S2{L + 1, li, 256, nl < 256 ? nl : 256};
                    EpiBf16 E2{(bf16_t*)(ws + WS_PP), D}; pg8::gemm_phase(F.lds, g2, S2, E2, F.tid); } }
            SEAML(P + 9); }
        if (IN(P + 10)) { OPQ();
            group_table(F, L);
            pg8::Gemm g{(const bf16_t*)(ws + WS_ACT), (const bf16_t*)(ws + WOFF(L) + WS_WDN), DE, DE, DE};
            GroupSched<false> S{(const LAS int*)(F.lds + TSTART_OFF), F.G, F.bid, (const unsigned*)(ws + WS_TOK)};
            EpiDown E{(const unsigned*)(ws + WS_TOK), (const float*)(ws + WS_WL), (bf16_t*)(ws + WS_Y0), (bf16_t*)(ws + WS_Y1)};
            for (int rep = 0; rep < REPN(10); ++rep) pg8::gemm_phase(F.lds, g, S, E, F.tid);
            if (L + 1 < DEPTH) { int nl, li; group_light(F.G, F.bid, ((const LAS int*)(F.lds + TSTART_OFF))[16], nl, li); if (li >= 0) { OPQ(); F.ws = ws; prep_weights(F, L + 1, TR_S2, TR_NITEMS, li * 8 + F.wave, nl * 8);
                    OPQ(); pg8::Gemm g2{(const bf16_t*)(ws + WS_PB), (const bf16_t*)(ws + WS_WPP), PLED, PLED, PLED}; PPSub S2{L + 1, nl + li, 256, 256};
                    EpiBf16 E2{(bf16_t*)(ws + WS_PP), D}; pg8::gemm_phase(F.lds, g2, S2, E2, F.tid); } }
            SEAM(P + 10); }
        if (IN(P + 11)) { OPQ(); F.ws = ws; s3_phase(F); SEAML(P + 11); }
        if (IN(P + 12)) { OPQ();
            pg8::Gemm g{(const bf16_t*)(ws + WS_XB), (const bf16_t*)(ws + WS_WPGL) + (size_t)L * D * D, D, D, D}; pg8::StaticOrder S; S.init(T, D, F.G, F.bid);
            EpiPle E{(const float*)(ws + WS_MISC + 131072), (const bf16_t*)(ws + WS_PP) + (size_t)L * T * D, F.out, F.out, (bf16_t*)(ws + WS_XBW), (float*)(ws + WS_SSQ)};
            pg8::gemm_phase(F.lds, g, S, E, F.tid);
            SEAML(P + 12); }
    }
    if (IN(DEPTH * NPH)) final_phase(F);
#undef IN
#undef SEAM
}

extern "C" void kernel_launch(void* const* d_in, const int* in_sizes, int n_in, void* d_out, int out_size, void* d_ws, size_t ws_size, hipStream_t stream) {
    static int grid = 0;
    if (grid == 0) {
        if (n_in != 26 || in_sizes[0] != T * D || out_size != T * D || ws_size < WS_END) { fprintf(stderr, "kernel_launch: unexpected shapes (n_in %d, in0 %d, out %d, ws %zu need %zu)\n", n_in, n_in > 0 ? in_sizes[0] : -1, out_size, ws_size, (size_t)WS_END); grid = -1; return; }
        int dev = 0, cus = 0, per_cu = 0;
        if (hipGetDevice(&dev) != hipSuccess || hipDeviceGetAttribute(&cus, hipDeviceAttributeMultiprocessorCount, dev) != hipSuccess) { grid = -1; return; }
        if (hipFuncSetAttribute((const void*)trunk_fwd, hipFuncAttributeMaxDynamicSharedMemorySize, LDS_BYTES) != hipSuccess) { fprintf(stderr, "kernel_launch: hipFuncSetAttribute failed\n"); grid = -1; return; }
        if (hipOccupancyMaxActiveBlocksPerMultiprocessor(&per_cu, (const void*)trunk_fwd, 512, LDS_BYTES) != hipSuccess || per_cu < 1) fprintf(stderr, "kernel_launch: occupancy query reports %d\n", per_cu);
        (void)hipGetLastError();
        grid = cus;
    }
    if (grid < 0) return;
    if (hipMemsetAsync((char*)d_ws + WS_CTL, 0, CTL_ZERO_BYTES, stream) != hipSuccess) return;
    Args a{};
    for (int i = 0; i < 26; ++i) a.in[i] = (const float*)d_in[i];
    a.out = (float*)d_out; a.ws = (unsigned char*)d_ws;
#if MK_N_LAUNCHES == 1
    a.ph_lo = 0; a.ph_hi = PH_TOTAL;
    hipLaunchKernelGGL(trunk_fwd, dim3(grid), dim3(512), LDS_BYTES, stream, a);
#else
    for (int ph = 0; ph < PH_TOTAL; ++ph) { a.ph_lo = ph; a.ph_hi = ph + 1; hipLaunchKernelGGL(trunk_fwd, dim3(grid), dim3(512), LDS_BYTES, stream, a); }
#endif
}
```

```cpp
#include <hip/hip_runtime.h>
#include <cstdio>
#include <cstdint>

#ifndef REP_PHASE
#define REP_PHASE -1
#endif
#define REPN(k) ((REP_PHASE == (k)) ? 2 : 1)
#ifndef MK_N_LAUNCHES
#define MK_N_LAUNCHES 1
#endif

#define LAS __attribute__((address_space(3)))
#define GAS __attribute__((address_space(1)))
typedef unsigned short bf16_t;
typedef short bf16x8 __attribute__((ext_vector_type(8)));
typedef float f32x4 __attribute__((ext_vector_type(4)));
typedef float f32x2 __attribute__((ext_vector_type(2)));
typedef float f32x16 __attribute__((ext_vector_type(16)));
typedef unsigned u32x4 __attribute__((ext_vector_type(4)));
typedef unsigned u32x2 __attribute__((ext_vector_type(2)));

constexpr int NB = 4, SEQ = 4096, T = NB * SEQ, D = 1024, DA = 512, DR = 512, NIN = 4608, NE = 16, DE = 512, PLED = 256, DEPTH = 4, NHEAD = 8;
constexpr float EPS = 1e-6f;
constexpr float LOG2E = 1.4426950408889634f;
constexpr float QSCALE = 0.125f * LOG2E;
constexpr int LCAP = 16384;

__device__ __forceinline__ unsigned cvt_pk_bf16(float lo, float hi) { unsigned r; asm volatile("v_cvt_pk_bf16_f32 %0, %1, %2" : "=v"(r) : "v"(lo), "v"(hi)); return r; }
__device__ __forceinline__ u32x4 zero4() { unsigned z; asm volatile("v_mov_b32 %0, 0" : "=v"(z)); return (u32x4){z, z, z, z}; }
__device__ __forceinline__ float bf2f(unsigned short h) { return __uint_as_float(((unsigned)h) << 16); }
__device__ __forceinline__ float bflo(unsigned w) { return __uint_as_float(w << 16); }
__device__ __forceinline__ float bfhi(unsigned w) { return __uint_as_float(w & 0xffff0000u); }
__device__ __forceinline__ float fexp2(float x) { return __builtin_amdgcn_exp2f(x); }
__device__ __forceinline__ float frcp(float x) { return __builtin_amdgcn_rcpf(x); }
__device__ __forceinline__ float sigmoidf_(float x) { return frcp(1.0f + fexp2(-LOG2E * x)); }
__device__ __forceinline__ float gelu_tanh_(float x) { const float u = 1.5957691216057308f * (x + 0.044715f * x * x * x); return x * sigmoidf_(u); }
template <int CTRL> __device__ __forceinline__ float dpp_f(float v) { return __int_as_float(__builtin_amdgcn_update_dpp(0, __float_as_int(v), CTRL, 0xF, 0xF, false)); }
__device__ __forceinline__ float wave_sum(float v) {
    v += dpp_f<0xB1>(v);
    v += dpp_f<0x4E>(v);
    v += dpp_f<0x141>(v);
    v += dpp_f<0x140>(v);
    const float a = __int_as_float(__builtin_amdgcn_readlane(__float_as_int(v), 0)), b = __int_as_float(__builtin_amdgcn_readlane(__float_as_int(v), 16));
    const float c = __int_as_float(__builtin_amdgcn_readlane(__float_as_int(v), 32)), d = __int_as_float(__builtin_amdgcn_readlane(__float_as_int(v), 48));
    return (a + b) + (c + d);
}

namespace pg8 {
constexpr int BM = 256, BK = 64, HALF = 128, HTB = HALF * BK * 2, STAGE_BYTES = 8 * HTB, NXCD = 8, WGM = 8;
__host__ __device__ __forceinline__ int lds_byte(int r, int c) { const int st = (r >> 4) * 2 + (c >> 5), rr = r & 15, cc = c & 31, ob = rr * 64 + cc * 2; return st * 1024 + (ob ^ (((ob >> 9) & 1) << 5)); }
__host__ __device__ __forceinline__ void stage_rc(int b, int& R, int& C) { const int st = b / 1024, sb = b % 1024, swz = sb ^ (((sb >> 9) & 1) << 5); R = (st >> 1) * 16 + swz / 64; C = (st & 1) * 32 + (swz % 64) / 2; }
__host__ __device__ __forceinline__ int perm32(int rho) { const int n = rho >> 4, i = rho & 15; return 8 * (i >> 2) + 4 * n + (i & 3); }

struct Unit { int pm, pn, e, pos0, ne; };
struct Gemm { const bf16_t* A; const bf16_t* Bt; int lda, ldb, K; };

struct StaticOrder {
    int nM, nN, nwg, G, c;
    __device__ __forceinline__ void init(int M, int N, int G_, int c_) { nM = M / BM; nN = N / BM; nwg = nM * nN; G = G_; c = c_; }
    __device__ __forceinline__ bool next(int i, Unit& u) const {
        const long L = (long)i * G + c; if (L >= nwg) return false;
        int wgid = (int)L; { const int q = nwg / NXCD, r = nwg % NXCD, xcd = wgid % NXCD, off = wgid / NXCD; wgid = (xcd < r ? xcd * (q + 1) : r * (q + 1) + (xcd - r) * q) + off; }
        const int nig = WGM * nN, gid = wgid / nig, fm = gid * WGM, gsz = (nM - fm) < WGM ? (nM - fm) : WGM;
        u.pm = fm + ((wgid % nig) % gsz); u.pn = (wgid % nig) / gsz; u.e = 0; u.pos0 = i; u.ne = 0; return true;
    }
    static constexpr bool GATHER = false;
    __device__ __forceinline__ int arow(const Unit& u, int r) const { return u.pm * BM + r; }
    __device__ __forceinline__ int arow0(const Unit& u) const { return u.pm * BM; }
    __device__ __forceinline__ int brow(const Unit& u) const { return u.pn * BM; }
    __device__ __forceinline__ int koff(const Unit&) const { return 0; }
};

template <class Epi, class Sched>
__device__ __forceinline__ void gemm_phase(LAS unsigned char* lds, const Gemm g, const Sched& S, const Epi& E, int tid_) {
    asm volatile("" : "+v"(tid_));
    const int tid = tid_, wid = __builtin_amdgcn_readfirstlane(tid >> 6), lane = tid & 63, wr = wid >> 2, wc = wid & 3, fr = lane & 15, fq = lane >> 4;
    int nt = g.K / BK; asm volatile("" : "+s"(nt));
    unsigned voffB[2];
#pragma unroll
    for (int i = 0; i < 2; ++i) { int R, C; stage_rc(tid * 16 + i * 8192, R, C); const int Rb = Epi::PERM ? ((R & ~31) + perm32(R & 31)) : R;
        voffB[i] = (unsigned)(Rb * g.ldb + C) * 2u; }
    const size_t kstep = (size_t)(BK * 2);
    const size_t hstepB = (size_t)HALF * g.ldb * 2;
    const unsigned ldsw = (unsigned)wid * 1024u;
    const int aoff = lds_byte(wr * 64 + fr, fq * 8), boff = lds_byte(wc * 32 + fr, fq * 8);
#define PG8_SA(b, h) (((b) * 2 + (h)) * HTB)
#define PG8_SB(b, h) ((4 + (b) * 2 + (h)) * HTB)
#define PG8_STAGE(bufoff, gbase, voff) do { _Pragma("unroll") for (int _i = 0; _i < 2; ++_i) \
        __builtin_amdgcn_global_load_lds((const unsigned*)((const char*)(gbase) + (voff)[_i]), (LAS unsigned*)(lds + (bufoff) + ldsw + _i * 8192), 16, 0, 0); } while (0)
#define PG8_LDA(dst, b, h) do { _Pragma("unroll") for (int m = 0; m < 4; ++m) _Pragma("unroll") for (int k = 0; k < 2; ++k) dst[m][k] = *(const LAS bf16x8*)(lds + PG8_SA(b, h) + aoff + m * 2048 + k * 1024); } while (0)
#define PG8_LDB(dst, b, h) do { _Pragma("unroll") for (int n = 0; n < 2; ++n) _Pragma("unroll") for (int k = 0; k < 2; ++k) dst[n][k] = *(const LAS bf16x8*)(lds + PG8_SB(b, h) + boff + n * 2048 + k * 1024); } while (0)
#define PG8_MMA(ai, bj, At, Bt) do { __builtin_amdgcn_s_setprio(1); _Pragma("unroll") for (int m = 0; m < 4; ++m) _Pragma("unroll") for (int n = 0; n < 2; ++n) _Pragma("unroll") for (int k = 0; k < 2; ++k) \
        acc[ai][bj][m][n] = __builtin_amdgcn_mfma_f32_16x16x32_bf16(Bt[n][k], At[m][k], acc[ai][bj][m][n], 0, 0, 0); __builtin_amdgcn_s_setprio(0); } while (0)
#define PG8_WAIT_V(n) asm volatile("s_waitcnt vmcnt(" #n ")" ::: "memory")
#define PG8_WAIT_L(n) asm volatile("s_waitcnt lgkmcnt(" #n ")" ::: "memory")
#define PG8_BAR __builtin_amdgcn_s_barrier()
#define PG8_SCHED __builtin_amdgcn_sched_barrier(0)
#define PG8_AOFF(dst, u) do { _Pragma("unroll") for (int _i = 0; _i < 2; ++_i) { int _R, _C; stage_rc(tid * 16 + _i * 8192, _R, _C); _Pragma("unroll") for (int _h = 0; _h < 2; ++_h) \
        dst[_h][_i] = ((unsigned)S.arow(u, _h * HALF + _R) * (unsigned)g.lda + (unsigned)_C) * 2u; } } while (0)
#define PG8_LOFF(dst) do { _Pragma("unroll") for (int _i = 0; _i < 2; ++_i) { int _R, _C; stage_rc(tid * 16 + _i * 8192, _R, _C); _Pragma("unroll") for (int _h = 0; _h < 2; ++_h) \
        dst[_h][_i] = ((unsigned)(_h * HALF + _R) * (unsigned)g.lda + (unsigned)_C) * 2u; } } while (0)
    Unit cur, nxt; int ui = 0;
    if (!S.next(0, cur)) return;
    f32x4 acc[2][2][4][2];
    if constexpr (Epi::INIT_ACC) E.init(acc, cur, wr, wc, fr, fq);
    else {
#pragma unroll
    for (int a = 0; a < 2; ++a)
#pragma unroll
        for (int b = 0; b < 2; ++b)
#pragma unroll
            for (int m = 0; m < 4; ++m)
#pragma unroll
                for (int n = 0; n < 2; ++n) acc[a][b][m][n] = (f32x4){0.f, 0.f, 0.f, 0.f};
    }
    bf16x8 At[4][2], B0[2][2], B1[2][2];
    constexpr bool GA = Sched::GATHER;
    unsigned ca[2][2], na[2][2];
    const char* cA = (const char*)g.A; const char* nA = cA;
    if constexpr (GA) { PG8_AOFF(ca, cur); }
    else { PG8_LOFF(ca); cA = (const char*)g.A + ((size_t)S.arow0(cur) * g.lda + S.koff(cur)) * 2; }
    const char* cB = (const char*)g.Bt + ((size_t)S.brow(cur) * g.ldb + S.koff(cur)) * 2;
    PG8_STAGE(PG8_SB(0, 0), cB, voffB); PG8_STAGE(PG8_SB(0, 1), cB + hstepB, voffB); PG8_STAGE(PG8_SA(0, 0), cA, ca[0]); PG8_STAGE(PG8_SA(0, 1), cA, ca[1]);
    if (wr == 1) PG8_BAR;
    PG8_WAIT_V(2); PG8_BAR;
    PG8_STAGE(PG8_SB(1, 0), cB + kstep, voffB); PG8_STAGE(PG8_SA(1, 0), cA + kstep, ca[0]); PG8_STAGE(PG8_SB(1, 1), cB + hstepB + kstep, voffB);
    PG8_WAIT_V(6); PG8_BAR;
    for (;;) {
        const bool has_next = S.next(ui + 1, nxt);
        const char* nB = cB; nA = cA;
        if (has_next) { nB = (const char*)g.Bt + ((size_t)S.brow(nxt) * g.ldb + S.koff(nxt)) * 2;
            if constexpr (GA) { PG8_AOFF(na, nxt); } else { nA = (const char*)g.A + ((size_t)S.arow0(nxt) * g.lda + S.koff(nxt)) * 2; } }
        else { if constexpr (GA) {
#pragma unroll
            for (int h = 0; h < 2; ++h)
#pragma unroll
                for (int i = 0; i < 2; ++i) na[h][i] = ca[h][i]; } }
        for (int t = 0; t < nt; t += 2) {
            const bool last = (t == nt - 2);
            if constexpr (Epi::HAS_MID) { if (2 * t == nt) { int mfr = fr, mfq = fq; asm volatile("" : "+v"(mfr), "+v"(mfq)); E.mid(acc, cur, wr, wc, mfr, mfq); } }
            const char* a1 = cA + (size_t)(t + 1) * kstep;
            const char* a2 = last ? nA : cA + (size_t)(t + 2) * kstep; const char* b2 = last ? nB : cB + (size_t)(t + 2) * kstep;
            const char* a3 = a2 + kstep; const char* b3 = b2 + kstep;
            unsigned o2[2][2];
#pragma unroll
            for (int h = 0; h < 2; ++h)
#pragma unroll
                for (int i = 0; i < 2; ++i) { if constexpr (GA) o2[h][i] = last ? na[h][i] : ca[h][i]; else o2[h][i] = ca[h][i]; }
            PG8_LDB(B0, 0, 0); PG8_LDB(B1, 0, 1); PG8_SCHED; PG8_LDA(At, 0, 0); PG8_STAGE(PG8_SA(1, 1), a1, ca[1]);
            PG8_WAIT_V(8); PG8_WAIT_L(0); PG8_BAR; PG8_MMA(0, 0, At, B0); PG8_MMA(0, 1, At, B1); PG8_BAR; PG8_SCHED;
            PG8_LDA(At, 0, 1); PG8_STAGE(PG8_SB(0, 0), b2, voffB); PG8_STAGE(PG8_SB(0, 1), b2 + hstepB, voffB); PG8_STAGE(PG8_SA(0, 0), a2, o2[0]);
            PG8_WAIT_V(8); PG8_WAIT_L(0); PG8_BAR; PG8_MMA(1, 0, At, B0); PG8_MMA(1, 1, At, B1); PG8_BAR; PG8_SCHED;
            PG8_LDB(B0, 1, 0); PG8_LDB(B1, 1, 1); PG8_SCHED; PG8_LDA(At, 1, 0); PG8_STAGE(PG8_SA(0, 1), a2, o2[1]);
            PG8_WAIT_V(8); PG8_WAIT_L(0); PG8_BAR; PG8_MMA(0, 0, At, B0); PG8_MMA(0, 1, At, B1); PG8_BAR; PG8_SCHED;
            PG8_LDA(At, 1, 1); PG8_STAGE(PG8_SB(1, 0), b3, voffB); PG8_STAGE(PG8_SB(1, 1), b3 + hstepB, voffB); PG8_STAGE(PG8_SA(1, 0), a3, o2[0]);
            PG8_WAIT_V(8); PG8_WAIT_L(0); PG8_BAR; PG8_MMA(1, 0, At, B0); PG8_MMA(1, 1, At, B1); PG8_BAR; PG8_SCHED;
        }
        if (wr == 0) PG8_BAR;
        { int efr = fr, efq = fq; asm volatile("" : "+v"(efr), "+v"(efq));
          E(acc, cur, wr, wc, efr, efq); }
        if (!has_next) break;
        if constexpr (Epi::INIT_ACC) E.init(acc, nxt, wr, wc, fr, fq);
        else {
#pragma unroll
        for (int a = 0; a < 2; ++a)
#pragma unroll
            for (int b = 0; b < 2; ++b)
#pragma unroll
                for (int m = 0; m < 4; ++m)
#pragma unroll
                    for (int n = 0; n < 2; ++n) acc[a][b][m][n] = (f32x4){0.f, 0.f, 0.f, 0.f};
        }
        cur = nxt; cB = nB; cA = nA; ++ui;
        if constexpr (GA) {
#pragma unroll
            for (int h = 0; h < 2; ++h)
#pragma unroll
                for (int i = 0; i < 2; ++i) ca[h][i] = na[h][i]; }
        if (wr == 1) PG8_BAR;
    }
    PG8_WAIT_V(0);
    PG8_BAR;
#undef PG8_SA
#undef PG8_SB
#undef PG8_STAGE
#undef PG8_LDA
#undef PG8_LDB
#undef PG8_MMA
#undef PG8_WAIT_V
#undef PG8_WAIT_L
#undef PG8_BAR
#undef PG8_SCHED
#undef PG8_AOFF
#undef PG8_LOFF
}
}
using pg8::Unit;

constexpr size_t MiB = 1u << 20;
constexpr size_t WS_CTL = 0, CTL_ZERO_BYTES = 1 * MiB;
constexpr size_t WS_RTAB = 1 * MiB + 262144;
constexpr size_t WS_MISC = 1 * MiB;
constexpr size_t WS_WIN = 2 * MiB, WS_WGT = 11 * MiB, WS_WAO = 12 * MiB, WS_WRO = 13 * MiB, WS_WOUT = 14 * MiB, WS_WPG = 16 * MiB, WS_WPP = 18 * MiB;
constexpr size_t WS_WGU = 20 * MiB, WS_WDN = 52 * MiB;
constexpr size_t WS_WPGL = 551 * MiB;
constexpr size_t WSET = 66 * MiB;
#define WOFF(L) ((size_t)((L) & 1) * WSET)
constexpr size_t WS_SSQ = 134 * MiB;
constexpr size_t WS_XB = 135 * MiB, WS_PB = 167 * MiB, WS_PP = 199 * MiB;
constexpr size_t WS_Q = 327 * MiB, WS_K = 343 * MiB, WS_VT = 359 * MiB, WS_XR = 375 * MiB, WS_XG = 391 * MiB, WS_GA = 407 * MiB, WS_GR = 439 * MiB, WS_XC = 471 * MiB;
constexpr size_t WS_DB = 487 * MiB, WS_AO = 519 * MiB, WS_RI = 535 * MiB, WS_PART = 551 * MiB, WS_MG = 583 * MiB, WS_SUM = 615 * MiB;
constexpr size_t WS_ACT = 327 * MiB, WS_Y0 = WS_DB, WS_Y1 = WS_AO, WS_TOK = 616 * MiB, WS_WL = 617 * MiB, WS_RS = 618 * MiB;
constexpr size_t WS_XBW = WS_MG;
constexpr size_t WS_END = 619 * MiB;
constexpr int CW_BAR = 4096, CW_CNT = 16384;

constexpr int RING_BYTES = 131072, LDSCTL_OFF = RING_BYTES, MISC_OFF = LDSCTL_OFF + 320, LDS_BYTES = 147456;
constexpr int TSTART_OFF = LDSCTL_OFF + 512;
constexpr int RSTD_OFF = LDSCTL_OFF + 2048, RSTD_UNITS = 5;

#define XB_TMO      128
#define XB_XCNT(j)  (256  + 64 * (j))
#define XB_XSUB(j)  (1280 + 64 * (j))
#define XB_XGEN(j)  (2304 + 64 * (j))
#define XB_TOP      3328
#define XB_TOPGEN   3392
#define XCD_BAR_WORDS 3456
#define XB_SPIN_CAP (1u << 18)
__device__ __forceinline__ unsigned xb_ld(unsigned* p)              { return __hip_atomic_load(p, __ATOMIC_RELAXED, __HIP_MEMORY_SCOPE_AGENT); }
__device__ __forceinline__ unsigned xb_add(unsigned* p, unsigned v) { return __hip_atomic_fetch_add(p, v, __ATOMIC_RELAXED, __HIP_MEMORY_SCOPE_AGENT); }
__device__ __forceinline__ unsigned xb_xcc_id() { return (unsigned)__builtin_amdgcn_s_getreg((3 << 11) | 20) & 0xFu; }
#define XB_SPIN(cond, bar) do { unsigned _sp = 0; while (cond) { __builtin_amdgcn_s_sleep(1); \
    if ((++_sp & 255u) == 0u) { if (xb_ld(&(bar)[XB_TMO])) break; if (_sp > XB_SPIN_CAP) { atomicAdd(&(bar)[XB_TMO], 1u); break; } } } } while (0)
struct XcdBarrier { unsigned* bar; unsigned x; volatile LAS unsigned* st; };
__device__ __forceinline__ XcdBarrier xcd_barrier_post(unsigned* bar, volatile LAS unsigned* st) {
    XcdBarrier b; b.bar = bar; b.x = xb_xcc_id(); b.st = st;
    if (threadIdx.x == 0) (void)xb_add(&bar[XB_XCNT(b.x)], 1u);
    return b;
}
__device__ __forceinline__ void xcd_barrier_complete(unsigned* bar, unsigned x, unsigned& nloc, unsigned& nx) {
    const unsigned G = gridDim.x * gridDim.y * gridDim.z;
    unsigned sum, cnt, mine, sp = 0u;
    for (;;) {
        sum = 0u; cnt = 0u; mine = 0u;
#pragma unroll
        for (unsigned j = 0; j < 16; ++j) { const unsigned c = xb_ld(&bar[XB_XCNT(j)]); sum += c; cnt += (c > 0u) ? 1u : 0u; mine = (j == x) ? c : mine; }
        if (sum == G) break;
        __builtin_amdgcn_s_sleep(1);
        if ((++sp & 255u) == 0u) { if (xb_ld(&bar[XB_TMO])) break; if (sp > XB_SPIN_CAP) { atomicAdd(&bar[XB_TMO], 1u); break; } }
    }
    nloc = mine > 0u ? mine : 1u; nx = cnt > 0u ? cnt : 1u;
}
__device__ __forceinline__ void xcd_barrier(const XcdBarrier& b, int mode = 0) {
    const bool local = mode != 0;
    asm volatile("s_waitcnt vmcnt(0)" ::: "memory");
    __syncthreads();
    if (threadIdx.x == 0) {
        unsigned* bar = b.bar;
        __builtin_amdgcn_s_waitcnt(0);
        unsigned nloc = b.st[0], nx = b.st[1];
        if (nloc == 0u) { xcd_barrier_complete(bar, b.x, nloc, nx); b.st[0] = nloc; b.st[1] = nx; }
        const unsigned old = xb_add(&bar[XB_XSUB(b.x)], 1u);
        const unsigned gen = old / nloc;
        if (old + 1u == (gen + 1u) * nloc) {
            if (!local) {
            __builtin_amdgcn_fence(__ATOMIC_RELEASE, "agent");
            asm volatile("s_waitcnt vmcnt(0)" ::: "memory");
            const unsigned og = xb_add(&bar[XB_TOP], 1u);
            const unsigned tg = og / nx;
            if (og + 1u == (tg + 1u) * nx) xb_add(&bar[XB_TOPGEN], 1u);
            else XB_SPIN(xb_ld(&bar[XB_TOPGEN]) == tg, bar);
            }
            else if (mode == 2) {
                if ((b.x & 1u) == 0u) { __builtin_amdgcn_fence(__ATOMIC_RELEASE, "agent"); asm volatile("s_waitcnt vmcnt(0)" ::: "memory"); }
                else XB_SPIN(xb_ld(&bar[XB_XGEN(b.x - 1u)]) <= gen, bar);
            }
            __builtin_amdgcn_fence(__ATOMIC_ACQUIRE, "agent");
            xb_add(&bar[XB_XGEN(b.x)], 1u);
            asm volatile("s_waitcnt vmcnt(0)" ::: "memory");
        } else {
            XB_SPIN(xb_ld(&bar[XB_XGEN(b.x)]) == gen, bar);
            __builtin_amdgcn_fence(__ATOMIC_ACQUIRE, "agent");
            asm volatile("s_waitcnt vmcnt(0)" ::: "memory");
        }
    }
    __syncthreads();
}

struct Args { const float* in[26]; float* out; unsigned char* ws; int ph_lo, ph_hi; };
struct Frame {
    LAS unsigned char* lds;
    unsigned* ctl;
    unsigned char* ws;
    int tid, lane, wave, G, bid;
    float* out;
};
struct XSpan { int base, first, stride, count; };
__device__ __forceinline__ XSpan xspan(int G, int bid, int n) { XSpan s; if ((G & 7) == 0) { s.base = (bid & 7) * (n >> 3); s.first = bid >> 3; s.stride = G >> 3; s.count = n >> 3; } else { s.base = 0; s.first = bid; s.stride = G; s.count = n; } return s; }
constexpr int PTAB_OFF = LDSCTL_OFF + 1024;
__device__ __forceinline__ const float* inp(const Frame& F, int k) {
    const unsigned long long v = ((const LAS unsigned long long*)(F.lds + PTAB_OFF))[k];
    const unsigned lo = __builtin_amdgcn_readfirstlane((unsigned)v), hi = __builtin_amdgcn_readfirstlane((unsigned)(v >> 32));
    return (const float*)(const GAS float*)(((unsigned long long)hi << 32) | lo);
}
#define LDS_WAIT() asm volatile("s_waitcnt lgkmcnt(0)" ::: "memory")

__device__ __forceinline__ float row_rstd(const float* SSQ, int row) {
    const f32x4* p = (const f32x4*)(SSQ + (size_t)row * 16); const f32x4 a = p[0], b = p[1], c = p[2], d = p[3];
    const float s = (((a[0] + a[1]) + (a[2] + a[3])) + ((b[0] + b[1]) + (b[2] + b[3]))) + (((c[0] + c[1]) + (c[2] + c[3])) + ((d[0] + d[1]) + (d[2] + d[3])));
    return 1.0f / sqrtf(s * (1.0f / D) + EPS);
}
typedef f32x4 AccT[2][2][4][2];

struct EpiWin {
    static constexpr bool PERM = true, INIT_ACC = false, HAS_MID = false;
    const float* SSQ; const LAS float* RL; bf16_t *Q, *K, *VT, *XR, *XG, *GA, *GR;
    __device__ __forceinline__ void operator()(const AccT& acc, const Unit& u, int wr, int wc, int fr, int fq) const {
        const int pn = u.pn, row0 = u.pm * 256 + wr * 64 + fr, cl = wc * 32 + 8 * fq;
        float rsv[2][4];
        if (u.pos0 < RSTD_UNITS) {
#pragma unroll
            for (int ai = 0; ai < 2; ++ai)
#pragma unroll
                for (int m = 0; m < 4; ++m) rsv[ai][m] = RL[u.pos0 * 256 + ai * 128 + wr * 64 + m * 16 + fr];
        } else { const int l = fr + 16 * fq; const float r0 = row_rstd(SSQ, u.pm * 256 + wr * 64 + l), r1 = row_rstd(SSQ, u.pm * 256 + 128 + wr * 64 + l);
#pragma unroll
          for (int m = 0; m < 4; ++m) { rsv[0][m] = __shfl(r0, 16 * m + fr); rsv[1][m] = __shfl(r1, 16 * m + fr); } }
        if (pn == 4 || pn == 5) {
            const int cb = (pn - 4) * 256;
#pragma unroll
            for (int ai = 0; ai < 2; ++ai)
#pragma unroll
                for (int m = 0; m < 4; ++m) { const int row = row0 + ai * 128 + m * 16; const float rs = rsv[ai][m];
                    const int b = row >> 12, ts = row & (SEQ - 1), o = ts & 15;
                    const int kin = (ts & 16) + ((o & 3) | (((o >> 3) & 1) << 2) | (((o >> 2) & 1) << 3));
                    const size_t tb = ((size_t)b * NHEAD * (SEQ / 32) + (ts >> 5)) * 2048 + kin;
#pragma unroll
                    for (int bj = 0; bj < 2; ++bj)
#pragma unroll
                        for (int n = 0; n < 2; ++n) { const f32x4 v = acc[ai][bj][m][n] * rs; const int c = cb + bj * 128 + cl + 4 * n;
#pragma unroll
                            for (int q = 0; q < 4; ++q) { const int cc = c + q; VT[tb + (size_t)(cc >> 6) * ((SEQ / 32) * 2048) + (cc & 63) * 32] = (bf16_t)(cvt_pk_bf16(v[q], 0.f) & 0xffffu); } } }
            return;
        }
        if (pn < 4) {
            bf16_t* base = Q + (size_t)(pn >> 1) * (size_t)((WS_K - WS_Q) / 2); const float sc = (pn < 2) ? QSCALE : 1.f; const int c0 = (pn & 1) * 256;
#pragma unroll
            for (int ai = 0; ai < 2; ++ai)
#pragma unroll
                for (int m = 0; m < 4; ++m) { const int row = row0 + ai * 128 + m * 16; const float rs = rsv[ai][m] * sc; const int b = row >> 12, ts = row & (SEQ - 1);
#pragma unroll
                    for (int bj = 0; bj < 2; ++bj) { const f32x4 v0 = acc[ai][bj][m][0] * rs, v1 = acc[ai][bj][m][1] * rs; const int c = c0 + bj * 128 + cl;
                        u32x4 w; w.x = cvt_pk_bf16(v0[0], v0[1]); w.y = cvt_pk_bf16(v0[2], v0[3]); w.z = cvt_pk_bf16(v1[0], v1[1]); w.w = cvt_pk_bf16(v1[2], v1[3]);
                        *(u32x4*)(base + (((size_t)b * NHEAD + (c >> 6)) * SEQ + ts) * 64 + (c & 63)) = w; }
                    asm volatile("" ::: "memory"); }
            return;
        }
        int act = 0, pitch = 512, c0; float sc = 1.f; size_t boff;
        if (pn < 8) { boff = WS_XR - WS_Q; c0 = (pn - 6) * 256; }
        else if (pn < 10) { boff = WS_XG - WS_Q; c0 = (pn - 8) * 256; act = 1; }
        else if (pn < 14) { boff = WS_GA - WS_Q; c0 = (pn - 10) * 256; act = 2; pitch = 1024; }
        else { boff = WS_GR - WS_Q; c0 = (pn - 14) * 256; act = 2; pitch = 1024; }
        bf16_t* base = (bf16_t*)((unsigned char*)Q + boff);
#pragma unroll
        for (int ai = 0; ai < 2; ++ai)
#pragma unroll
            for (int m = 0; m < 4; ++m) { const int row = row0 + ai * 128 + m * 16; const float rs = rsv[ai][m] * sc;
#pragma unroll
                for (int bj = 0; bj < 2; ++bj) { f32x4 v0 = acc[ai][bj][m][0] * rs, v1 = acc[ai][bj][m][1] * rs;
                    if (act == 1) {
#pragma unroll
                        for (int q = 0; q < 4; ++q) { v0[q] = gelu_tanh_(v0[q]); v1[q] = gelu_tanh_(v1[q]); }
                    } else if (act == 2) {
#pragma unroll
                        for (int q = 0; q < 4; ++q) { v0[q] = sigmoidf_(v0[q]); v1[q] = sigmoidf_(v1[q]); }
                    }
                    u32x4 w; w.x = cvt_pk_bf16(v0[0], v0[1]); w.y = cvt_pk_bf16(v0[2], v0[3]); w.z = cvt_pk_bf16(v1[0], v1[1]); w.w = cvt_pk_bf16(v1[2], v1[3]);
                    *(u32x4*)(base + (size_t)row * pitch + c0 + bj * 128 + cl) = w; }
                asm volatile("" ::: "memory"); }
    }
};

struct EpiGates {
    static constexpr bool PERM = true, INIT_ACC = false, HAS_MID = false;
    const bf16_t* XC; const float *ba, *bx, *cA; unsigned* DB;
    __device__ __forceinline__ void operator()(const AccT& acc, const Unit& u, int wr, int wc, int fr, int fq) const {
        const int row0 = u.pm * 256 + wr * 64 + fr, ch0 = u.pn * 128 + wc * 32 + 8 * fq;
        float vba[8], vbx[8], vca[8];
#pragma unroll
        for (int q = 0; q < 8; ++q) { vba[q] = ba[ch0 + q]; vbx[q] = bx[ch0 + q]; vca[q] = cA[ch0 + q]; }
        u32x4 xwv[2][4];
#pragma unroll
        for (int ai = 0; ai < 2; ++ai)
#pragma unroll
            for (int m = 0; m < 4; ++m) xwv[ai][m] = *(const u32x4*)(XC + (size_t)(row0 + ai * 128 + m * 16) * DR + ch0);
#pragma unroll
        for (int ai = 0; ai < 2; ++ai)
#pragma unroll
            for (int m = 0; m < 4; ++m) { const int row = row0 + ai * 128 + m * 16;
                const u32x4 xw = xwv[ai][m];
                float xc[8] = {bflo(xw.x), bfhi(xw.x), bflo(xw.y), bfhi(xw.y), bflo(xw.z), bfhi(xw.z), bflo(xw.w), bfhi(xw.w)};
                unsigned od[8];
#pragma unroll
                for (int q = 0; q < 8; ++q) { const float pa = acc[ai][0][m][q >> 2][q & 3], px = acc[ai][1][m][q >> 2][q & 3];
                    const float r = sigmoidf_(pa + vba[q]), ig = sigmoidf_(px + vbx[q]);
                    const float la = vca[q] * r;
                    const float om1 = (la > -0.25f) ? (-la * (1.f + 0.5f * la * (1.f + (1.f / 3.f) * la * (1.f + 0.25f * la * (1.f + 0.2f * la))))) : (1.f - fexp2(LOG2E * la));
                    const float om2 = om1 * (2.f - om1);
                    od[q] = cvt_pk_bf16(om1, __builtin_amdgcn_sqrtf(om2) * (ig * xc[q])); }
                *(u32x4*)(DB + (size_t)row * DR + ch0) = (u32x4){od[0], od[1], od[2], od[3]}; *(u32x4*)(DB + (size_t)row * DR + ch0 + 4) = (u32x4){od[4], od[5], od[6], od[7]};
                asm volatile("" ::: "memory"); }
    }
};

struct EpiMerge {
    static constexpr bool PERM = true, INIT_ACC = false, HAS_MID = false;
    const bf16_t *GA, *GR; bf16_t *PART, *MG;
    __device__ __forceinline__ void operator()(const AccT& acc, const Unit& u, int wr, int wc, int fr, int fq) const {
        const int row0 = u.pm * 256 + wr * 64 + fr, c00 = u.pn * 256 + wc * 32 + 8 * fq;
        const bf16_t* G = GA + (size_t)u.e * (size_t)((WS_GR - WS_GA) / 2);
        bf16_t* OUT = PART + (size_t)u.e * (size_t)((WS_MG - WS_PART) / 2);
#pragma unroll
        for (int ai = 0; ai < 2; ++ai)
#pragma unroll
            for (int mp = 0; mp < 2; ++mp) {
                u32x4 gw[2][2], pw[2][2];
#pragma unroll
                for (int mm = 0; mm < 2; ++mm)
#pragma unroll
                    for (int bj = 0; bj < 2; ++bj) { const size_t o = (size_t)(row0 + ai * 128 + (2 * mp + mm) * 16) * D + c00 + bj * 128;
                        gw[mm][bj] = *(const u32x4*)(G + o); pw[mm][bj] = u.e ? *(const u32x4*)(PART + o) : zero4(); }
#pragma unroll
                for (int mm = 0; mm < 2; ++mm)
#pragma unroll
                    for (int bj = 0; bj < 2; ++bj) { const int m = 2 * mp + mm; const size_t o = (size_t)(row0 + ai * 128 + m * 16) * D + c00 + bj * 128;
                        const u32x4 g = gw[mm][bj], p = pw[mm][bj];
                        const f32x4 g0 = {bflo(g.x), bfhi(g.x), bflo(g.y), bfhi(g.y)}, g1 = {bflo(g.z), bfhi(g.z), bflo(g.w), bfhi(g.w)};
                        const f32x4 v0 = g0 * acc[ai][bj][m][0] + (f32x4){bflo(p.x), bfhi(p.x), bflo(p.y), bfhi(p.y)}, v1 = g1 * acc[ai][bj][m][1] + (f32x4){bflo(p.z), bfhi(p.z), bflo(p.w), bfhi(p.w)};
                        u32x4 w; w.x = cvt_pk_bf16(v0[0], v0[1]); w.y = cvt_pk_bf16(v0[2], v0[3]); w.z = cvt_pk_bf16(v1[0], v1[1]); w.w = cvt_pk_bf16(v1[2], v1[3]);
                        *(u32x4*)(OUT + o) = w; }
                asm volatile("" ::: "memory"); }
    }
};
struct EpiMerge2 {
    static constexpr bool PERM = true, INIT_ACC = false, HAS_MID = true;
    const bf16_t *GA, *GR; bf16_t* MG;
    __device__ __forceinline__ void mid(AccT& acc, const Unit& u, int wr, int wc, int fr, int fq) const {
        const int row0 = u.pm * 256 + wr * 64 + fr, c00 = u.pn * 256 + wc * 32 + 8 * fq;
#pragma unroll
        for (int ai = 0; ai < 2; ++ai)
#pragma unroll
            for (int mp = 0; mp < 2; ++mp) {
                u32x4 ga[2][2], gr[2][2];
#pragma unroll
                for (int mm = 0; mm < 2; ++mm)
#pragma unroll
                    for (int bj = 0; bj < 2; ++bj) { const size_t o = (size_t)(row0 + ai * 128 + (2 * mp + mm) * 16) * D + c00 + bj * 128; ga[mm][bj] = *(const u32x4*)(GA + o); gr[mm][bj] = *(const u32x4*)(GR + o); }
#pragma unroll
                for (int mm = 0; mm < 2; ++mm)
#pragma unroll
                    for (int bj = 0; bj < 2; ++bj) { const int m = 2 * mp + mm; const u32x4 a = ga[mm][bj], r = gr[mm][bj];
                        const f32x4 r0 = {frcp(fmaxf(bflo(r.x), 1e-30f)), frcp(fmaxf(bfhi(r.x), 1e-30f)), frcp(fmaxf(bflo(r.y), 1e-30f)), frcp(fmaxf(bfhi(r.y), 1e-30f))};
                        const f32x4 r1 = {frcp(fmaxf(bflo(r.z), 1e-30f)), frcp(fmaxf(bfhi(r.z), 1e-30f)), frcp(fmaxf(bflo(r.w), 1e-30f)), frcp(fmaxf(bfhi(r.w), 1e-30f))};
                        acc[ai][bj][m][0] = acc[ai][bj][m][0] * ((f32x4){bflo(a.x), bfhi(a.x), bflo(a.y), bfhi(a.y)} * r0);
                        acc[ai][bj][m][1] = acc[ai][bj][m][1] * ((f32x4){bflo(a.z), bfhi(a.z), bflo(a.w), bfhi(a.w)} * r1); }
                asm volatile("" ::: "memory"); }
    }
    __device__ __forceinline__ void operator()(const AccT& acc, const Unit& u, int wr, int wc, int fr, int fq) const {
        const int row0 = u.pm * 256 + wr * 64 + fr, c00 = u.pn * 256 + wc * 32 + 8 * fq;
#pragma unroll
        for (int ai = 0; ai < 2; ++ai)
#pragma unroll
            for (int mp = 0; mp < 2; ++mp) {
                u32x4 gr[2][2];
#pragma unroll
                for (int mm = 0; mm < 2; ++mm)
#pragma unroll
                    for (int bj = 0; bj < 2; ++bj) gr[mm][bj] = *(const u32x4*)(GR + (size_t)(row0 + ai * 128 + (2 * mp + mm) * 16) * D + c00 + bj * 128);
#pragma unroll
                for (int mm = 0; mm < 2; ++mm)
#pragma unroll
                    for (int bj = 0; bj < 2; ++bj) { const int m = 2 * mp + mm; const u32x4 r = gr[mm][bj];
                        const f32x4 v0 = acc[ai][bj][m][0] * (f32x4){fmaxf(bflo(r.x), 1e-30f), fmaxf(bfhi(r.x), 1e-30f), fmaxf(bflo(r.y), 1e-30f), fmaxf(bfhi(r.y), 1e-30f)};
                        const f32x4 v1 = acc[ai][bj][m][1] * (f32x4){fmaxf(bflo(r.z), 1e-30f), fmaxf(bfhi(r.z), 1e-30f), fmaxf(bflo(r.w), 1e-30f), fmaxf(bfhi(r.w), 1e-30f)};
                        u32x4 w; w.x = cvt_pk_bf16(v0[0], v0[1]); w.y = cvt_pk_bf16(v0[2], v0[3]); w.z = cvt_pk_bf16(v1[0], v1[1]); w.w = cvt_pk_bf16(v1[2], v1[3]);
                        *(u32x4*)(MG + (size_t)(row0 + ai * 128 + m * 16) * D + c00 + bj * 128) = w; }
                asm volatile("" ::: "memory"); }
    }
};
struct GateOrder : pg8::StaticOrder {
    __device__ __forceinline__ int koff(const Unit& u) const { return 256 * (u.pn >> 1); }
};
struct PairOrder : pg8::StaticOrder {
    __device__ __forceinline__ bool next(int i, Unit& u) const { const bool ok = pg8::StaticOrder::next(i >> 1, u); u.e = i & 1; return ok; }
    __device__ __forceinline__ int arow(const Unit& u, int r) const { return u.e * T + u.pm * 256 + r; }
    __device__ __forceinline__ int arow0(const Unit& u) const { return u.e * T + u.pm * 256; }
    __device__ __forceinline__ int brow(const Unit& u) const { return u.e * 1024 + u.pn * 256; }
};
struct PPOrder : pg8::StaticOrder {
    __device__ __forceinline__ int arow(const Unit& u, int r) const { return u.pm * 256 + r; }
    __device__ __forceinline__ int arow0(const Unit& u) const { return u.pm * 256; }
    __device__ __forceinline__ int brow(const Unit& u) const { return (u.pm >> 6) * 1024 + u.pn * 256; }
};
struct EpiResid {
    static constexpr bool PERM = false, INIT_ACC = true, HAS_MID = false;
    const float* XI; float* XO;
    __device__ __forceinline__ void init(AccT& acc, const Unit& u, int wr, int wc, int fr, int fq) const {
        const int row0 = u.pm * 256 + wr * 64 + fr, c00 = u.pn * 256 + wc * 32 + 4 * fq;
#pragma unroll
        for (int ai = 0; ai < 2; ++ai)
#pragma unroll
            for (int m = 0; m < 4; ++m) { const size_t ro = (size_t)(row0 + ai * 128 + m * 16) * D;
#pragma unroll
                for (int bj = 0; bj < 2; ++bj)
#pragma unroll
                    for (int n = 0; n < 2; ++n) acc[ai][bj][m][n] = *(const f32x4*)(XI + ro + c00 + bj * 128 + n * 16); }
    }
    __device__ __forceinline__ void operator()(const AccT& acc, const Unit& u, int wr, int wc, int fr, int fq) const {
        const int row0 = u.pm * 256 + wr * 64 + fr, c00 = u.pn * 256 + wc * 32 + 4 * fq;
#pragma unroll
        for (int ai = 0; ai < 2; ++ai)
#pragma unroll
            for (int m = 0; m < 4; ++m) { const size_t ro = (size_t)(row0 + ai * 128 + m * 16) * D;
#pragma unroll
                for (int bj = 0; bj < 2; ++bj)
#pragma unroll
                    for (int n = 0; n < 2; ++n) *(f32x4*)(XO + ro + c00 + bj * 128 + n * 16) = acc[ai][bj][m][n]; }
    }
};
struct EpiBf16 {
    static constexpr bool PERM = true, INIT_ACC = false, HAS_MID = false;
    bf16_t* O; int ldc;
    __device__ __forceinline__ void operator()(const AccT& acc, const Unit& u, int wr, int wc, int fr, int fq) const {
        const int row0 = u.pm * 256 + wr * 64 + fr, c00 = u.pn * 256 + wc * 32 + 8 * fq;
#pragma unroll
        for (int ai = 0; ai < 2; ++ai)
#pragma unroll
            for (int m = 0; m < 4; ++m) { const int row = row0 + ai * 128 + m * 16;
#pragma unroll
                for (int bj = 0; bj < 2; ++bj) { const f32x4 v0 = acc[ai][bj][m][0], v1 = acc[ai][bj][m][1];
                    u32x4 w; w.x = cvt_pk_bf16(v0[0], v0[1]); w.y = cvt_pk_bf16(v0[2], v0[3]); w.z = cvt_pk_bf16(v1[0], v1[1]); w.w = cvt_pk_bf16(v1[2], v1[3]);
                    *(u32x4*)(O + (size_t)row * ldc + c00 + bj * 128) = w; }
                asm volatile("" ::: "memory"); }
    }
};
struct EpiGU {
    static constexpr bool PERM = true, INIT_ACC = false, HAS_MID = false;
    const float* RS; bf16_t* ACT;
    __device__ __forceinline__ void operator()(const AccT& acc, const Unit& u, int wr, int wc, int fr, int fq) const {
        const int r0 = wr * 64 + fr, c0 = u.pn * 128 + wc * 32 + 8 * fq;
        float rsv[2][4];
#pragma unroll
        for (int ai = 0; ai < 2; ++ai)
#pragma unroll
            for (int m = 0; m < 4; ++m) rsv[ai][m] = RS[(size_t)u.e * LCAP + u.pos0 + r0 + ai * 128 + m * 16];
#pragma unroll
        for (int ai = 0; ai < 2; ++ai)
#pragma unroll
            for (int m = 0; m < 4; ++m) { const int r = r0 + ai * 128 + m * 16; const float rs = rsv[ai][m];
                float o[8];
#pragma unroll
                for (int q = 0; q < 8; ++q) { const float gg = rs * acc[ai][0][m][q >> 2][q & 3], uu = rs * acc[ai][1][m][q >> 2][q & 3]; o[q] = gg * sigmoidf_(gg) * uu; }
                u32x4 w; w.x = cvt_pk_bf16(o[0], o[1]); w.y = cvt_pk_bf16(o[2], o[3]); w.z = cvt_pk_bf16(o[4], o[5]); w.w = cvt_pk_bf16(o[6], o[7]);
                *(u32x4*)(ACT + (size_t)(u.pm * 256 + r) * DE + c0) = w;
                asm volatile("" ::: "memory"); }
    }
};
struct EpiDown {
    static constexpr bool PERM = true, INIT_ACC = false, HAS_MID = false;
    const unsigned* TOK; const float* WL; bf16_t *Y0, *Y1;
    __device__ __forceinline__ void operator()(const AccT& acc, const Unit& u, int wr, int wc, int fr, int fq) const {
        const int r0 = wr * 64 + fr, c00 = u.pn * 256 + wc * 32 + 8 * fq;
        unsigned tkv[2][4]; float wgv[2][4];
#pragma unroll
        for (int ai = 0; ai < 2; ++ai)
#pragma unroll
            for (int m = 0; m < 4; ++m) { const int p = u.pos0 + r0 + ai * 128 + m * 16; const bool ok = p < u.ne; tkv[ai][m] = ok ? TOK[(size_t)u.e * LCAP + p] : 0u; wgv[ai][m] = ok ? WL[(size_t)u.e * LCAP + p] : 0.f; }
#pragma unroll
        for (int ai = 0; ai < 2; ++ai)
#pragma unroll
            for (int m = 0; m < 4; ++m) { const int p = u.pos0 + r0 + ai * 128 + m * 16;
                if (p < u.ne) { const unsigned tk = tkv[ai][m]; const float wg = wgv[ai][m];
                    bf16_t* dst = ((tk >> 31) ? Y1 : Y0) + (size_t)(tk & 0x7fffffffu) * D + c00;
#pragma unroll
                    for (int bj = 0; bj < 2; ++bj) { const f32x4 v0 = acc[ai][bj][m][0] * wg, v1 = acc[ai][bj][m][1] * wg;
                        u32x4 w; w.x = cvt_pk_bf16(v0[0], v0[1]); w.y = cvt_pk_bf16(v0[2], v0[3]); w.z = cvt_pk_bf16(v1[0], v1[1]); w.w = cvt_pk_bf16(v1[2], v1[3]);
                        *(u32x4*)(dst + bj * 128) = w; } }
                asm volatile("" ::: "memory"); }
    }
};
struct EpiPle {
    static constexpr bool PERM = false, INIT_ACC = false, HAS_MID = false;
    const float* rstd; const bf16_t* PP; const float* X; float* XO; bf16_t* XB; float* SSQ;
    __device__ __forceinline__ void operator()(const AccT& acc, const Unit& u, int wr, int wc, int fr, int fq) const {
        const int row0 = u.pm * 256 + wr * 64 + fr, c00 = u.pn * 256 + wc * 32 + 4 * fq;
        u32x2 gp[2][4][2][2];
#pragma unroll
        for (int ai = 0; ai < 2; ++ai) {
            float rsv[4]; u32x2 ppv[4][2][2];
#pragma unroll
            for (int m = 0; m < 4; ++m) { const int row = row0 + ai * 128 + m * 16; rsv[m] = rstd[row];
#pragma unroll
                for (int bj = 0; bj < 2; ++bj)
#pragma unroll
                    for (int n = 0; n < 2; ++n) ppv[m][bj][n] = *(const u32x2*)(PP + (size_t)row * D + c00 + bj * 128 + n * 16); }
#pragma unroll
            for (int m = 0; m < 4; ++m)
#pragma unroll
                for (int bj = 0; bj < 2; ++bj)
#pragma unroll
                    for (int n = 0; n < 2; ++n) { const u32x2 pw = ppv[m][bj][n]; const f32x4 a = acc[ai][bj][m][n] * rsv[m];
                        gp[ai][m][bj][n].x = cvt_pk_bf16(sigmoidf_(a[0]) * bflo(pw.x), sigmoidf_(a[1]) * bfhi(pw.x));
                        gp[ai][m][bj][n].y = cvt_pk_bf16(sigmoidf_(a[2]) * bflo(pw.y), sigmoidf_(a[3]) * bfhi(pw.y)); }
            asm volatile("" ::: "memory"); }
#pragma unroll
        for (int ai = 0; ai < 2; ++ai) {
            f32x4 xv[4][2][2];
#pragma unroll
            for (int m = 0; m < 4; ++m)
#pragma unroll
                for (int bj = 0; bj < 2; ++bj)
#pragma unroll
                    for (int n = 0; n < 2; ++n) xv[m][bj][n] = *(const f32x4*)(X + (size_t)(row0 + ai * 128 + m * 16) * D + c00 + bj * 128 + n * 16);
#pragma unroll
            for (int m = 0; m < 4; ++m) { const int row = row0 + ai * 128 + m * 16; const size_t ro = (size_t)row * D; float sq = 0.f;
#pragma unroll
                for (int bj = 0; bj < 2; ++bj)
#pragma unroll
                    for (int n = 0; n < 2; ++n) { const int c = c00 + bj * 128 + n * 16; const u32x2 g = gp[ai][m][bj][n];
                        const f32x4 xn = xv[m][bj][n] + (f32x4){bflo(g.x), bfhi(g.x), bflo(g.y), bfhi(g.y)};
                        *(f32x4*)(XO + ro + c) = xn; sq += (xn[0] * xn[0] + xn[1] * xn[1]) + (xn[2] * xn[2] + xn[3] * xn[3]);
                        u32x2 xw; xw.x = cvt_pk_bf16(xn[0], xn[1]); xw.y = cvt_pk_bf16(xn[2], xn[3]); *(u32x2*)(XB + ro + c) = xw; }
                sq += __shfl_xor(sq, 16); sq += __shfl_xor(sq, 32);
                if (fq == 0) SSQ[(size_t)row * 16 + u.pn * 4 + wc] = sq; }
            asm volatile("" ::: "memory"); }
    }
};

template <bool GATHER_> struct GroupSched {
    static constexpr bool GATHER = GATHER_;
    const LAS int* tab; int G, c; const unsigned* TOK;
    __device__ __forceinline__ bool next(int i, Unit& u) const {
        const int ntile = tab[16]; int j, pn;
        if ((G & 7) == 0) { const int q = i * (G >> 3) + (c >> 3); j = ((q >> 2) << 3) + (c & 7); pn = q & 3; } else { const int Lu = i * G + c; j = Lu >> 2; pn = Lu & 3; }
        if (j >= ntile) return false;
        int e = 0;
#pragma unroll
        for (int k = 1; k < 16; ++k) e += (j >= tab[k]) ? 1 : 0;
        e = __builtin_amdgcn_readfirstlane(e);
        u.pm = j; u.pn = pn; u.e = e; u.pos0 = __builtin_amdgcn_readfirstlane((j - tab[e]) * 256); u.ne = __builtin_amdgcn_readfirstlane(tab[17 + e]); return true;
    }
    __device__ __forceinline__ int arow0(const Unit& u) const { return u.pm * 256; }
    __device__ __forceinline__ int arow(const Unit& u, int r) const {
        const int p = u.pos0 + r;
        return (p < u.ne) ? (int)(TOK[(size_t)u.e * LCAP + p] & 0x7fffffffu) : 0;
    }
    __device__ __forceinline__ int brow(const Unit& u) const { return u.e * 1024 + u.pn * 256; }
    __device__ __forceinline__ int koff(const Unit&) const { return 0; }
};

__device__ __forceinline__ void group_light(int G, int bid, int ntile, int& nl, int& li) {
    if ((G & 7) == 0) { const int W = G >> 3, maxu = (4 * ((ntile + 7) >> 3) + W - 1) / W; int tot = 0, mine = -1;
        for (int x = 0; x < 8; ++x) { const int ntx = (ntile + 7 - x) >> 3; int h = 4 * ntx - (maxu - 1) * W; h = h < 0 ? 0 : (h > W ? W : h);
            if (x == (bid & 7)) mine = ((bid >> 3) >= h) ? tot + (bid >> 3) - h : -1;
            tot += W - h; }
        nl = tot; li = mine; }
    else { const int nun = 4 * ntile, maxu = (nun + G - 1) / G, nheavy = nun - (maxu - 1) * G; nl = G - nheavy; li = bid - nheavy; }
    if (nl < 64) { nl = G; li = bid; }
}

struct TrDesc { const float* W; bf16_t* WT; int N, ldt, kofs, nbase, mode, rowoff, k0, n0, gsel; };
__device__ __forceinline__ void tr_load(const TrDesc& d, int lane, f32x4 (&v)[8]) {
    const float* p = d.W + (size_t)(d.k0 + (lane >> 3)) * d.N + d.n0 + 4 * (lane & 7);
#pragma unroll
    for (int i = 0; i < 8; ++i) v[i] = __builtin_nontemporal_load((const f32x4*)(p + (size_t)(8 * i) * d.N));
}
__device__ __forceinline__ void tr_store(const TrDesc& d, int lane, const f32x4 (&v)[8], LAS float* scr, const LAS float* gains) {
#pragma unroll
    for (int i = 0; i < 8; ++i) *(LAS f32x4*)(scr + (8 * i + (lane >> 3)) * 36 + 4 * (lane & 7)) = v[i];
    LDS_WAIT(); asm volatile("" ::: "memory");
    const int n = lane & 31;
    const LAS float* gl = gains + d.gsel * 1024 + d.k0;
#pragma unroll
    for (int j = 0; j < 4; ++j) { const int c = (lane >> 5) + 2 * j; const LAS float* s = scr + (8 * c) * 36 + n; const LAS float* gq = gl + 8 * c;
        float t[8];
#pragma unroll
        for (int q = 0; q < 8; ++q) t[q] = s[q * 36] * gq[q];
        u32x4 o; o.x = cvt_pk_bf16(t[0], t[1]); o.y = cvt_pk_bf16(t[2], t[3]); o.z = cvt_pk_bf16(t[4], t[5]); o.w = cvt_pk_bf16(t[6], t[7]);
        const int nn = d.nbase + d.n0 + n; const int drow = (d.mode ? (256 * (nn >> 7) + (nn & 127)) : nn) + d.rowoff;
        *(u32x4*)(d.WT + (size_t)drow * d.ldt + d.kofs + d.k0 + 8 * c) = o; }
    LDS_WAIT(); asm volatile("" ::: "memory");
}
constexpr int I_IN = 16 * 144, I_AO = 8 * 32, I_OUT = 16 * 32, I_PP = 4 * 32, I_EG = 16 * 16 * 16, I_ED = 16 * 8 * 32, I_RG = 16;
constexpr int TR_NITEMS = I_IN + 2 * I_AO + 2 * I_OUT + 2 * I_EG + I_ED + 2 * I_RG;
constexpr int TR_S1 = 5400, TR_S2 = 11000;
struct Frame;
__device__ __forceinline__ void tr_decode(const Frame& F, int L, int it, TrDesc& d);

__device__ __forceinline__ void route_tables(Frame& F, int L, int first, int stride) {
    const float* wrg = inp(F, 15) + (size_t)L * D * 4; const float* wre = inp(F, 17) + (size_t)L * D * 16; const float* gm = inp(F, 14) + L * D;
    unsigned char* img = F.ws + WS_RTAB + (size_t)(L & 1) * 81920;
    for (int en = first * 64 + F.lane; en < 32 * 64 + 32 * 16; en += stride * 64) {
        int ks, kg, n; unsigned char *ph, *pl;
        if (en < 2048) { ks = en >> 6; const int l = en & 63; kg = l >> 4; n = l & 15; ph = img + en * 16; pl = img + 32768 + en * 16; }
        else { const int r = en - 2048; ks = r >> 4; kg = (r >> 2) & 3; n = 16 + (r & 3); ph = img + 65536 + r * 16; pl = img + 65536 + 8192 + r * 16; }
        const int k0 = 32 * ks + 8 * kg; float v[8];
#pragma unroll
        for (int j = 0; j < 8; ++j) { const int k = k0 + j; const float w = (n < 4) ? wrg[k * 4 + n] : wre[k * 16 + (n - 4)]; v[j] = w * gm[k]; }
        unsigned hw[4];
#pragma unroll
        for (int j = 0; j < 4; ++j) hw[j] = cvt_pk_bf16(v[2 * j], v[2 * j + 1]);
        u32x4 lo;
        lo.x = cvt_pk_bf16(v[0] - bflo(hw[0]), v[1] - bfhi(hw[0])); lo.y = cvt_pk_bf16(v[2] - bflo(hw[1]), v[3] - bfhi(hw[1]));
        lo.z = cvt_pk_bf16(v[4] - bflo(hw[2]), v[5] - bfhi(hw[2])); lo.w = cvt_pk_bf16(v[6] - bflo(hw[3]), v[7] - bfhi(hw[3]));
        *(u32x4*)ph = (u32x4){hw[0], hw[1], hw[2], hw[3]}; *(u32x4*)pl = lo; }
}
__device__ __forceinline__ void prep_weights(Frame& F, int L, int it_lo, int it_hi, int first, int stride) {
    LAS float* scr = (LAS float*)(F.lds + F.wave * 9216);
    LAS float* gains = (LAS float*)(F.lds + 8 * 9216);
    const int lane = F.lane; unsigned char* ws = F.ws;
    { const float* g1 = inp(F, 2) + L * D; const float* g2 = inp(F, 14) + L * D; const float* g3 = inp(F, 22) + L * D;
      __syncthreads();
      for (int i = F.tid; i < 1024; i += 512) { gains[i] = 1.0f; gains[1024 + i] = g1[i]; gains[2048 + i] = g2[i]; gains[3072 + i] = g3[i]; }
      __syncthreads(); }
    { int it = it_lo + first; TrDesc d, dn; f32x4 v[8], vn[8]; const int nitems = it_hi;
      if (it < nitems) { tr_decode(F, L, it, d); tr_load(d, lane, v); }
      while (it < nitems) { const int itn = it + stride;
          if (itn < nitems) { tr_decode(F, L, itn, dn); tr_load(dn, lane, vn); }
          tr_store(d, lane, v, scr, gains);
          d = dn;
#pragma unroll
          for (int i = 0; i < 8; ++i) v[i] = vn[i];
          it = itn; } }
    if (it_lo == 0) for (int row = first; row < 1024; row += stride) { const int g = (((row >> 8) * 128) + (row & 127)) >> 6;
        if ((lane >> 3) != g) *(u32x4*)((bf16_t*)(ws + WOFF(L) + WS_WGT) + (size_t)row * DR + 8 * lane) = zero4(); }
    if (it_lo == 0) route_tables(F, L, first, stride);
    if (it_lo == 0 && first == 0) { float* cA = (float*)(ws + WS_MISC + 196608 + (L & 1) * 2048); const float* lam = inp(F, 10) + L * DR;
        for (int c = lane; c < DR; c += 64) { const float l = lam[c]; const float sp = (l > 0.f) ? log1pf(expf(-l)) : (-l + log1pf(expf(l))); cA[c] = -8.0f * sp; } }
    __syncthreads();
}
__device__ __forceinline__ void prep_phase(Frame& F) {
    const int gw = F.bid * 8 + F.wave, NGW = F.G * 8, lane = F.lane;
    unsigned char* ws = F.ws;
    prep_weights(F, 0, 0, TR_NITEMS + 4 * I_PP, gw, NGW);
    { const float* x = inp(F, 0); bf16_t* xb = (bf16_t*)(ws + WS_XBW); float* SSQ = (float*)(ws + WS_SSQ);
      for (int m = gw; m < T; m += NGW) { const f32x4* xr = (const f32x4*)(x + (size_t)m * D) + lane; f32x4 v[4]; float s = 0.f;
#pragma unroll
          for (int j = 0; j < 4; ++j) { v[j] = xr[64 * j]; s += (v[j][0] * v[j][0] + v[j][1] * v[j][1]) + (v[j][2] * v[j][2] + v[j][3] * v[j][3]); }
          s = wave_sum(s); if (lane < 16) SSQ[(size_t)m * 16 + lane] = (lane == 0) ? s : 0.f;
          u32x2* o = (u32x2*)(xb + (size_t)m * D) + lane;
#pragma unroll
          for (int j = 0; j < 4; ++j) { u32x2 w; w.x = cvt_pk_bf16(v[j][0], v[j][1]); w.y = cvt_pk_bf16(v[j][2], v[j][3]); o[64 * j] = w; } } }
    { const float* p = inp(F, 1); bf16_t* pb = (bf16_t*)(ws + WS_PB); const size_t n8 = (size_t)DEPTH * T * PLED / 8;
        for (size_t i = (size_t)F.bid * 512 + F.tid; i < n8; i += (size_t)F.G * 512) { const f32x4 a = *(const f32x4*)(p + i * 8), b = *(const f32x4*)(p + i * 8 + 4);
            u32x4 w; w.x = cvt_pk_bf16(a[0], a[1]); w.y = cvt_pk_bf16(a[2], a[3]); w.z = cvt_pk_bf16(b[0], b[1]); w.w = cvt_pk_bf16(b[2], b[3]); *(u32x4*)(pb + i * 8) = w; } }
}
__device__ __forceinline__ void tr_decode(const Frame& F, int L, int it, TrDesc& d) {
    unsigned char* ws = F.ws; int r = it;
    d.kofs = 0; d.nbase = 0; d.mode = 0; d.rowoff = 0; d.gsel = 0;
    int nblk;
    if (r < I_IN) { d.W = inp(F, 3) + (size_t)L * D * NIN; d.N = NIN; d.WT = (bf16_t*)(ws + WOFF(L) + WS_WIN); d.ldt = D; d.gsel = 1; nblk = 144; }
    else if ((r -= I_IN) < I_AO) { d.W = inp(F, 11) + (size_t)L * DA * D; d.N = D; d.WT = (bf16_t*)(ws + WOFF(L) + WS_WAO); d.ldt = D; nblk = 32; }
    else if ((r -= I_AO) < I_AO) { d.W = inp(F, 12) + (size_t)L * DR * D; d.N = D; d.WT = (bf16_t*)(ws + WOFF(L) + WS_WAO); d.ldt = D; d.kofs = DA; nblk = 32; }
    else if ((r -= I_AO) < I_OUT) { d.W = inp(F, 13) + (size_t)L * D * D; d.N = D; d.WT = (bf16_t*)(ws + WOFF(L) + WS_WOUT); d.ldt = D; nblk = 32; }
    else if ((r -= I_OUT) < I_OUT) { d.W = inp(F, 23) + (size_t)L * D * D; d.N = D; d.WT = (bf16_t*)(ws + WS_WPGL) + (size_t)L * D * D; d.ldt = D; d.gsel = 3; nblk = 32; }
    else if ((r -= I_OUT) < I_EG) { const int e = r >> 8; r &= 255; d.W = inp(F, 19) + ((size_t)L * NE + e) * D * DE; d.N = DE; d.WT = (bf16_t*)(ws + WOFF(L) + WS_WGU) + (size_t)e * 1024 * 1024; d.ldt = D; d.mode = 1; d.gsel = 2; nblk = 16; }
    else if ((r -= I_EG) < I_EG) { const int e = r >> 8; r &= 255; d.W = inp(F, 20) + ((size_t)L * NE + e) * D * DE; d.N = DE; d.WT = (bf16_t*)(ws + WOFF(L) + WS_WGU) + (size_t)e * 1024 * 1024; d.ldt = D; d.mode = 1; d.rowoff = 128; d.gsel = 2; nblk = 16; }
    else if ((r -= I_EG) < I_ED) { const int e = r >> 8; r &= 255; d.W = inp(F, 21) + ((size_t)L * NE + e) * DE * D; d.N = D; d.WT = (bf16_t*)(ws + WOFF(L) + WS_WDN) + (size_t)e * 1024 * 512; d.ldt = DE; nblk = 32; }
    else if ((r -= I_ED) < I_RG) { const int g = r >> 1; r &= 1; d.W = inp(F, 6) + ((size_t)L * 8 + g) * 4096; d.N = 64; d.WT = (bf16_t*)(ws + WOFF(L) + WS_WGT); d.ldt = DR; d.kofs = 64 * g; d.nbase = 64 * g; d.mode = 1; nblk = 2; }
    else if ((r -= I_RG) < I_RG) { const int g = r >> 1; r &= 1; d.W = inp(F, 8) + ((size_t)L * 8 + g) * 4096; d.N = 64; d.WT = (bf16_t*)(ws + WOFF(L) + WS_WGT); d.ldt = DR; d.kofs = 64 * g; d.nbase = 64 * g; d.mode = 1; d.rowoff = 128; nblk = 2; }
    else { r -= I_RG; const int l = r / I_PP; r -= l * I_PP; d.W = inp(F, 24) + (size_t)l * PLED * D; d.N = D; d.WT = (bf16_t*)(ws + WS_WPP) + (size_t)l * 1024 * PLED; d.ldt = PLED; nblk = 32; }
    d.k0 = 64 * (r / nblk); d.n0 = 32 * (r % nblk);
}

__device__ __forceinline__ void conv_phase(Frame& F, int L) {
    const bf16_t* XR = (const bf16_t*)(F.ws + WS_XR); bf16_t* XC = (bf16_t*)(F.ws + WS_XC);
    const float* cw = inp(F, 4) + (size_t)L * 4 * DR; const float* cb = inp(F, 5) + L * DR;
    const int c0 = (F.tid & 63) * 8;
    float w[4][8], bsv[8];
#pragma unroll
    for (int q = 0; q < 8; ++q) { bsv[q] = cb[c0 + q];
#pragma unroll
        for (int j = 0; j < 4; ++j) w[j][q] = cw[j * DR + c0 + q]; }
    const XSpan sp = xspan(F.G, F.bid, T / 64);
    for (int it = sp.first; it < sp.count; it += sp.stride) { const int task = (sp.base + it) * 8 + (F.tid >> 6); const int t0 = task * 8, ts0 = t0 & (SEQ - 1);
        u32x4 xw[11];
#pragma unroll
        for (int i = 0; i < 11; ++i) xw[i] = (ts0 - 3 + i >= 0) ? *(const u32x4*)(XR + (size_t)(t0 - 3 + i) * DR + c0) : zero4();
#pragma unroll
        for (int r = 0; r < 8; ++r) { float o[8];
#pragma unroll
            for (int q = 0; q < 8; ++q) o[q] = bsv[q];
#pragma unroll
            for (int j = 0; j < 4; ++j) { const u32x4 z = xw[r + j];
                const float xv[8] = {bflo(z.x), bfhi(z.x), bflo(z.y), bfhi(z.y), bflo(z.z), bfhi(z.z), bflo(z.w), bfhi(z.w)};
#pragma unroll
                for (int q = 0; q < 8; ++q) o[q] += w[j][q] * xv[q]; }
            u32x4 ow; ow.x = cvt_pk_bf16(o[0], o[1]); ow.y = cvt_pk_bf16(o[2], o[3]); ow.z = cvt_pk_bf16(o[4], o[5]); ow.w = cvt_pk_bf16(o[6], o[7]);
            *(u32x4*)(XC + (size_t)(t0 + r) * DR + c0) = ow; } }
}

__device__ __forceinline__ void attn_unit(const bf16_t* Q, const bf16_t* K, const bf16_t* VT, bf16_t* O, int b, int h, int jb, int lane) {
    const int r32 = lane & 31, hi = lane >> 5;
    const size_t rowb = (size_t)b * SEQ; const int q0 = jb * 32;
    bf16x8 qr[4];
    const size_t hb = ((size_t)b * NHEAD + h) * SEQ;
    const bf16_t* VTh = VT + ((size_t)b * NHEAD + h) * (SEQ / 32) * 2048;
    { const bf16_t* qp = Q + (hb + q0 + r32) * 64 + hi * 8;
#pragma unroll
      for (int d0 = 0; d0 < 4; ++d0) qr[d0] = *(const bf16x8*)(qp + 16 * d0); }
    f32x16 o0, o1;
#pragma unroll
    for (int r = 0; r < 16; ++r) { o0[r] = 0.f; o1[r] = 0.f; }
    float Pc = 1.0f;
    bf16x8 kfn[4], vfn[2][2];
#define ATT_LOAD(kb_) do { const bf16_t* kp_ = K + (hb + (kb_) + r32) * 64 + hi * 8; \
        _Pragma("unroll") for (int d0 = 0; d0 < 4; ++d0) kfn[d0] = *(const bf16x8*)(kp_ + 16 * d0); \
        const bf16_t* vp_ = VTh + (size_t)((kb_) >> 5) * 2048 + r32 * 32 + 8 * hi; \
        _Pragma("unroll") for (int s = 0; s < 2; ++s) _Pragma("unroll") for (int db = 0; db < 2; ++db) vfn[s][db] = *(const bf16x8*)(vp_ + db * 1024 + 16 * s); } while (0)
    ATT_LOAD(q0);
    for (int kb = q0; kb >= 0; kb -= 32) {
        bf16x8 kf[4], vf[2][2];
#pragma unroll
        for (int d0 = 0; d0 < 4; ++d0) kf[d0] = kfn[d0];
#pragma unroll
        for (int s = 0; s < 2; ++s)
#pragma unroll
            for (int db = 0; db < 2; ++db) vf[s][db] = vfn[s][db];
        if (kb >= 32) ATT_LOAD(kb - 32);
        f32x16 p;
#pragma unroll
        for (int r = 0; r < 16; ++r) p[r] = 0.f;
#pragma unroll
        for (int d0 = 0; d0 < 4; ++d0) p = __builtin_amdgcn_mfma_f32_32x32x16_bf16(kf[d0], qr[d0], p, 0, 0, 0);
        float rr[16], be[16];
        const bool diag = (kb == q0);
#pragma unroll
        for (int r = 0; r < 16; ++r) { const int kr = (r & 3) + 8 * (r >> 2) + 4 * hi;
            const float e = fexp2(p[r]); const float t = frcp(1.0f + e);
            const bool valid = (!diag) || (kr < r32);
            rr[r] = valid ? t : 1.0f; be[r] = valid ? (1.0f - t) : 0.0f; }
        float sfx[16], Gg[4];
#pragma unroll
        for (int g = 0; g < 4; ++g) { sfx[4 * g + 3] = 1.0f; sfx[4 * g + 2] = rr[4 * g + 3]; sfx[4 * g + 1] = sfx[4 * g + 2] * rr[4 * g + 2]; sfx[4 * g] = sfx[4 * g + 1] * rr[4 * g + 1]; Gg[g] = sfx[4 * g] * rr[4 * g]; }
        float Gl[4], Gh[4];
#pragma unroll
        for (int g = 0; g < 4; ++g) { const unsigned gb = __float_as_uint(Gg[g]); auto x = __builtin_amdgcn_permlane32_swap(gb, gb, false, false); Gl[g] = __uint_as_float(x[0]); Gh[g] = __uint_as_float(x[1]); }
        float Eh[4], El[4]; float c = Pc;
#pragma unroll
        for (int g = 3; g >= 0; --g) { Eh[g] = c; c *= Gh[g]; El[g] = c; c *= Gl[g]; }
        Pc = c;
        float w[16];
#pragma unroll
        for (int g = 0; g < 4; ++g) { const float Eg = hi ? Eh[g] : El[g];
#pragma unroll
            for (int cc = 0; cc < 4; ++cc) w[4 * g + cc] = be[4 * g + cc] * (sfx[4 * g + cc] * Eg); }
        u32x4 w0, w1;
        w0.x = cvt_pk_bf16(w[0], w[1]); w0.y = cvt_pk_bf16(w[2], w[3]); w0.z = cvt_pk_bf16(w[4], w[5]); w0.w = cvt_pk_bf16(w[6], w[7]);
        w1.x = cvt_pk_bf16(w[8], w[9]); w1.y = cvt_pk_bf16(w[10], w[11]); w1.z = cvt_pk_bf16(w[12], w[13]); w1.w = cvt_pk_bf16(w[14], w[15]);
        const bf16x8 wf0 = __builtin_bit_cast(bf16x8, w0), wf1 = __builtin_bit_cast(bf16x8, w1);
        o0 = __builtin_amdgcn_mfma_f32_32x32x16_bf16(vf[0][0], wf0, o0, 0, 0, 0);
        o1 = __builtin_amdgcn_mfma_f32_32x32x16_bf16(vf[0][1], wf0, o1, 0, 0, 0);
        o0 = __builtin_amdgcn_mfma_f32_32x32x16_bf16(vf[1][0], wf1, o0, 0, 0, 0);
        o1 = __builtin_amdgcn_mfma_f32_32x32x16_bf16(vf[1][1], wf1, o1, 0, 0, 0);
        if (__all(Pc < 1e-30f)) break;
    }
#undef ATT_LOAD
    bf16_t* op = O + (rowb + q0 + r32) * D + h * 64 + 4 * hi;
#pragma unroll
    for (int g = 0; g < 4; ++g) { u32x2 a, b2; a.x = cvt_pk_bf16(o0[4 * g], o0[4 * g + 1]); a.y = cvt_pk_bf16(o0[4 * g + 2], o0[4 * g + 3]); b2.x = cvt_pk_bf16(o1[4 * g], o1[4 * g + 1]); b2.y = cvt_pk_bf16(o1[4 * g + 2], o1[4 * g + 3]);
        *(u32x2*)(op + 8 * g) = a; *(u32x2*)(op + 32 + 8 * g) = b2; }
}
__device__ __forceinline__ void attn_phase(Frame& F) {
    const bf16_t* Q = (const bf16_t*)(F.ws + WS_Q); const bf16_t* K = (const bf16_t*)(F.ws + WS_K); const bf16_t* VT = (const bf16_t*)(F.ws + WS_VT); bf16_t* O = (bf16_t*)(F.ws + WS_AO);
    const bool pl = (F.G & 7) == 0 && NB * 2 == 8;
    const int first = pl ? (F.bid >> 3) * 8 + F.wave : F.bid * 8 + F.wave, stride = pl ? (F.G >> 3) * 8 : F.G * 8, count = pl ? NHEAD * (SEQ / 64) : NB * NHEAD * (SEQ / 32);
    for (int u = first; u < count; u += stride) {
        const int jb = pl ? (F.bid & 1) * (SEQ / 64) + (u & (SEQ / 64 - 1)) : (u & 127), bh = pl ? ((F.bid & 7) >> 1) * NHEAD + u / (SEQ / 64) : (u >> 7);
        attn_unit(Q, K, VT, O, bh >> 3, bh & 7, jb, F.lane); }
}

__device__ __forceinline__ void scan1_unit(Frame& F, int b, int ck, int cg) {
    const unsigned* DB = (const unsigned*)(F.ws + WS_DB); float* SA = (float*)(F.ws + WS_SUM); float* SH = SA + NB * 64 * DR;
    const int c = cg * 64 + F.lane; const size_t r0 = (size_t)b * SEQ + ck * 64;
    unsigned w[64];
#pragma unroll
    for (int t = 0; t < 64; ++t) w[t] = DB[(r0 + t) * DR + c];
    float A = 1.f, H = 0.f;
#pragma unroll
    for (int t = 0; t < 64; ++t) { const float a = 1.0f - bflo(w[t]); A *= a; H = a * H + bfhi(w[t]); }
    SA[(size_t)(b * 64 + ck) * DR + c] = A; SH[(size_t)(b * 64 + ck) * DR + c] = H;
}
__device__ __forceinline__ void scan2_phase(Frame& F) {
    const unsigned* DB = (const unsigned*)(F.ws + WS_DB); const float* SA = (const float*)(F.ws + WS_SUM); const float* SH = SA + NB * 64 * DR;
    const bf16_t* XG = (const bf16_t*)(F.ws + WS_XG); bf16_t* RI = (bf16_t*)(F.ws + WS_AO);
    LAS bf16_t* stg = (LAS bf16_t*)(F.lds + F.wave * 9216);
    const int lane = F.lane; const XSpan sp = xspan(F.G, F.bid, NB * 64);
    for (int it = sp.first; it < sp.count; it += sp.stride) { const int u = (sp.base + it) * 8 + F.wave; const int cg = u & 7, ck = (u >> 3) & 63, b = u >> 9; const int c = cg * 64 + lane; const size_t r0 = (size_t)b * SEQ + ck * 64;
        unsigned w[64]; u32x4 xg[8]; const int tr = lane >> 3, cq = (lane & 7) * 8;
#pragma unroll
        for (int t = 0; t < 64; ++t) w[t] = DB[(r0 + t) * DR + c];
#pragma unroll
        for (int i = 0; i < 8; ++i) xg[i] = *(const u32x4*)(XG + (r0 + tr + 8 * i) * DR + cg * 64 + cq);
        float H = 0.f;
        { const float* sa = SA + (size_t)(b * 64) * DR + c; const float* sh = SH + (size_t)(b * 64) * DR + c;
          for (int j0 = 0; j0 < ck; j0 += 32) { float ta[32], th[32];
#pragma unroll
              for (int j = 0; j < 32; ++j) { const int jj = (j0 + j < ck) ? (j0 + j) : 0; ta[j] = sa[(size_t)jj * DR]; th[j] = sh[(size_t)jj * DR]; }
#pragma unroll
              for (int j = 0; j < 32; ++j) if (j0 + j < ck) H = ta[j] * H + th[j]; } }
        {
#pragma unroll
          for (int i = 0; i < 8; ++i) *(LAS u32x4*)(stg + (tr + 8 * i) * 72 + cq) = xg[i];
          LDS_WAIT(); asm volatile("" ::: "memory"); }
#pragma unroll
        for (int t = 0; t < 64; ++t) { const float a = 1.0f - bflo(w[t]); H = a * H + bfhi(w[t]);
            const float g = bf2f(stg[t * 72 + lane]); stg[t * 72 + lane] = (bf16_t)(cvt_pk_bf16(H * g, 0.f) & 0xffffu); }
        LDS_WAIT(); asm volatile("" ::: "memory");
        {
#pragma unroll
          for (int i = 0; i < 8; ++i) { const u32x4 o = *(const LAS u32x4*)(stg + (tr + 8 * i) * 72 + cq); *(u32x4*)(RI + (r0 + tr + 8 * i) * D + DA + cg * 64 + cq) = o; }
          LDS_WAIT(); asm volatile("" ::: "memory"); } }
}

__device__ __forceinline__ void route_load_tables(Frame& F, int L) {
    const int tid = F.tid;
    const u32x4* srcp = (const u32x4*)(F.ws + WS_RTAB + (size_t)(L & 1) * 81920); u32x4 tv[10];
#pragma unroll
    for (int i = 0; i < 10; ++i) tv[i] = srcp[tid + 512 * i];
#pragma unroll
    for (int i = 0; i < 10; ++i) *(LAS u32x4*)(F.lds + (tid + 512 * i) * 16) = tv[i];
}
__device__ __forceinline__ void route_phase(Frame& F, int L, int CL) {
    LAS unsigned char* T0h = F.lds;
    LAS unsigned char* T0l = F.lds + 32768;
    LAS unsigned char* T1h = F.lds + 65536;
    LAS unsigned char* T1l = F.lds + 65536 + 8192;
    LAS int* cnt = (LAS int*)(F.lds + 81920); LAS int* bas = cnt + 16; LAS float* tinfo = (LAS float*)(F.lds + 81920 + 128);
    LAS float* lgs0 = (LAS float*)(F.lds + 86016); LAS float* lgs = lgs0 + F.wave * 528;
    const float* wrg = inp(F, 15) + (size_t)L * D * 4; const float* brg = inp(F, 16) + L * 4; const float* wre = inp(F, 17) + (size_t)L * D * 16; const float* bre = inp(F, 18) + L * 16;
    const float* gm = inp(F, 14) + L * D; const float* x = F.out;
    bf16_t* xb = (bf16_t*)(F.ws + WS_XB); unsigned* TOK = (unsigned*)(F.ws + WS_TOK); float* WLs = (float*)(F.ws + WS_WL); float* RS = (float*)(F.ws + WS_RS);
    unsigned* gcnt = F.ctl + CW_CNT + CL * 16 * 64;
    const int lane = F.lane, tid = F.tid;
    const int row = lane & 15, kg = lane >> 4;
    const XSpan sp = xspan(F.G, F.bid, T / 64);
    for (int it = sp.first; it < sp.count; it += sp.stride) { const int blk = sp.base + it;
        if (tid < 16) cnt[tid] = 0;
        __syncthreads();
        const int t0 = blk * 64 + (F.wave & 3) * 16;
        const float* xp = x + (size_t)(t0 + row) * D + 8 * kg;
        bf16_t* xbp = xb + (size_t)(t0 + row) * D + 8 * kg;
        f32x4 acc0 = {0.f, 0.f, 0.f, 0.f}, acc1 = {0.f, 0.f, 0.f, 0.f}; float ss = 0.f;
        { const int ks0 = (F.wave >> 2) * 16;
            f32x4 xa[16], xc[16];
#pragma unroll
            for (int i = 0; i < 16; ++i) { xa[i] = *(const f32x4*)(xp + 32 * (ks0 + i)); xc[i] = *(const f32x4*)(xp + 32 * (ks0 + i) + 4); }
#pragma unroll
            for (int i = 0; i < 16; ++i) { const int ks = ks0 + i; const f32x4 a = xa[i], c = xc[i];
                ss += ((a[0] * a[0] + a[1] * a[1]) + (a[2] * a[2] + a[3] * a[3])) + ((c[0] * c[0] + c[1] * c[1]) + (c[2] * c[2] + c[3] * c[3]));
                u32x4 h; h.x = cvt_pk_bf16(a[0], a[1]); h.y = cvt_pk_bf16(a[2], a[3]); h.z = cvt_pk_bf16(c[0], c[1]); h.w = cvt_pk_bf16(c[2], c[3]);
                u32x4 l; l.x = cvt_pk_bf16(a[0] - bflo(h.x), a[1] - bfhi(h.x)); l.y = cvt_pk_bf16(a[2] - bflo(h.y), a[3] - bfhi(h.y));
                l.z = cvt_pk_bf16(c[0] - bflo(h.z), c[1] - bfhi(h.z)); l.w = cvt_pk_bf16(c[2] - bflo(h.w), c[3] - bfhi(h.w));
                *(u32x4*)(xbp + 32 * ks) = h;
                const bf16x8 ah = __builtin_bit_cast(bf16x8, h), al = __builtin_bit_cast(bf16x8, l);
                const bf16x8 b0h = *(const LAS bf16x8*)(T0h + (ks * 64 + lane) * 16), b0l = *(const LAS bf16x8*)(T0l + (ks * 64 + lane) * 16);
                const int o1 = (ks * 16 + kg * 4 + (row & 3)) * 16;
                const bf16x8 b1h = *(const LAS bf16x8*)(T1h + o1), b1l = *(const LAS bf16x8*)(T1l + o1);
                acc0 = __builtin_amdgcn_mfma_f32_16x16x32_bf16(ah, b0h, acc0, 0, 0, 0); acc0 = __builtin_amdgcn_mfma_f32_16x16x32_bf16(ah, b0l, acc0, 0, 0, 0); acc0 = __builtin_amdgcn_mfma_f32_16x16x32_bf16(al, b0h, acc0, 0, 0, 0);
                acc1 = __builtin_amdgcn_mfma_f32_16x16x32_bf16(ah, b1h, acc1, 0, 0, 0); acc1 = __builtin_amdgcn_mfma_f32_16x16x32_bf16(ah, b1l, acc1, 0, 0, 0); acc1 = __builtin_amdgcn_mfma_f32_16x16x32_bf16(al, b1h, acc1, 0, 0, 0); }
        }
        ss += __shfl_xor(ss, 16); ss += __shfl_xor(ss, 32);
        {
#pragma unroll
            for (int i = 0; i < 4; ++i) { lgs[(4 * kg + i) * 32 + row] = acc0[i]; if (row < 4) lgs[(4 * kg + i) * 32 + 16 + row] = acc1[i]; } }
        if (lane < 16) lgs[512 + lane] = ss;
        __syncthreads();
        if (tid < 64) { const int tk = tid;
            const LAS float* lr = lgs0 + (tk >> 4) * 528 + (tk & 15) * 32; const LAS float* lr2 = lr + 4 * 528;
            const float rstd = 1.0f / sqrtf((lgs0[(tk >> 4) * 528 + 512 + (tk & 15)] + lgs0[((tk >> 4) + 4) * 528 + 512 + (tk & 15)]) * (1.0f / D) + EPS);
            float lg[4];
#pragma unroll
            for (int j = 0; j < 4; ++j) lg[j] = rstd * (lr[j] + lr2[j]) + brg[j];
            int gi = 0; float gmx = lg[0];
#pragma unroll
            for (int j = 1; j < 4; ++j) if (lg[j] > gmx) { gmx = lg[j]; gi = j; }
            float den = 0.f;
#pragma unroll
            for (int j = 0; j < 4; ++j) den += expf(lg[j] - gmx);
            const float gate_group = 1.0f / den;
            float sel[4];
#pragma unroll
            for (int i = 0; i < 4; ++i) sel[i] = rstd * (lr[4 + gi * 4 + i] + lr2[4 + gi * 4 + i]) + bre[gi * 4 + i];
            int i1 = 0; float v1 = sel[0];
#pragma unroll
            for (int i = 1; i < 4; ++i) if (sel[i] > v1) { v1 = sel[i]; i1 = i; }
            int i2 = -1; float v2 = 0.f;
#pragma unroll
            for (int i = 0; i < 4; ++i) if (i != i1 && (i2 < 0 || sel[i] > v2)) { v2 = sel[i]; i2 = i; }
            const float ex = expf(v2 - v1); const float w1 = 1.0f / (1.0f + ex), w2 = ex / (1.0f + ex);
            const int e1 = gi * 4 + i1, e2 = gi * 4 + i2;
            const int p1 = __hip_atomic_fetch_add(cnt + e1, 1, __ATOMIC_RELAXED, __HIP_MEMORY_SCOPE_WORKGROUP);
            const int p2 = __hip_atomic_fetch_add(cnt + e2, 1, __ATOMIC_RELAXED, __HIP_MEMORY_SCOPE_WORKGROUP);
            LAS float* ti = tinfo + tk * 8;
            ti[0] = __int_as_float(e1); ti[1] = __int_as_float(p1); ti[2] = gate_group * w1; ti[3] = __int_as_float(e2); ti[4] = __int_as_float(p2); ti[5] = gate_group * w2; ti[6] = rstd; }
        __syncthreads();
        if (tid < 16) { const int c = cnt[tid]; int b0 = 0; if (c > 0) b0 = (int)__hip_atomic_fetch_add(gcnt + tid * 64, (unsigned)c, __ATOMIC_RELAXED, __HIP_MEMORY_SCOPE_AGENT); bas[tid] = b0; }
        __syncthreads();
        if (tid < 64) { const LAS float* ti = tinfo + tid * 8; const int t = blk * 64 + tid;
            const int e1 = __float_as_int(ti[0]), p1 = __float_as_int(ti[1]), e2 = __float_as_int(ti[3]), p2 = __float_as_int(ti[4]);
            const size_t i1 = (size_t)e1 * LCAP + bas[e1] + p1, i2 = (size_t)e2 * LCAP + bas[e2] + p2;
            TOK[i1] = (unsigned)t; WLs[i1] = ti[2]; RS[i1] = ti[6];
            TOK[i2] = (unsigned)t | 0x80000000u; WLs[i2] = ti[5]; RS[i2] = ti[6]; }
        __syncthreads();
    }
}
__device__ __forceinline__ void group_table(Frame& F, int L) {
    LAS int* tab = (LAS int*)(F.lds + TSTART_OFF);
    if (F.tid < 16) tab[17 + F.tid] = (int)__hip_atomic_load(F.ctl + CW_CNT + (L * 16 + F.tid) * 64, __ATOMIC_RELAXED, __HIP_MEMORY_SCOPE_AGENT);
    __syncthreads();
    if (F.tid == 0) { int a = 0;
        for (int e = 0; e < 16; ++e) { tab[e] = a; a += (tab[17 + e] + 255) >> 8; }
        tab[16] = a; }
    __syncthreads();
}
__device__ __forceinline__ void s3_phase(Frame& F) {
    float* x = F.out; const bf16_t* Y0 = (const bf16_t*)(F.ws + WS_Y0); const bf16_t* Y1 = (const bf16_t*)(F.ws + WS_Y1); bf16_t* xb = (bf16_t*)(F.ws + WS_XB); float* rstd3 = (float*)(F.ws + WS_MISC + 131072);
    const int lane = F.lane; const XSpan sp = xspan(F.G, F.bid, T / 64);
    for (int it2 = 2 * sp.first; it2 < 2 * sp.count; it2 += ((it2 & 1) ? 2 * sp.stride - 1 : 1)) {
        const int m0 = (sp.base + (it2 >> 1)) * 64 + F.wave * 8 + (it2 & 1) * 4;
        f32x4 v[4][4]; u32x2 ya[4][4], yb[4][4];
#pragma unroll
        for (int r = 0; r < 4; ++r) { const int m = m0 + r; {
#pragma unroll
            for (int j = 0; j < 4; ++j) { v[r][j] = ((const f32x4*)(x + (size_t)m * D) + lane)[64 * j]; ya[r][j] = ((const u32x2*)(Y0 + (size_t)m * D) + lane)[64 * j]; yb[r][j] = ((const u32x2*)(Y1 + (size_t)m * D) + lane)[64 * j]; } } }
#pragma unroll
        for (int r = 0; r < 4; ++r) { const int m = m0 + r; { float s = 0.f;
#pragma unroll
            for (int j = 0; j < 4; ++j) { const u32x2 a = ya[r][j], b = yb[r][j]; f32x4 t = v[r][j];
                t[0] += bflo(a.x) + bflo(b.x); t[1] += bfhi(a.x) + bfhi(b.x); t[2] += bflo(a.y) + bflo(b.y); t[3] += bfhi(a.y) + bfhi(b.y);
                v[r][j] = t; s += (t[0] * t[0] + t[1] * t[1]) + (t[2] * t[2] + t[3] * t[3]); }
            s = wave_sum(s); if (lane == 0) rstd3[m] = 1.0f / sqrtf(s * (1.0f / D) + EPS);
            f32x4* xr = (f32x4*)(x + (size_t)m * D) + lane; u32x2* o = (u32x2*)(xb + (size_t)m * D) + lane;
#pragma unroll
            for (int j = 0; j < 4; ++j) { xr[64 * j] = v[r][j]; u32x2 w; w.x = cvt_pk_bf16(v[r][j][0], v[r][j][1]); w.y = cvt_pk_bf16(v[r][j][2], v[r][j][3]); o[64 * j] = w; } } } }
}
__device__ __forceinline__ void final_phase(Frame& F) {
    float* x = F.out; const float* g = inp(F, 25);
    const int lane = F.lane;
    f32x4 gg[4];
#pragma unroll
    for (int j = 0; j < 4; ++j) gg[j] = *((const f32x4*)g + lane + 64 * j);
    const XSpan sp = xspan(F.G, F.bid, T / 64);
    for (int it2 = 2 * sp.first; it2 < 2 * sp.count; it2 += ((it2 & 1) ? 2 * sp.stride - 1 : 1)) { f32x4 v[4][4];
        const int m0 = (sp.base + (it2 >> 1)) * 64 + F.wave * 8 + (it2 & 1) * 4;
#pragma unroll
        for (int r = 0; r < 4; ++r) { const int m = m0 + r; {
#pragma unroll
            for (int j = 0; j < 4; ++j) v[r][j] = ((const f32x4*)(x + (size_t)m * D) + lane)[64 * j]; } }
#pragma unroll
        for (int r = 0; r < 4; ++r) { const int m = m0 + r; { float s = 0.f;
#pragma unroll
            for (int j = 0; j < 4; ++j) s += (v[r][j][0] * v[r][j][0] + v[r][j][1] * v[r][j][1]) + (v[r][j][2] * v[r][j][2] + v[r][j][3] * v[r][j][3]);
            const float rs = 1.0f / sqrtf(wave_sum(s) * (1.0f / D) + EPS); f32x4* xr = (f32x4*)(x + (size_t)m * D) + lane;
#pragma unroll
            for (int j = 0; j < 4; ++j) xr[64 * j] = v[r][j] * rs * gg[j]; } } }
}

constexpr int NPH = 13;
constexpr int PH_TOTAL = DEPTH * NPH + 1;
__global__ void __launch_bounds__(512, 2) trunk_fwd(Args args) {
    extern __shared__ __attribute__((aligned(16))) unsigned char lds[];
    Frame F;
    F.lds = (LAS unsigned char*)lds; F.ws = args.ws; F.ctl = (unsigned*)(args.ws + WS_CTL); F.out = args.out;
    F.tid = threadIdx.x; F.lane = F.tid & 63; F.wave = __builtin_amdgcn_readfirstlane(F.tid >> 6); F.G = gridDim.x;
    F.bid = blockIdx.x;
    const int wave0 = F.wave, grid0 = gridDim.x; int bid0 = blockIdx.x; bool xloc = false;
    for (int u = F.tid; u < (LDS_BYTES - LDSCTL_OFF) / 4; u += 512) ((LAS unsigned*)(F.lds + LDSCTL_OFF))[u] = 0u;
    __syncthreads();
    if (F.tid < 26) ((LAS unsigned long long*)(F.lds + PTAB_OFF))[F.tid] = (unsigned long long)args.in[F.tid];
    __syncthreads();
    XcdBarrier bar; bar.bar = F.ctl + CW_BAR; bar.x = 0; bar.st = nullptr;
#if MK_N_LAUNCHES == 1
    { volatile LAS unsigned* st = (volatile LAS unsigned*)(F.lds + MISC_OFF) + 8; unsigned* bw = F.ctl + CW_BAR;
      bar.bar = bw; bar.x = xb_xcc_id(); bar.st = st;
      if (F.tid == 0) { const unsigned rank = xb_add(&bw[XB_XCNT(bar.x)], 1u); unsigned nloc, nx; xcd_barrier_complete(bw, bar.x, nloc, nx); st[0] = nloc; st[1] = nx;
          bool eq = (grid0 % 8 == 0) && (nx == 8u); unsigned pre = 0u;
          for (unsigned j = 0; j < 16; ++j) { const unsigned c = xb_ld(&bw[XB_XCNT(j)]); if (j < 8) eq = eq && (c == (unsigned)grid0 / 8u); else eq = eq && (c == 0u); if (j < bar.x) pre += c; }
          st[2] = eq ? rank * 8u + bar.x : pre + rank; st[3] = eq ? 1u : 0u; }
      __syncthreads();
      bid0 = (int)__builtin_amdgcn_readfirstlane(st[2]); xloc = __builtin_amdgcn_readfirstlane(st[3]) != 0u; F.bid = bid0; }
#endif
    const int lo = args.ph_lo, hi = args.ph_hi;
#define IN(k) (lo <= (k) && (k) < hi)
#if MK_N_LAUNCHES == 1
#define SEAM(k) do { if (IN(k) && IN((k) + 1)) { xcd_barrier(bar); if (REP_PHASE == 99) xcd_barrier(bar); } } while (0)
#define SEAML(k) do { if (IN(k) && IN((k) + 1)) { xcd_barrier(bar, xloc ? 1 : 0); } } while (0)
#define SEAMP(k) do { if (IN(k) && IN((k) + 1)) { xcd_barrier(bar, xloc ? 2 : 0); } } while (0)
#else
#define SEAM(k) do { } while (0)
#define SEAML(k) do { } while (0)
#define SEAMP(k) do { } while (0)
#endif
    unsigned char* const ws0 = args.ws;
    for (int L = 0; L < DEPTH; ++L) {
        const int P = L * NPH;
        unsigned char* ws;
#define OPQ() do { unsigned long long wq_ = (unsigned long long)ws0; asm volatile("" : "+s"(wq_) :: "memory"); ws = (unsigned char*)(GAS unsigned char*)wq_; int l_; asm volatile("v_mbcnt_lo_u32_b32 %0, -1, 0\n\tv_mbcnt_hi_u32_b32 %0, -1, %0" : "=v"(l_)); int w_ = wave0, b_ = bid0, g_ = grid0; asm volatile("" : "+s"(w_), "+s"(b_), "+s"(g_)); F.lane = l_; F.wave = w_; F.tid = w_ * 64 + l_; F.bid = b_; F.G = g_; } while (0)
#define BG_PREP(nun_, lo_, hi_) do { const int nun__ = (nun_), maxu__ = (nun__ + F.G - 1) / F.G, nheavy__ = nun__ - (maxu__ - 1) * F.G; int nl__ = F.G - nheavy__, li__ = F.bid - nheavy__; \
            if (nl__ < 64) { nl__ = F.G; li__ = F.bid; } if (REP_PHASE != 77 && li__ >= 0) { OPQ(); F.ws = ws; prep_weights(F, L + 1, (lo_), (hi_), li__ * 8 + F.wave, nl__ * 8); } } while (0)
        if (IN(P + 0) && L == 0) { OPQ(); F.ws = ws; prep_phase(F); SEAM(P + 0); }
        if (REP_PHASE == 77 && IN(P + 0) && L > 0) { OPQ(); F.ws = ws; prep_weights(F, L, 0, TR_NITEMS, F.bid * 8 + F.wave, F.G * 8); xcd_barrier(bar); }
        if (IN(P + 1)) { OPQ();
            pg8::Gemm g{(const bf16_t*)(ws + WS_XBW), (const bf16_t*)(ws + WOFF(L) + WS_WIN), D, D, D}; pg8::StaticOrder S; S.init(T, NIN, F.G, F.bid);
            { LAS float* rl = (LAS float*)(F.lds + RSTD_OFF); const float* SSQ = (const float*)(ws + WS_SSQ); Unit u; float rv[RSTD_UNITS];
              if (F.tid < 256) {
#pragma unroll
                  for (int i = 0; i < RSTD_UNITS; ++i) rv[i] = S.next(i, u) ? row_rstd(SSQ, u.pm * 256 + F.tid) : 0.f;
#pragma unroll
                  for (int i = 0; i < RSTD_UNITS; ++i) rl[i * 256 + F.tid] = rv[i]; }
              __syncthreads(); }
            EpiWin E{(const float*)(ws + WS_SSQ), (const LAS float*)(F.lds + RSTD_OFF), (bf16_t*)(ws + WS_Q), (bf16_t*)(ws + WS_K), (bf16_t*)(ws + WS_VT), (bf16_t*)(ws + WS_XR), (bf16_t*)(ws + WS_XG), (bf16_t*)(ws + WS_GA), (bf16_t*)(ws + WS_GR)};
            for (int rep = 0; rep < REPN(1); ++rep) pg8::gemm_phase(F.lds, g, S, E, F.tid);
            if (L + 1 < DEPTH) { for (int rep = 0; rep < REPN(93); ++rep) BG_PREP(T / 256 * (NIN / 256), 0, TR_S1); }
            if (L == 0) { OPQ();
                pg8::Gemm g2{(const bf16_t*)(ws + WS_PB), (const bf16_t*)(ws + WS_WPP), PLED, PLED, PLED}; PPOrder S2; S2.init(DEPTH * T, D, F.G, F.bid);
                EpiBf16 E2{(bf16_t*)(ws + WS_PP), D};
                pg8::gemm_phase(F.lds, g2, S2, E2, F.tid); }
            SEAMP(P + 1); }
        if (IN(P + 2)) { for (int rep = 0; rep < REPN(2); ++rep) { OPQ(); F.ws = ws; conv_phase(F, L); } for (int rep = 0; rep < REPN(20); ++rep) { OPQ(); F.ws = ws; attn_phase(F); } SEAML(P + 2); }
        if (IN(P + 3)) { OPQ();
            pg8::Gemm g{(const bf16_t*)(ws + WS_XC), (const bf16_t*)(ws + WOFF(L) + WS_WGT), DR, DR, 256}; GateOrder S; S.init(T, 1024, F.G, F.bid);
            EpiGates E{(const bf16_t*)(ws + WS_XC), inp(F, 7) + L * DR, inp(F, 9) + L * DR, (const float*)(ws + WS_MISC + 196608 + (L & 1) * 2048), (unsigned*)(ws + WS_DB)};
            for (int rep = 0; rep < REPN(3); ++rep) pg8::gemm_phase(F.lds, g, S, E, F.tid);
            asm volatile("s_waitcnt vmcnt(0)" ::: "memory"); __syncthreads();
            { OPQ(); F.ws = ws; Unit u;
              for (int i = 0; S.next(i, u); ++i) scan1_unit(F, u.pm >> 4, (u.pm & 15) * 4 + (F.wave & 3), 2 * u.pn + (F.wave >> 2)); }
            SEAMP(P + 3); }
        if (IN(P + 5)) { for (int rep = 0; rep < REPN(5); ++rep) { OPQ(); F.ws = ws; scan2_phase(F); } SEAML(P + 5); }
        if (IN(P + 6)) { OPQ();
            pg8::Gemm g{(const bf16_t*)(ws + WS_AO), (const bf16_t*)(ws + WOFF(L) + WS_WAO), D, D, D}; pg8::StaticOrder S; S.init(T, D, F.G, F.bid);
            EpiMerge2 E{(const bf16_t*)(ws + WS_GA), (const bf16_t*)(ws + WS_GR), (bf16_t*)(ws + WS_MG)};
            for (int rep = 0; rep < REPN(6); ++rep) pg8::gemm_phase(F.lds, g, S, E, F.tid);
            SEAML(P + 6); }
        if (IN(P + 7)) { OPQ();
            pg8::Gemm g{(const bf16_t*)(ws + WS_MG), (const bf16_t*)(ws + WOFF(L) + WS_WOUT), D, D, D}; pg8::StaticOrder S; S.init(T, D, F.G, F.bid);
            EpiResid E{(L == 0) ? inp(F, 0) : F.out, F.out};
            pg8::gemm_phase(F.lds, g, S, E, F.tid);
            if (IN(P + 8)) { OPQ(); F.ws = ws; route_load_tables(F, L); }
            SEAML(P + 7); }
        if (IN(P + 8)) { if (!IN(P + 7)) { OPQ(); F.ws = ws; route_load_tables(F, L); __syncthreads(); }
            if (REP_PHASE == 8) { OPQ(); F.ws = ws; route_phase(F, L, L + 4); SEAM(P + 8); } OPQ(); F.ws = ws; route_phase(F, L, L); SEAM(P + 8); }
        if (IN(P + 9)) { OPQ();
            group_table(F, L);
            pg8::Gemm g{(const bf16_t*)(ws + WS_XB), (const bf16_t*)(ws + WOFF(L) + WS_WGU), D, D, D};
            GroupSched<true> S{(const LAS int*)(F.lds + TSTART_OFF), F.G, F.bid, (const unsigned*)(ws + WS_TOK)};
            EpiGU E{(const float*)(ws + WS_RS), (bf16_t*)(ws + WS_ACT)};
            for (int rep = 0; rep < REPN(9); ++rep) pg8::gemm_phase(F.lds, g, S, E, F.tid);
            if (L + 1 < DEPTH) { int nl, li; group_light(F.G, F.bid, ((const LAS int*)(F.lds + TSTART_OFF))[16], nl, li); if (li >= 0) { OPQ(); F.ws = ws; prep_weights(F, L + 1, TR_S1, TR_S2, li * 8 + F.wave, nl * 8); } }
            SEAML(P + 9); }
        if (IN(P + 10)) { OPQ();
            group_table(F, L);
            pg8::Gemm g{(const bf16_t*)(ws + WS_ACT), (const bf16_t*)(ws + WOFF(L) + WS_WDN), DE, DE, DE};
            GroupSched<false> S{(const LAS int*)(F.lds + TSTART_OFF), F.G, F.bid, (const unsigned*)(ws + WS_TOK)};
            EpiDown E{(const unsigned*)(ws + WS_TOK), (const float*)(ws + WS_WL), (bf16_t*)(ws + WS_Y0), (bf16_t*)(ws + WS_Y1)};
            for (int rep = 0; rep < REPN(10); ++rep) pg8::gemm_phase(F.lds, g, S, E, F.tid);
            if (L + 1 < DEPTH) { int nl, li; group_light(F.G, F.bid, ((const LAS int*)(F.lds + TSTART_OFF))[16], nl, li); if (li >= 0) { OPQ(); F.ws = ws; prep_weights(F, L + 1, TR_S2, TR_NITEMS, li * 8 + F.wave, nl * 8); } }
            SEAM(P + 10); }
        if (IN(P + 11)) { OPQ(); F.ws = ws; s3_phase(F); SEAML(P + 11); }
        if (IN(P + 12)) { OPQ();
            pg8::Gemm g{(const bf16_t*)(ws + WS_XB), (const bf16_t*)(ws + WS_WPGL) + (size_t)L * D * D, D, D, D}; pg8::StaticOrder S; S.init(T, D, F.G, F.bid);
            EpiPle E{(const float*)(ws + WS_MISC + 131072), (const bf16_t*)(ws + WS_PP) + (size_t)L * T * D, F.out, F.out, (bf16_t*)(ws + WS_XBW), (float*)(ws + WS_SSQ)};
            pg8::gemm_phase(F.lds, g, S, E, F.tid);
            SEAML(P + 12); }
    }
    if (IN(DEPTH * NPH)) final_phase(F);
#undef IN
#undef SEAM
}

extern "C" void kernel_launch(void* const* d_in, const int* in_sizes, int n_in, void* d_out, int out_size, void* d_ws, size_t ws_size, hipStream_t stream) {
    static int grid = 0;
    if (grid == 0) {
        if (n_in != 26 || in_sizes[0] != T * D || out_size != T * D || ws_size < WS_END) { fprintf(stderr, "kernel_launch: unexpected shapes (n_in %d, in0 %d, out %d, ws %zu need %zu)\n", n_in, n_in > 0 ? in_sizes[0] : -1, out_size, ws_size, (size_t)WS_END); grid = -1; return; }
        int dev = 0, cus = 0, per_cu = 0;
        if (hipGetDevice(&dev) != hipSuccess || hipDeviceGetAttribute(&cus, hipDeviceAttributeMultiprocessorCount, dev) != hipSuccess) { grid = -1; return; }
        if (hipFuncSetAttribute((const void*)trunk_fwd, hipFuncAttributeMaxDynamicSharedMemorySize, LDS_BYTES) != hipSuccess) { fprintf(stderr, "kernel_launch: hipFuncSetAttribute failed\n"); grid = -1; return; }
        if (hipOccupancyMaxActiveBlocksPerMultiprocessor(&per_cu, (const void*)trunk_fwd, 512, LDS_BYTES) != hipSuccess || per_cu < 1) fprintf(stderr, "kernel_launch: occupancy query reports %d\n", per_cu);
        (void)hipGetLastError();
        grid = cus;
    }
    if (grid < 0) return;
    if (hipMemsetAsync((char*)d_ws + WS_CTL, 0, CTL_ZERO_BYTES, stream) != hipSuccess) return;
    Args a{};
    for (int i = 0; i < 26; ++i) a.in[i] = (const float*)d_in[i];
    a.out = (float*)d_out; a.ws = (unsigned char*)d_ws;
#if MK_N_LAUNCHES == 1
    a.ph_lo = 0; a.ph_hi = PH_TOTAL;
    hipLaunchKernelGGL(trunk_fwd, dim3(grid), dim3(512), LDS_BYTES, stream, a);
#else
    for (int ph = 0; ph < PH_TOTAL; ++ph) { a.ph_lo = ph; a.ph_hi = ph + 1; hipLaunchKernelGGL(trunk_fwd, dim3(grid), dim3(512), LDS_BYTES, stream, a); }
#endif
}
```

```cpp
#include <hip/hip_runtime.h>
#include <cstdio>
#include <cstdint>

#ifndef REP_PHASE
#define REP_PHASE -1
#endif
#define REPN(k) ((REP_PHASE == (k)) ? 2 : 1)
#ifndef MK_N_LAUNCHES
#define MK_N_LAUNCHES 1
#endif

#define LAS __attribute__((address_space(3)))
#define GAS __attribute__((address_space(1)))
typedef unsigned short bf16_t;
typedef short bf16x8 __attribute__((ext_vector_type(8)));
typedef float f32x4 __attribute__((ext_vector_type(4)));
typedef float f32x2 __attribute__((ext_vector_type(2)));
typedef float f32x16 __attribute__((ext_vector_type(16)));
typedef unsigned u32x4 __attribute__((ext_vector_type(4)));
typedef unsigned u32x2 __attribute__((ext_vector_type(2)));

constexpr int NB = 4, SEQ = 4096, T = NB * SEQ, D = 1024, DA = 512, DR = 512, NIN = 4608, NE = 16, DE = 512, PLED = 256, DEPTH = 4, NHEAD = 8;
constexpr float EPS = 1e-6f;
constexpr float LOG2E = 1.4426950408889634f;
constexpr float QSCALE = 0.125f * LOG2E;
constexpr int LCAP = 16384;

__device__ __forceinline__ unsigned cvt_pk_bf16(float lo, float hi) { unsigned r; asm volatile("v_cvt_pk_bf16_f32 %0, %1, %2" : "=v"(r) : "v"(lo), "v"(hi)); return r; }
__device__ __forceinline__ u32x4 zero4() { unsigned z; asm volatile("v_mov_b32 %0, 0" : "=v"(z)); return (u32x4){z, z, z, z}; }
__device__ __forceinline__ float bf2f(unsigned short h) { return __uint_as_float(((unsigned)h) << 16); }
__device__ __forceinline__ float bflo(unsigned w) { return __uint_as_float(w << 16); }
__device__ __forceinline__ float bfhi(unsigned w) { return __uint_as_float(w & 0xffff0000u); }
__device__ __forceinline__ float fexp2(float x) { return __builtin_amdgcn_exp2f(x); }
__device__ __forceinline__ float frcp(float x) { return __builtin_amdgcn_rcpf(x); }
__device__ __forceinline__ float sigmoidf_(float x) { return frcp(1.0f + fexp2(-LOG2E * x)); }
__device__ __forceinline__ float gelu_tanh_(float x) { const float u = 1.5957691216057308f * (x + 0.044715f * x * x * x); return x * sigmoidf_(u); }
template <int CTRL> __device__ __forceinline__ float dpp_f(float v) { return __int_as_float(__builtin_amdgcn_update_dpp(0, __float_as_int(v), CTRL, 0xF, 0xF, false)); }
__device__ __forceinline__ float wave_sum(float v) {
    v += dpp_f<0xB1>(v);
    v += dpp_f<0x4E>(v);
    v += dpp_f<0x141>(v);
    v += dpp_f<0x140>(v);
    const float a = __int_as_float(__builtin_amdgcn_readlane(__float_as_int(v), 0)), b = __int_as_float(__builtin_amdgcn_readlane(__float_as_int(v), 16));
    const float c = __int_as_float(__builtin_amdgcn_readlane(__float_as_int(v), 32)), d = __int_as_float(__builtin_amdgcn_readlane(__float_as_int(v), 48));
    return (a + b) + (c + d);
}

namespace pg8 {
constexpr int BM = 256, BK = 64, HALF = 128, HTB = HALF * BK * 2, STAGE_BYTES = 8 * HTB, NXCD = 8, WGM = 8;
__host__ __device__ __forceinline__ int lds_byte(int r, int c) { const int st = (r >> 4) * 2 + (c >> 5), rr = r & 15, cc = c & 31, ob = rr * 64 + cc * 2; return st * 1024 + (ob ^ (((ob >> 9) & 1) << 5)); }
__host__ __device__ __forceinline__ void stage_rc(int b, int& R, int& C) { const int st = b / 1024, sb = b % 1024, swz = sb ^ (((sb >> 9) & 1) << 5); R = (st >> 1) * 16 + swz / 64; C = (st & 1) * 32 + (swz % 64) / 2; }
__host__ __device__ __forceinline__ int perm32(int rho) { const int n = rho >> 4, i = rho & 15; return 8 * (i >> 2) + 4 * n + (i & 3); }

struct Unit { int pm, pn, e, pos0, ne; };
struct Gemm { const bf16_t* A; const bf16_t* Bt; int lda, ldb, K; };

struct StaticOrder {
    int nM, nN, nwg, G, c;
    __device__ __forceinline__ void init(int M, int N, int G_, int c_) { nM = M / BM; nN = N / BM; nwg = nM * nN; G = G_; c = c_; }
    __device__ __forceinline__ bool next(int i, Unit& u) const {
        const long L = (long)i * G + c; if (L >= nwg) return false;
        int wgid = (int)L; { const int q = nwg / NXCD, r = nwg % NXCD, xcd = wgid % NXCD, off = wgid / NXCD; wgid = (xcd < r ? xcd * (q + 1) : r * (q + 1) + (xcd - r) * q) + off; }
        const int nig = WGM * nN, gid = wgid / nig, fm = gid * WGM, gsz = (nM - fm) < WGM ? (nM - fm) : WGM;
        u.pm = fm + ((wgid % nig) % gsz); u.pn = (wgid % nig) / gsz; u.e = 0; u.pos0 = i; u.ne = 0; return true;
    }
    static constexpr bool GATHER = false;
    __device__ __forceinline__ int arow(const Unit& u, int r) const { return u.pm * BM + r; }
    __device__ __forceinline__ int arow0(const Unit& u) const { return u.pm * BM; }
    __device__ __forceinline__ int brow(const Unit& u) const { return u.pn * BM; }
    __device__ __forceinline__ int koff(const Unit&) const { return 0; }
};

template <class Epi, class Sched>
__device__ __forceinline__ void gemm_phase(LAS unsigned char* lds, const Gemm g, const Sched& S, const Epi& E, int tid_) {
    asm volatile("" : "+v"(tid_));
    const int tid = tid_, wid = __builtin_amdgcn_readfirstlane(tid >> 6), lane = tid & 63, wr = wid >> 2, wc = wid & 3, fr = lane & 15, fq = lane >> 4;
    int nt = g.K / BK; asm volatile("" : "+s"(nt));
    unsigned voffB[2];
#pragma unroll
    for (int i = 0; i < 2; ++i) { int R, C; stage_rc(tid * 16 + i * 8192, R, C); const int Rb = Epi::PERM ? ((R & ~31) + perm32(R & 31)) : R;
        voffB[i] = (unsigned)(Rb * g.ldb + C) * 2u; }
    const size_t kstep = (size_t)(BK * 2);
    const size_t hstepB = (size_t)HALF * g.ldb * 2;
    const unsigned ldsw = (unsigned)wid * 1024u;
    const int aoff = lds_byte(wr * 64 + fr, fq * 8), boff = lds_byte(wc * 32 + fr, fq * 8);
#define PG8_SA(b, h) (((b) * 2 + (h)) * HTB)
#define PG8_SB(b, h) ((4 + (b) * 2 + (h)) * HTB)
#define PG8_STAGE(bufoff, gbase, voff) do { _Pragma("unroll") for (int _i = 0; _i < 2; ++_i) \
        __builtin_amdgcn_global_load_lds((const unsigned*)((const char*)(gbase) + (voff)[_i]), (LAS unsigned*)(lds + (bufoff) + ldsw + _i * 8192), 16, 0, 0); } while (0)
#define PG8_LDA(dst, b, h) do { _Pragma("unroll") for (int m = 0; m < 4; ++m) _Pragma("unroll") for (int k = 0; k < 2; ++k) dst[m][k] = *(const LAS bf16x8*)(lds + PG8_SA(b, h) + aoff + m * 2048 + k * 1024); } while (0)
#define PG8_LDB(dst, b, h) do { _Pragma("unroll") for (int n = 0; n < 2; ++n) _Pragma("unroll") for (int k = 0; k < 2; ++k) dst[n][k] = *(const LAS bf16x8*)(lds + PG8_SB(b, h) + boff + n * 2048 + k * 1024); } while (0)
#define PG8_MMA(ai, bj, At, Bt) do { __builtin_amdgcn_s_setprio(1); _Pragma("unroll") for (int m = 0; m < 4; ++m) _Pragma("unroll") for (int n = 0; n < 2; ++n) _Pragma("unroll") for (int k = 0; k < 2; ++k) \
        acc[ai][bj][m][n] = __builtin_amdgcn_mfma_f32_16x16x32_bf16(Bt[n][k], At[m][k], acc[ai][bj][m][n], 0, 0, 0); __builtin_amdgcn_s_setprio(0); } while (0)
#define PG8_WAIT_V(n) asm volatile("s_waitcnt vmcnt(" #n ")" ::: "memory")
#define PG8_WAIT_L(n) asm volatile("s_waitcnt lgkmcnt(" #n ")" ::: "memory")
#define PG8_BAR __builtin_amdgcn_s_barrier()
#define PG8_SCHED __builtin_amdgcn_sched_barrier(0)
#define PG8_AOFF(dst, u) do { _Pragma("unroll") for (int _i = 0; _i < 2; ++_i) { int _R, _C; stage_rc(tid * 16 + _i * 8192, _R, _C); _Pragma("unroll") for (int _h = 0; _h < 2; ++_h) \
        dst[_h][_i] = ((unsigned)S.arow(u, _h * HALF + _R) * (unsigned)g.lda + (unsigned)_C) * 2u; } } while (0)
#define PG8_LOFF(dst) do { _Pragma("unroll") for (int _i = 0; _i < 2; ++_i) { int _R, _C; stage_rc(tid * 16 + _i * 8192, _R, _C); _Pragma("unroll") for (int _h = 0; _h < 2; ++_h) \
        dst[_h][_i] = ((unsigned)(_h * HALF + _R) * (unsigned)g.lda + (unsigned)_C) * 2u; } } while (0)
    Unit cur, nxt; int ui = 0;
    if (!S.next(0, cur)) return;
    f32x4 acc[2][2][4][2];
    if constexpr (Epi::INIT_ACC) E.init(acc, cur, wr, wc, fr, fq);
    else {
#pragma unroll
    for (int a = 0; a < 2; ++a)
#pragma unroll
        for (int b = 0; b < 2; ++b)
#pragma unroll
            for (int m = 0; m < 4; ++m)
#pragma unroll
                for (int n = 0; n < 2; ++n) acc[a][b][m][n] = (f32x4){0.f, 0.f, 0.f, 0.f};
    }
    bf16x8 At[4][2], B0[2][2], B1[2][2];
    constexpr bool GA = Sched::GATHER;
    unsigned ca[2][2], na[2][2];
    const char* cA = (const char*)g.A; const char* nA = cA;
    if constexpr (GA) { PG8_AOFF(ca, cur); }
    else { PG8_LOFF(ca); cA = (const char*)g.A + ((size_t)S.arow0(cur) * g.lda + S.koff(cur)) * 2; }
    const char* cB = (const char*)g.Bt + ((size_t)S.brow(cur) * g.ldb + S.koff(cur)) * 2;
    PG8_STAGE(PG8_SB(0, 0), cB, voffB); PG8_STAGE(PG8_SB(0, 1), cB + hstepB, voffB); PG8_STAGE(PG8_SA(0, 0), cA, ca[0]); PG8_STAGE(PG8_SA(0, 1), cA, ca[1]);
    if (wr == 1) PG8_BAR;
    PG8_WAIT_V(2); PG8_BAR;
    PG8_STAGE(PG8_SB(1, 0), cB + kstep, voffB); PG8_STAGE(PG8_SA(1, 0), cA + kstep, ca[0]); PG8_STAGE(PG8_SB(1, 1), cB + hstepB + kstep, voffB);
    PG8_WAIT_V(6); PG8_BAR;
    for (;;) {
        const bool has_next = S.next(ui + 1, nxt);
        const char* nB = cB; nA = cA;
        if (has_next) { nB = (const char*)g.Bt + ((size_t)S.brow(nxt) * g.ldb + S.koff(nxt)) * 2;
            if constexpr (GA) { PG8_AOFF(na, nxt); } else { nA = (const char*)g.A + ((size_t)S.arow0(nxt) * g.lda + S.koff(nxt)) * 2; } }
        else { if constexpr (GA) {
#pragma unroll
            for (int h = 0; h < 2; ++h)
#pragma unroll
                for (int i = 0; i < 2; ++i) na[h][i] = ca[h][i]; } }
        for (int t = 0; t < nt; t += 2) {
            const bool last = (t == nt - 2);
            if constexpr (Epi::HAS_MID) { if (2 * t == nt) { int mfr = fr, mfq = fq; asm volatile("" : "+v"(mfr), "+v"(mfq)); E.mid(acc, cur, wr, wc, mfr, mfq); } }
            const char* a1 = cA + (size_t)(t + 1) * kstep;
            const char* a2 = last ? nA : cA + (size_t)(t + 2) * kstep; const char* b2 = last ? nB : cB + (size_t)(t + 2) * kstep;
            const char* a3 = a2 + kstep; const char* b3 = b2 + kstep;
            unsigned o2[2][2];
#pragma unroll
            for (int h = 0; h < 2; ++h)
#pragma unroll
                for (int i = 0; i < 2; ++i) { if constexpr (GA) o2[h][i] = last ? na[h][i] : ca[h][i]; else o2[h][i] = ca[h][i]; }
            PG8_LDB(B0, 0, 0); PG8_LDB(B1, 0, 1); PG8_SCHED; PG8_LDA(At, 0, 0); PG8_STAGE(PG8_SA(1, 1), a1, ca[1]);
            PG8_WAIT_V(8); PG8_WAIT_L(0); PG8_BAR; PG8_MMA(0, 0, At, B0); PG8_MMA(0, 1, At, B1); PG8_BAR; PG8_SCHED;
            PG8_LDA(At, 0, 1); PG8_STAGE(PG8_SB(0, 0), b2, voffB); PG8_STAGE(PG8_SB(0, 1), b2 + hstepB, voffB); PG8_STAGE(PG8_SA(0, 0), a2, o2[0]);
            PG8_WAIT_V(8); PG8_WAIT_L(0); PG8_BAR; PG8_MMA(1, 0, At, B0); PG8_MMA(1, 1, At, B1); PG8_BAR; PG8_SCHED;
            PG8_LDB(B0, 1, 0); PG8_LDB(B1, 1, 1); PG8_SCHED; PG8_LDA(At, 1, 0); PG8_STAGE(PG8_SA(0, 1), a2, o2[1]);
            PG8_WAIT_V(8); PG8_WAIT_L(0); PG8_BAR; PG8_MMA(0, 0, At, B0); PG8_MMA(0, 1, At, B1); PG8_BAR; PG8_SCHED;
            PG8_LDA(At, 1, 1); PG8_STAGE(PG8_SB(1, 0), b3, voffB); PG8_STAGE(PG8_SB(1, 1), b3 + hstepB, voffB); PG8_STAGE(PG8_SA(1, 0), a3, o2[0]);
            PG8_WAIT_V(8); PG8_WAIT_L(0); PG8_BAR; PG8_MMA(1, 0, At, B0); PG8_MMA(1, 1, At, B1); PG8_BAR; PG8_SCHED;
        }
        if (wr == 0) PG8_BAR;
        { int efr = fr, efq = fq; asm volatile("" : "+v"(efr), "+v"(efq));
          E(acc, cur, wr, wc, efr, efq); }
        if (!has_next) break;
        if constexpr (Epi::INIT_ACC) E.init(acc, nxt, wr, wc, fr, fq);
        else {
#pragma unroll
        for (int a = 0; a < 2; ++a)
#pragma unroll
            for (int b = 0; b < 2; ++b)
#pragma unroll
                for (int m = 0; m < 4; ++m)
#pragma unroll
                    for (int n = 0; n < 2; ++n) acc[a][b][m][n] = (f32x4){0.f, 0.f, 0.f, 0.f};
        }
        cur = nxt; cB = nB; cA = nA; ++ui;
        if constexpr (GA) {
#pragma unroll
            for (int h = 0; h < 2; ++h)
#pragma unroll
                for (int i = 0; i < 2; ++i) ca[h][i] = na[h][i]; }
        if (wr == 1) PG8_BAR;
    }
    PG8_WAIT_V(0);
    PG8_BAR;
#undef PG8_SA
#undef PG8_SB
#undef PG8_STAGE
#undef PG8_LDA
#undef PG8_LDB
#undef PG8_MMA
#undef PG8_WAIT_V
#undef PG8_WAIT_L
#undef PG8_BAR
#undef PG8_SCHED
#undef PG8_AOFF
#undef PG8_LOFF
}
}
using pg8::Unit;

constexpr size_t MiB = 1u << 20;
constexpr size_t WS_CTL = 0, CTL_ZERO_BYTES = 1 * MiB;
constexpr size_t WS_RTAB = 1 * MiB + 262144;
constexpr size_t WS_MISC = 1 * MiB;
constexpr size_t WS_WIN = 2 * MiB, WS_WGT = 11 * MiB, WS_WAO = 12 * MiB, WS_WRO = 13 * MiB, WS_WOUT = 14 * MiB, WS_WPG = 16 * MiB, WS_WPP = 18 * MiB;
constexpr size_t WS_WGU = 20 * MiB, WS_WDN = 52 * MiB;
constexpr size_t WS_WPGL = 619 * MiB;
constexpr size_t WSET = 66 * MiB;
#define WOFF(L) ((size_t)((L) & 1) * WSET)
constexpr size_t WS_SSQ = 134 * MiB;
constexpr size_t WS_XB = 135 * MiB, WS_PB = 167 * MiB, WS_PP = 199 * MiB;
constexpr size_t WS_Q = 327 * MiB, WS_K = 343 * MiB, WS_VT = 359 * MiB, WS_XR = 375 * MiB, WS_XG = 391 * MiB, WS_GA = 407 * MiB, WS_GR = 439 * MiB, WS_XC = 471 * MiB;
constexpr size_t WS_DB = 487 * MiB, WS_AO = 519 * MiB, WS_RI = 535 * MiB, WS_PART = 551 * MiB, WS_MG = 583 * MiB, WS_SUM = 615 * MiB;
constexpr size_t WS_ACT = 327 * MiB, WS_Y0 = WS_DB, WS_Y1 = WS_AO, WS_TOK = 616 * MiB, WS_WL = 617 * MiB, WS_RS = 618 * MiB;
constexpr size_t WS_XBW = 551 * MiB;
constexpr size_t WS_END = 627 * MiB;
constexpr int CW_BAR = 4096, CW_CNT = 16384;

constexpr int RING_BYTES = 131072, LDSCTL_OFF = RING_BYTES, MISC_OFF = LDSCTL_OFF + 320, LDS_BYTES = 147456;
constexpr int TSTART_OFF = LDSCTL_OFF + 512;
constexpr int RSTD_OFF = LDSCTL_OFF + 2048, RSTD_UNITS = 5;

#define XB_TMO      128
#define XB_XCNT(j)  (256  + 64 * (j))
#define XB_XSUB(j)  (1280 + 64 * (j))
#define XB_XGEN(j)  (2304 + 64 * (j))
#define XB_TOP      3328
#define XB_TOPGEN   3392
#define XCD_BAR_WORDS 3456
#define XB_SPIN_CAP (1u << 18)
__device__ __forceinline__ unsigned xb_ld(unsigned* p)              { return __hip_atomic_load(p, __ATOMIC_RELAXED, __HIP_MEMORY_SCOPE_AGENT); }
__device__ __forceinline__ unsigned xb_add(unsigned* p, unsigned v) { return __hip_atomic_fetch_add(p, v, __ATOMIC_RELAXED, __HIP_MEMORY_SCOPE_AGENT); }
__device__ __forceinline__ unsigned xb_xcc_id() { return (unsigned)__builtin_amdgcn_s_getreg((3 << 11) | 20) & 0xFu; }
#define XB_SPIN(cond, bar) do { unsigned _sp = 0; while (cond) { __builtin_amdgcn_s_sleep(1); \
    if ((++_sp & 255u) == 0u) { if (xb_ld(&(bar)[XB_TMO])) break; if (_sp > XB_SPIN_CAP) { atomicAdd(&(bar)[XB_TMO], 1u); break; } } } } while (0)
struct XcdBarrier { unsigned* bar; unsigned x; volatile LAS unsigned* st; };
__device__ __forceinline__ XcdBarrier xcd_barrier_post(unsigned* bar, volatile LAS unsigned* st) {
    XcdBarrier b; b.bar = bar; b.x = xb_xcc_id(); b.st = st;
    if (threadIdx.x == 0) (void)xb_add(&bar[XB_XCNT(b.x)], 1u);
    return b;
}
__device__ __forceinline__ void xcd_barrier_complete(unsigned* bar, unsigned x, unsigned& nloc, unsigned& nx) {
    const unsigned G = gridDim.x * gridDim.y * gridDim.z;
    unsigned sum, cnt, mine, sp = 0u;
    for (;;) {
        sum = 0u; cnt = 0u; mine = 0u;
#pragma unroll
        for (unsigned j = 0; j < 16; ++j) { const unsigned c = xb_ld(&bar[XB_XCNT(j)]); sum += c; cnt += (c > 0u) ? 1u : 0u; mine = (j == x) ? c : mine; }
        if (sum == G) break;
        __builtin_amdgcn_s_sleep(1);
        if ((++sp & 255u) == 0u) { if (xb_ld(&bar[XB_TMO])) break; if (sp > XB_SPIN_CAP) { atomicAdd(&bar[XB_TMO], 1u); break; } }
    }
    nloc = mine > 0u ? mine : 1u; nx = cnt > 0u ? cnt : 1u;
}
__device__ __forceinline__ void xcd_barrier(const XcdBarrier& b, int mode = 0) {
    const bool local = mode != 0;
    asm volatile("s_waitcnt vmcnt(0)" ::: "memory");
    __syncthreads();
    if (threadIdx.x == 0) {
        unsigned* bar = b.bar;
        __builtin_amdgcn_s_waitcnt(0);
        unsigned nloc = b.st[0], nx = b.st[1];
        if (nloc == 0u) { xcd_barrier_complete(bar, b.x, nloc, nx); b.st[0] = nloc; b.st[1] = nx; }
        const unsigned old = xb_add(&bar[XB_XSUB(b.x)], 1u);
        const unsigned gen = old / nloc;
        if (old + 1u == (gen + 1u) * nloc) {
            if (!local) {
            __builtin_amdgcn_fence(__ATOMIC_RELEASE, "agent");
            asm volatile("s_waitcnt vmcnt(0)" ::: "memory");
            const unsigned og = xb_add(&bar[XB_TOP], 1u);
            const unsigned tg = og / nx;
            if (og + 1u == (tg + 1u) * nx) xb_add(&bar[XB_TOPGEN], 1u);
            else XB_SPIN(xb_ld(&bar[XB_TOPGEN]) == tg, bar);
            }
            else if (mode == 2) {
                if ((b.x & 1u) == 0u) { __builtin_amdgcn_fence(__ATOMIC_RELEASE, "agent"); asm volatile("s_waitcnt vmcnt(0)" ::: "memory"); }
                else XB_SPIN(xb_ld(&bar[XB_XGEN(b.x - 1u)]) <= gen, bar);
            }
            __builtin_amdgcn_fence(__ATOMIC_ACQUIRE, "agent");
            xb_add(&bar[XB_XGEN(b.x)], 1u);
            asm volatile("s_waitcnt vmcnt(0)" ::: "memory");
        } else {
            XB_SPIN(xb_ld(&bar[XB_XGEN(b.x)]) == gen, bar);
            __builtin_amdgcn_fence(__ATOMIC_ACQUIRE, "agent");
            asm volatile("s_waitcnt vmcnt(0)" ::: "memory");
        }
    }
    __syncthreads();
}

struct Args { const float* in[26]; float* out; unsigned char* ws; int ph_lo, ph_hi; };
struct Frame {
    LAS unsigned char* lds;
    unsigned* ctl;
    unsigned char* ws;
    int tid, lane, wave, G, bid;
    float* out;
};
struct XSpan { int base, first, stride, count; };
__device__ __forceinline__ XSpan xspan(int G, int bid, int n) { XSpan s; if ((G & 7) == 0) { s.base = (bid & 7) * (n >> 3); s.first = bid >> 3; s.stride = G >> 3; s.count = n >> 3; } else { s.base = 0; s.first = bid; s.stride = G; s.count = n; } return s; }
constexpr int PTAB_OFF = LDSCTL_OFF + 1024;
__device__ __forceinline__ const float* inp(const Frame& F, int k) {
    const unsigned long long v = ((const LAS unsigned long long*)(F.lds + PTAB_OFF))[k];
    const unsigned lo = __builtin_amdgcn_readfirstlane((unsigned)v), hi = __builtin_amdgcn_readfirstlane((unsigned)(v >> 32));
    return (const float*)(const GAS float*)(((unsigned long long)hi << 32) | lo);
}
#define LDS_WAIT() asm volatile("s_waitcnt lgkmcnt(0)" ::: "memory")

__device__ __forceinline__ float row_rstd(const float* SSQ, int row) {
    const f32x4* p = (const f32x4*)(SSQ + (size_t)row * 16); const f32x4 a = p[0], b = p[1], c = p[2], d = p[3];
    const float s = (((a[0] + a[1]) + (a[2] + a[3])) + ((b[0] + b[1]) + (b[2] + b[3]))) + (((c[0] + c[1]) + (c[2] + c[3])) + ((d[0] + d[1]) + (d[2] + d[3])));
    return 1.0f / sqrtf(s * (1.0f / D) + EPS);
}
typedef f32x4 AccT[2][2][4][2];

struct EpiWin {
    static constexpr bool PERM = true, INIT_ACC = false, HAS_MID = false;
    const float* SSQ; const LAS float* RL; bf16_t *Q, *K, *VT, *XR, *XG, *GA, *GR;
    __device__ __forceinline__ void operator()(const AccT& acc, const Unit& u, int wr, int wc, int fr, int fq) const {
        const int pn = u.pn, row0 = u.pm * 256 + wr * 64 + fr, cl = wc * 32 + 8 * fq;
        float rsv[2][4];
        if (u.pos0 < RSTD_UNITS) {
#pragma unroll
            for (int ai = 0; ai < 2; ++ai)
#pragma unroll
                for (int m = 0; m < 4; ++m) rsv[ai][m] = RL[u.pos0 * 256 + ai * 128 + wr * 64 + m * 16 + fr];
        } else { const int l = fr + 16 * fq; const float r0 = row_rstd(SSQ, u.pm * 256 + wr * 64 + l), r1 = row_rstd(SSQ, u.pm * 256 + 128 + wr * 64 + l);
#pragma unroll
          for (int m = 0; m < 4; ++m) { rsv[0][m] = __shfl(r0, 16 * m + fr); rsv[1][m] = __shfl(r1, 16 * m + fr); } }
        if (pn == 4 || pn == 5) {
            const int cb = (pn - 4) * 256;
#pragma unroll
            for (int ai = 0; ai < 2; ++ai)
#pragma unroll
                for (int m = 0; m < 4; ++m) { const int row = row0 + ai * 128 + m * 16; const float rs = rsv[ai][m];
                    const int b = row >> 12, ts = row & (SEQ - 1), o = ts & 15;
                    const int kin = (ts & 16) + ((o & 3) | (((o >> 3) & 1) << 2) | (((o >> 2) & 1) << 3));
                    const size_t tb = ((size_t)b * NHEAD * (SEQ / 32) + (ts >> 5)) * 2048 + kin;
#pragma unroll
                    for (int bj = 0; bj < 2; ++bj)
#pragma unroll
                        for (int n = 0; n < 2; ++n) { const f32x4 v = acc[ai][bj][m][n] * rs; const int c = cb + bj * 128 + cl + 4 * n;
#pragma unroll
                            for (int q = 0; q < 4; ++q) { const int cc = c + q; VT[tb + (size_t)(cc >> 6) * ((SEQ / 32) * 2048) + (cc & 63) * 32] = (bf16_t)(cvt_pk_bf16(v[q], 0.f) & 0xffffu); } } }
            return;
        }
        if (pn < 4) {
            bf16_t* base = Q + (size_t)(pn >> 1) * (size_t)((WS_K - WS_Q) / 2); const float sc = (pn < 2) ? QSCALE : 1.f; const int c0 = (pn & 1) * 256;
#pragma unroll
            for (int ai = 0; ai < 2; ++ai)
#pragma unroll
                for (int m = 0; m < 4; ++m) { const int row = row0 + ai * 128 + m * 16; const float rs = rsv[ai][m] * sc; const int b = row >> 12, ts = row & (SEQ - 1);
#pragma unroll
                    for (int bj = 0; bj < 2; ++bj) { const f32x4 v0 = acc[ai][bj][m][0] * rs, v1 = acc[ai][bj][m][1] * rs; const int c = c0 + bj * 128 + cl;
                        u32x4 w; w.x = cvt_pk_bf16(v0[0], v0[1]); w.y = cvt_pk_bf16(v0[2], v0[3]); w.z = cvt_pk_bf16(v1[0], v1[1]); w.w = cvt_pk_bf16(v1[2], v1[3]);
                        *(u32x4*)(base + (((size_t)b * NHEAD + (c >> 6)) * SEQ + ts) * 64 + (c & 63)) = w; }
                    asm volatile("" ::: "memory"); }
            return;
        }
        int act = 0, pitch = 512, c0; float sc = 1.f; size_t boff;
        if (pn < 8) { boff = WS_XR - WS_Q; c0 = (pn - 6) * 256; }
        else if (pn < 10) { boff = WS_XG - WS_Q; c0 = (pn - 8) * 256; act = 1; }
        else if (pn < 14) { boff = WS_GA - WS_Q; c0 = (pn - 10) * 256; act = 2; pitch = 1024; }
        else { boff = WS_GR - WS_Q; c0 = (pn - 14) * 256; act = 2; pitch = 1024; }
        bf16_t* base = (bf16_t*)((unsigned char*)Q + boff);
#pragma unroll
        for (int ai = 0; ai < 2; ++ai)
#pragma unroll
            for (int m = 0; m < 4; ++m) { const int row = row0 + ai * 128 + m * 16; const float rs = rsv[ai][m] * sc;
#pragma unroll
                for (int bj = 0; bj < 2; ++bj) { f32x4 v0 = acc[ai][bj][m][0] * rs, v1 = acc[ai][bj][m][1] * rs;
                    if (act == 1) {
#pragma unroll
                        for (int q = 0; q < 4; ++q) { v0[q] = gelu_tanh_(v0[q]); v1[q] = gelu_tanh_(v1[q]); }
                    } else if (act == 2) {
#pragma unroll
                        for (int q = 0; q < 4; ++q) { v0[q] = sigmoidf_(v0[q]); v1[q] = sigmoidf_(v1[q]); }
                    }
                    u32x4 w; w.x = cvt_pk_bf16(v0[0], v0[1]); w.y = cvt_pk_bf16(v0[2], v0[3]); w.z = cvt_pk_bf16(v1[0], v1[1]); w.w = cvt_pk_bf16(v1[2], v1[3]);
                    *(u32x4*)(base + (size_t)row * pitch + c0 + bj * 128 + cl) = w; }
                asm volatile("" ::: "memory"); }
    }
};

struct EpiGates {
    static constexpr bool PERM = true, INIT_ACC = false, HAS_MID = false;
    const bf16_t* XC; const float *ba, *bx, *cA; unsigned* DB;
    __device__ __forceinline__ void operator()(const AccT& acc, const Unit& u, int wr, int wc, int fr, int fq) const {
        const int row0 = u.pm * 256 + wr * 64 + fr, ch0 = u.pn * 128 + wc * 32 + 8 * fq;
        float vba[8], vbx[8], vca[8];
#pragma unroll
        for (int q = 0; q < 8; ++q) { vba[q] = ba[ch0 + q]; vbx[q] = bx[ch0 + q]; vca[q] = cA[ch0 + q]; }
        u32x4 xwv[2][4];
#pragma unroll
        for (int ai = 0; ai < 2; ++ai)
#pragma unroll
            for (int m = 0; m < 4; ++m) xwv[ai][m] = *(const u32x4*)(XC + (size_t)(row0 + ai * 128 + m * 16) * DR + ch0);
#pragma unroll
        for (int ai = 0; ai < 2; ++ai)
#pragma unroll
            for (int m = 0; m < 4; ++m) { const int row = row0 + ai * 128 + m * 16;
                const u32x4 xw = xwv[ai][m];
                float xc[8] = {bflo(xw.x), bfhi(xw.x), bflo(xw.y), bfhi(xw.y), bflo(xw.z), bfhi(xw.z), bflo(xw.w), bfhi(xw.w)};
                unsigned od[8];
#pragma unroll
                for (int q = 0; q < 8; ++q) { const float pa = acc[ai][0][m][q >> 2][q & 3], px = acc[ai][1][m][q >> 2][q & 3];
                    const float r = sigmoidf_(pa + vba[q]), ig = sigmoidf_(px + vbx[q]);
                    const float la = vca[q] * r;
                    const float om1 = (la > -0.25f) ? (-la * (1.f + 0.5f * la * (1.f + (1.f / 3.f) * la * (1.f + 0.25f * la * (1.f + 0.2f * la))))) : (1.f - fexp2(LOG2E * la));
                    const float om2 = om1 * (2.f - om1);
                    od[q] = cvt_pk_bf16(om1, __builtin_amdgcn_sqrtf(om2) * (ig * xc[q])); }
                *(u32x4*)(DB + (size_t)row * DR + ch0) = (u32x4){od[0], od[1], od[2], od[3]}; *(u32x4*)(DB + (size_t)row * DR + ch0 + 4) = (u32x4){od[4], od[5], od[6], od[7]};
                asm volatile("" ::: "memory"); }
    }
};

struct EpiMerge {
    static constexpr bool PERM = true, INIT_ACC = false, HAS_MID = false;
    const bf16_t *GA, *GR; bf16_t *PART, *MG;
    __device__ __forceinline__ void operator()(const AccT& acc, const Unit& u, int wr, int wc, int fr, int fq) const {
        const int row0 = u.pm * 256 + wr * 64 + fr, c00 = u.pn * 256 + wc * 32 + 8 * fq;
        const bf16_t* G = GA + (size_t)u.e * (size_t)((WS_GR - WS_GA) / 2);
        bf16_t* OUT = PART + (size_t)u.e * (size_t)((WS_MG - WS_PART) / 2);
#pragma unroll
        for (int ai = 0; ai < 2; ++ai)
#pragma unroll
            for (int mp = 0; mp < 2; ++mp) {
                u32x4 gw[2][2], pw[2][2];
#pragma unroll
                for (int mm = 0; mm < 2; ++mm)
#pragma unroll
                    for (int bj = 0; bj < 2; ++bj) { const size_t o = (size_t)(row0 + ai * 128 + (2 * mp + mm) * 16) * D + c00 + bj * 128;
                        gw[mm][bj] = *(const u32x4*)(G + o); pw[mm][bj] = u.e ? *(const u32x4*)(PART + o) : zero4(); }
#pragma unroll
                for (int mm = 0; mm < 2; ++mm)
#pragma unroll
                    for (int bj = 0; bj < 2; ++bj) { const int m = 2 * mp + mm; const size_t o = (size_t)(row0 + ai * 128 + m * 16) * D + c00 + bj * 128;
                        const u32x4 g = gw[mm][bj], p = pw[mm][bj];
                        const f32x4 g0 = {bflo(g.x), bfhi(g.x), bflo(g.y), bfhi(g.y)}, g1 = {bflo(g.z), bfhi(g.z), bflo(g.w), bfhi(g.w)};
                        const f32x4 v0 = g0 * acc[ai][bj][m][0] + (f32x4){bflo(p.x), bfhi(p.x), bflo(p.y), bfhi(p.y)}, v1 = g1 * acc[ai][bj][m][1] + (f32x4){bflo(p.z), bfhi(p.z), bflo(p.w), bfhi(p.w)};
                        u32x4 w; w.x = cvt_pk_bf16(v0[0], v0[1]); w.y = cvt_pk_bf16(v0[2], v0[3]); w.z = cvt_pk_bf16(v1[0], v1[1]); w.w = cvt_pk_bf16(v1[2], v1[3]);
                        *(u32x4*)(OUT + o) = w; }
                asm volatile("" ::: "memory"); }
    }
};
struct EpiMerge2 {
    static constexpr bool PERM = true, INIT_ACC = false, HAS_MID = true;
    const bf16_t *GA, *GR; bf16_t* MG;
    __device__ __forceinline__ void mid(AccT& acc, const Unit& u, int wr, int wc, int fr, int fq) const {
        const int row0 = u.pm * 256 + wr * 64 + fr, c00 = u.pn * 256 + wc * 32 + 8 * fq;
#pragma unroll
        for (int ai = 0; ai < 2; ++ai)
#pragma unroll
            for (int mp = 0; mp < 2; ++mp) {
                u32x4 ga[2][2], gr[2][2];
#pragma unroll
                for (int mm = 0; mm < 2; ++mm)
#pragma unroll
                    for (int bj = 0; bj < 2; ++bj) { const size_t o = (size_t)(row0 + ai * 128 + (2 * mp + mm) * 16) * D + c00 + bj * 128; ga[mm][bj] = *(const u32x4*)(GA + o); gr[mm][bj] = *(const u32x4*)(GR + o); }
#pragma unroll
                for (int mm = 0; mm < 2; ++mm)
#pragma unroll
                    for (int bj = 0; bj < 2; ++bj) { const int m = 2 * mp + mm; const u32x4 a = ga[mm][bj], r = gr[mm][bj];
                        const f32x4 r0 = {frcp(fmaxf(bflo(r.x), 1e-30f)), frcp(fmaxf(bfhi(r.x), 1e-30f)), frcp(fmaxf(bflo(r.y), 1e-30f)), frcp(fmaxf(bfhi(r.y), 1e-30f))};
                        const f32x4 r1 = {frcp(fmaxf(bflo(r.z), 1e-30f)), frcp(fmaxf(bfhi(r.z), 1e-30f)), frcp(fmaxf(bflo(r.w), 1e-30f)), frcp(fmaxf(bfhi(r.w), 1e-30f))};
                        acc[ai][bj][m][0] = acc[ai][bj][m][0] * ((f32x4){bflo(a.x), bfhi(a.x), bflo(a.y), bfhi(a.y)} * r0);
                        acc[ai][bj][m][1] = acc[ai][bj][m][1] * ((f32x4){bflo(a.z), bfhi(a.z), bflo(a.w), bfhi(a.w)} * r1); }
                asm volatile("" ::: "memory"); }
    }
    __device__ __forceinline__ void operator()(const AccT& acc, const Unit& u, int wr, int wc, int fr, int fq) const {
        const int row0 = u.pm * 256 + wr * 64 + fr, c00 = u.pn * 256 + wc * 32 + 8 * fq;
#pragma unroll
        for (int ai = 0; ai < 2; ++ai)
#pragma unroll
            for (int mp = 0; mp < 2; ++mp) {
                u32x4 gr[2][2];
#pragma unroll
                for (int mm = 0; mm < 2; ++mm)
#pragma unroll
                    for (int bj = 0; bj < 2; ++bj) gr[mm][bj] = *(const u32x4*)(GR + (size_t)(row0 + ai * 128 + (2 * mp + mm) * 16) * D + c00 + bj * 128);
#pragma unroll
                for (int mm = 0; mm < 2; ++mm)
#pragma unroll
                    for (int bj = 0; bj < 2; ++bj) { const int m = 2 * mp + mm; const u32x4 r = gr[mm][bj];
                        const f32x4 v0 = acc[ai][bj][m][0] * (f32x4){fmaxf(bflo(r.x), 1e-30f), fmaxf(bfhi(r.x), 1e-30f), fmaxf(bflo(r.y), 1e-30f), fmaxf(bfhi(r.y), 1e-30f)};
                        const f32x4 v1 = acc[ai][bj][m][1] * (f32x4){fmaxf(bflo(r.z), 1e-30f), fmaxf(bfhi(r.z), 1e-30f), fmaxf(bflo(r.w), 1e-30f), fmaxf(bfhi(r.w), 1e-30f)};
                        u32x4 w; w.x = cvt_pk_bf16(v0[0], v0[1]); w.y = cvt_pk_bf16(v0[2], v0[3]); w.z = cvt_pk_bf16(v1[0], v1[1]); w.w = cvt_pk_bf16(v1[2], v1[3]);
                        *(u32x4*)(MG + (size_t)(row0 + ai * 128 + m * 16) * D + c00 + bj * 128) = w; }
                asm volatile("" ::: "memory"); }
    }
};
struct GateOrder : pg8::StaticOrder {
    __device__ __forceinline__ int koff(const Unit& u) const { return 256 * (u.pn >> 1); }
};
struct PairOrder : pg8::StaticOrder {
    __device__ __forceinline__ bool next(int i, Unit& u) const { const bool ok = pg8::StaticOrder::next(i >> 1, u); u.e = i & 1; return ok; }
    __device__ __forceinline__ int arow(const Unit& u, int r) const { return u.e * T + u.pm * 256 + r; }
    __device__ __forceinline__ int arow0(const Unit& u) const { return u.e * T + u.pm * 256; }
    __device__ __forceinline__ int brow(const Unit& u) const { return u.e * 1024 + u.pn * 256; }
};
struct PPOrder : pg8::StaticOrder {
    __device__ __forceinline__ int arow(const Unit& u, int r) const { return u.pm * 256 + r; }
    __device__ __forceinline__ int arow0(const Unit& u) const { return u.pm * 256; }
    __device__ __forceinline__ int brow(const Unit& u) const { return (u.pm >> 6) * 1024 + u.pn * 256; }
};
struct EpiResid {
    static constexpr bool PERM = true, INIT_ACC = true, HAS_MID = false;
    const bf16_t* XI; bf16_t* XO;
    __device__ __forceinline__ void init(AccT& acc, const Unit& u, int wr, int wc, int fr, int fq) const {
        const int row0 = u.pm * 256 + wr * 64 + fr, c00 = u.pn * 256 + wc * 32 + 8 * fq;
#pragma unroll
        for (int ai = 0; ai < 2; ++ai)
#pragma unroll
            for (int m = 0; m < 4; ++m) { const size_t ro = (size_t)(row0 + ai * 128 + m * 16) * D;
#pragma unroll
                for (int bj = 0; bj < 2; ++bj) { const u32x4 z = *(const u32x4*)(XI + ro + c00 + bj * 128);
                    acc[ai][bj][m][0] = (f32x4){bflo(z.x), bfhi(z.x), bflo(z.y), bfhi(z.y)}; acc[ai][bj][m][1] = (f32x4){bflo(z.z), bfhi(z.z), bflo(z.w), bfhi(z.w)}; } }
    }
    __device__ __forceinline__ void operator()(const AccT& acc, const Unit& u, int wr, int wc, int fr, int fq) const {
        const int row0 = u.pm * 256 + wr * 64 + fr, c00 = u.pn * 256 + wc * 32 + 8 * fq;
#pragma unroll
        for (int ai = 0; ai < 2; ++ai)
#pragma unroll
            for (int m = 0; m < 4; ++m) { const size_t ro = (size_t)(row0 + ai * 128 + m * 16) * D;
#pragma unroll
                for (int bj = 0; bj < 2; ++bj) { const f32x4 v0 = acc[ai][bj][m][0], v1 = acc[ai][bj][m][1];
                    u32x4 w; w.x = cvt_pk_bf16(v0[0], v0[1]); w.y = cvt_pk_bf16(v0[2], v0[3]); w.z = cvt_pk_bf16(v1[0], v1[1]); w.w = cvt_pk_bf16(v1[2], v1[3]);
                    *(u32x4*)(XO + ro + c00 + bj * 128) = w; }
                asm volatile("" ::: "memory"); }
    }
};
struct EpiBf16 {
    static constexpr bool PERM = true, INIT_ACC = false, HAS_MID = false;
    bf16_t* O; int ldc;
    __device__ __forceinline__ void operator()(const AccT& acc, const Unit& u, int wr, int wc, int fr, int fq) const {
        const int row0 = u.pm * 256 + wr * 64 + fr, c00 = u.pn * 256 + wc * 32 + 8 * fq;
#pragma unroll
        for (int ai = 0; ai < 2; ++ai)
#pragma unroll
            for (int m = 0; m < 4; ++m) { const int row = row0 + ai * 128 + m * 16;
#pragma unroll
                for (int bj = 0; bj < 2; ++bj) { const f32x4 v0 = acc[ai][bj][m][0], v1 = acc[ai][bj][m][1];
                    u32x4 w; w.x = cvt_pk_bf16(v0[0], v0[1]); w.y = cvt_pk_bf16(v0[2], v0[3]); w.z = cvt_pk_bf16(v1[0], v1[1]); w.w = cvt_pk_bf16(v1[2], v1[3]);
                    *(u32x4*)(O + (size_t)row * ldc + c00 + bj * 128) = w; }
                asm volatile("" ::: "memory"); }
    }
};
struct EpiGU {
    static constexpr bool PERM = true, INIT_ACC = false, HAS_MID = false;
    const float* RS; bf16_t* ACT;
    __device__ __forceinline__ void operator()(const AccT& acc, const Unit& u, int wr, int wc, int fr, int fq) const {
        const int r0 = wr * 64 + fr, c0 = u.pn * 128 + wc * 32 + 8 * fq;
        float rsv[2][4];
#pragma unroll
        for (int ai = 0; ai < 2; ++ai)
#pragma unroll
            for (int m = 0; m < 4; ++m) rsv[ai][m] = RS[(size_t)u.e * LCAP + u.pos0 + r0 + ai * 128 + m * 16];
#pragma unroll
        for (int ai = 0; ai < 2; ++ai)
#pragma unroll
            for (int m = 0; m < 4; ++m) { const int r = r0 + ai * 128 + m * 16; const float rs = rsv[ai][m];
                float o[8];
#pragma unroll
                for (int q = 0; q < 8; ++q) { const float gg = rs * acc[ai][0][m][q >> 2][q & 3], uu = rs * acc[ai][1][m][q >> 2][q & 3]; o[q] = gg * sigmoidf_(gg) * uu; }
                u32x4 w; w.x = cvt_pk_bf16(o[0], o[1]); w.y = cvt_pk_bf16(o[2], o[3]); w.z = cvt_pk_bf16(o[4], o[5]); w.w = cvt_pk_bf16(o[6], o[7]);
                *(u32x4*)(ACT + (size_t)(u.pm * 256 + r) * DE + c0) = w;
                asm volatile("" ::: "memory"); }
    }
};
struct EpiDown {
    static constexpr bool PERM = true, INIT_ACC = false, HAS_MID = false;
    const unsigned* TOK; const float* WL; bf16_t *Y0, *Y1;
    __device__ __forceinline__ void operator()(const AccT& acc, const Unit& u, int wr, int wc, int fr, int fq) const {
        const int r0 = wr * 64 + fr, c00 = u.pn * 256 + wc * 32 + 8 * fq;
        unsigned tkv[2][4]; float wgv[2][4];
#pragma unroll
        for (int ai = 0; ai < 2; ++ai)
#pragma unroll
            for (int m = 0; m < 4; ++m) { const int p = u.pos0 + r0 + ai * 128 + m * 16; const bool ok = p < u.ne; tkv[ai][m] = ok ? TOK[(size_t)u.e * LCAP + p] : 0u; wgv[ai][m] = ok ? WL[(size_t)u.e * LCAP + p] : 0.f; }
#pragma unroll
        for (int ai = 0; ai < 2; ++ai)
#pragma unroll
            for (int m = 0; m < 4; ++m) { const int p = u.pos0 + r0 + ai * 128 + m * 16;
                if (p < u.ne) { const unsigned tk = tkv[ai][m]; const float wg = wgv[ai][m];
                    bf16_t* dst = ((tk >> 31) ? Y1 : Y0) + (size_t)(tk & 0x7fffffffu) * D + c00;
#pragma unroll
                    for (int bj = 0; bj < 2; ++bj) { const f32x4 v0 = acc[ai][bj][m][0] * wg, v1 = acc[ai][bj][m][1] * wg;
                        u32x4 w; w.x = cvt_pk_bf16(v0[0], v0[1]); w.y = cvt_pk_bf16(v0[2], v0[3]); w.z = cvt_pk_bf16(v1[0], v1[1]); w.w = cvt_pk_bf16(v1[2], v1[3]);
                        *(u32x4*)(dst + bj * 128) = w; } }
                asm volatile("" ::: "memory"); }
    }
};
struct EpiPle {
    static constexpr bool PERM = true, INIT_ACC = false, HAS_MID = false;
    const float* rstd; const bf16_t* PP; const bf16_t* X; bf16_t* XO; float* SSQ;
    __device__ __forceinline__ void operator()(const AccT& acc, const Unit& u, int wr, int wc, int fr, int fq) const {
        const int row0 = u.pm * 256 + wr * 64 + fr, c00 = u.pn * 256 + wc * 32 + 8 * fq;
        u32x4 gp[2][4][2];
#pragma unroll
        for (int ai = 0; ai < 2; ++ai) {
            float rsv[4]; u32x4 ppv[4][2];
#pragma unroll
            for (int m = 0; m < 4; ++m) { const int row = row0 + ai * 128 + m * 16; rsv[m] = rstd[row];
#pragma unroll
                for (int bj = 0; bj < 2; ++bj) ppv[m][bj] = *(const u32x4*)(PP + (size_t)row * D + c00 + bj * 128); }
#pragma unroll
            for (int m = 0; m < 4; ++m)
#pragma unroll
                for (int bj = 0; bj < 2; ++bj) { const u32x4 pw = ppv[m][bj]; const f32x4 a = acc[ai][bj][m][0] * rsv[m], b = acc[ai][bj][m][1] * rsv[m];
                    gp[ai][m][bj].x = cvt_pk_bf16(sigmoidf_(a[0]) * bflo(pw.x), sigmoidf_(a[1]) * bfhi(pw.x));
                    gp[ai][m][bj].y = cvt_pk_bf16(sigmoidf_(a[2]) * bflo(pw.y), sigmoidf_(a[3]) * bfhi(pw.y));
                    gp[ai][m][bj].z = cvt_pk_bf16(sigmoidf_(b[0]) * bflo(pw.z), sigmoidf_(b[1]) * bfhi(pw.z));
                    gp[ai][m][bj].w = cvt_pk_bf16(sigmoidf_(b[2]) * bflo(pw.w), sigmoidf_(b[3]) * bfhi(pw.w)); }
            asm volatile("" ::: "memory"); }
#pragma unroll
        for (int ai = 0; ai < 2; ++ai) {
            u32x4 xv[4][2];
#pragma unroll
            for (int m = 0; m < 4; ++m)
#pragma unroll
                for (int bj = 0; bj < 2; ++bj) xv[m][bj] = *(const u32x4*)(X + (size_t)(row0 + ai * 128 + m * 16) * D + c00 + bj * 128);
#pragma unroll
            for (int m = 0; m < 4; ++m) { const int row = row0 + ai * 128 + m * 16; const size_t ro = (size_t)row * D; float sq = 0.f;
#pragma unroll
                for (int bj = 0; bj < 2; ++bj) { const u32x4 g = gp[ai][m][bj], z = xv[m][bj];
                    const float x0 = bflo(z.x) + bflo(g.x), x1 = bfhi(z.x) + bfhi(g.x), x2 = bflo(z.y) + bflo(g.y), x3 = bfhi(z.y) + bfhi(g.y);
                    const float x4 = bflo(z.z) + bflo(g.z), x5 = bfhi(z.z) + bfhi(g.z), x6 = bflo(z.w) + bflo(g.w), x7 = bfhi(z.w) + bfhi(g.w);
                    sq += ((x0 * x0 + x1 * x1) + (x2 * x2 + x3 * x3)) + ((x4 * x4 + x5 * x5) + (x6 * x6 + x7 * x7));
                    u32x4 w; w.x = cvt_pk_bf16(x0, x1); w.y = cvt_pk_bf16(x2, x3); w.z = cvt_pk_bf16(x4, x5); w.w = cvt_pk_bf16(x6, x7);
                    *(u32x4*)(XO + ro + c00 + bj * 128) = w; }
                sq += __shfl_xor(sq, 16); sq += __shfl_xor(sq, 32);
                if (fq == 0) SSQ[(size_t)row * 16 + u.pn * 4 + wc] = sq; }
            asm volatile("" ::: "memory"); }
    }
};

template <bool GATHER_> struct GroupSched {
    static constexpr bool GATHER = GATHER_;
    const LAS int* tab; int G, c; const unsigned* TOK;
    __device__ __forceinline__ bool next(int i, Unit& u) const {
        const int ntile = tab[16]; int j, pn;
        if ((G & 7) == 0) { const int q = i * (G >> 3) + (c >> 3); j = ((q >> 2) << 3) + (c & 7); pn = q & 3; } else { const int Lu = i * G + c; j = Lu >> 2; pn = Lu & 3; }
        if (j >= ntile) return false;
        int e = 0;
#pragma unroll
        for (int k = 1; k < 16; ++k) e += (j >= tab[k]) ? 1 : 0;
        e = __builtin_amdgcn_readfirstlane(e);
        u.pm = j; u.pn = pn; u.e = e; u.pos0 = __builtin_amdgcn_readfirstlane((j - tab[e]) * 256); u.ne = __builtin_amdgcn_readfirstlane(tab[17 + e]); return true;
    }
    __device__ __forceinline__ int arow0(const Unit& u) const { return u.pm * 256; }
    __device__ __forceinline__ int arow(const Unit& u, int r) const {
        const int p = u.pos0 + r;
        return (p < u.ne) ? (int)(TOK[(size_t)u.e * LCAP + p] & 0x7fffffffu) : 0;
    }
    __device__ __forceinline__ int brow(const Unit& u) const { return u.e * 1024 + u.pn * 256; }
    __device__ __forceinline__ int koff(const Unit&) const { return 0; }
};

__device__ __forceinline__ void group_light(int G, int bid, int ntile, int& nl, int& li) {
    if ((G & 7) == 0) { const int W = G >> 3, maxu = (4 * ((ntile + 7) >> 3) + W - 1) / W; int tot = 0, mine = -1;
        for (int x = 0; x < 8; ++x) { const int ntx = (ntile + 7 - x) >> 3; int h = 4 * ntx - (maxu - 1) * W; h = h < 0 ? 0 : (h > W ? W : h);
            if (x == (bid & 7)) mine = ((bid >> 3) >= h) ? tot + (bid >> 3) - h : -1;
            tot += W - h; }
        nl = tot; li = mine; }
    else { const int nun = 4 * ntile, maxu = (nun + G - 1) / G, nheavy = nun - (maxu - 1) * G; nl = G - nheavy; li = bid - nheavy; }
    if (nl < 64) { nl = G; li = bid; }
}

struct TrDesc { const float* W; bf16_t* WT; int N, ldt, kofs, nbase, mode, rowoff, k0, n0, gsel; };
__device__ __forceinline__ void tr_load(const TrDesc& d, int lane, f32x4 (&v)[8]) {
    const float* p = d.W + (size_t)(d.k0 + (lane >> 3)) * d.N + d.n0 + 4 * (lane & 7);
#pragma unroll
    for (int i = 0; i < 8; ++i) v[i] = __builtin_nontemporal_load((const f32x4*)(p + (size_t)(8 * i) * d.N));
}
__device__ __forceinline__ void tr_store(const TrDesc& d, int lane, const f32x4 (&v)[8], LAS float* scr, const LAS float* gains) {
#pragma unroll
    for (int i = 0; i < 8; ++i) *(LAS f32x4*)(scr + (8 * i + (lane >> 3)) * 36 + 4 * (lane & 7)) = v[i];
    LDS_WAIT(); asm volatile("" ::: "memory");
    const int n = lane & 31;
    const LAS float* gl = gains + d.gsel * 1024 + d.k0;
#pragma unroll
    for (int j = 0; j < 4; ++j) { const int c = (lane >> 5) + 2 * j; const LAS float* s = scr + (8 * c) * 36 + n; const LAS float* gq = gl + 8 * c;
        float t[8];
#pragma unroll
        for (int q = 0; q < 8; ++q) t[q] = s[q * 36] * gq[q];
        u32x4 o; o.x = cvt_pk_bf16(t[0], t[1]); o.y = cvt_pk_bf16(t[2], t[3]); o.z = cvt_pk_bf16(t[4], t[5]); o.w = cvt_pk_bf16(t[6], t[7]);
        const int nn = d.nbase + d.n0 + n; const int drow = (d.mode ? (256 * (nn >> 7) + (nn & 127)) : nn) + d.rowoff;
        *(u32x4*)(d.WT + (size_t)drow * d.ldt + d.kofs + d.k0 + 8 * c) = o; }
    LDS_WAIT(); asm volatile("" ::: "memory");
}
constexpr int I_IN = 16 * 144, I_AO = 8 * 32, I_OUT = 16 * 32, I_PP = 4 * 32, I_EG = 16 * 16 * 16, I_ED = 16 * 8 * 32, I_RG = 16;
constexpr int TR_NITEMS = I_IN + 2 * I_AO + 2 * I_OUT + 2 * I_EG + I_ED + 2 * I_RG;
constexpr int TR_S1 = 5400, TR_S2 = 11000;
struct Frame;
__device__ __forceinline__ void tr_decode(const Frame& F, int L, int it, TrDesc& d);

__device__ __forceinline__ void route_tables(Frame& F, int L, int first, int stride) {
    const float* wrg = inp(F, 15) + (size_t)L * D * 4; const float* wre = inp(F, 17) + (size_t)L * D * 16; const float* gm = inp(F, 14) + L * D;
    unsigned char* img = F.ws + WS_RTAB + (size_t)(L & 1) * 81920;
    for (int en = first * 64 + F.lane; en < 32 * 64 + 32 * 16; en += stride * 64) {
        int ks, kg, n; unsigned char *ph, *pl;
        if (en < 2048) { ks = en >> 6; const int l = en & 63; kg = l >> 4; n = l & 15; ph = img + en * 16; pl = img + 32768 + en * 16; }
        else { const int r = en - 2048; ks = r >> 4; kg = (r >> 2) & 3; n = 16 + (r & 3); ph = img + 65536 + r * 16; pl = img + 65536 + 8192 + r * 16; }
        const int k0 = 32 * ks + 8 * kg; float v[8];
#pragma unroll
        for (int j = 0; j < 8; ++j) { const int k = k0 + j; const float w = (n < 4) ? wrg[k * 4 + n] : wre[k * 16 + (n - 4)]; v[j] = w * gm[k]; }
        unsigned hw[4];
#pragma unroll
        for (int j = 0; j < 4; ++j) hw[j] = cvt_pk_bf16(v[2 * j], v[2 * j + 1]);
        u32x4 lo;
        lo.x = cvt_pk_bf16(v[0] - bflo(hw[0]), v[1] - bfhi(hw[0])); lo.y = cvt_pk_bf16(v[2] - bflo(hw[1]), v[3] - bfhi(hw[1]));
        lo.z = cvt_pk_bf16(v[4] - bflo(hw[2]), v[5] - bfhi(hw[2])); lo.w = cvt_pk_bf16(v[6] - bflo(hw[3]), v[7] - bfhi(hw[3]));
        *(u32x4*)ph = (u32x4){hw[0], hw[1], hw[2], hw[3]}; *(u32x4*)pl = lo; }
}
__device__ __forceinline__ void prep_weights(Frame& F, int L, int it_lo, int it_hi, int first, int stride) {
    LAS float* scr = (LAS float*)(F.lds + F.wave * 9216);
    LAS float* gains = (LAS float*)(F.lds + 8 * 9216);
    const int lane = F.lane; unsigned char* ws = F.ws;
    { const float* g1 = inp(F, 2) + L * D; const float* g2 = inp(F, 14) + L * D; const float* g3 = inp(F, 22) + L * D;
      __syncthreads();
      for (int i = F.tid; i < 1024; i += 512) { gains[i] = 1.0f; gains[1024 + i] = g1[i]; gains[2048 + i] = g2[i]; gains[3072 + i] = g3[i]; }
      __syncthreads(); }
    { int it = it_lo + first; TrDesc d, dn; f32x4 v[8], vn[8]; const int nitems = it_hi;
      if (it < nitems) { tr_decode(F, L, it, d); tr_load(d, lane, v); }
      while (it < nitems) { const int itn = it + stride;
          if (itn < nitems) { tr_decode(F, L, itn, dn); tr_load(dn, lane, vn); }
          tr_store(d, lane, v, scr, gains);
          d = dn;
#pragma unroll
          for (int i = 0; i < 8; ++i) v[i] = vn[i];
          it = itn; } }
    if (it_lo == 0) for (int row = first; row < 1024; row += stride) { const int g = (((row >> 8) * 128) + (row & 127)) >> 6;
        if ((lane >> 3) != g) *(u32x4*)((bf16_t*)(ws + WOFF(L) + WS_WGT) + (size_t)row * DR + 8 * lane) = zero4(); }
    if (it_lo == 0) route_tables(F, L, first, stride);
    if (it_lo == 0 && first == 0) { float* cA = (float*)(ws + WS_MISC + 196608 + (L & 1) * 2048); const float* lam = inp(F, 10) + L * DR;
        for (int c = lane; c < DR; c += 64) { const float l = lam[c]; const float sp = (l > 0.f) ? log1pf(expf(-l)) : (-l + log1pf(expf(l))); cA[c] = -8.0f * sp; } }
    __syncthreads();
}
__device__ __forceinline__ void prep_phase(Frame& F) {
    const int gw = F.bid * 8 + F.wave, NGW = F.G * 8, lane = F.lane;
    unsigned char* ws = F.ws;
    prep_weights(F, 0, 0, TR_NITEMS + 4 * I_PP, gw, NGW);
    { const float* x = inp(F, 0); bf16_t* xb = (bf16_t*)(ws + WS_XBW); float* SSQ = (float*)(ws + WS_SSQ);
      for (int m = gw; m < T; m += NGW) { const f32x4* xr = (const f32x4*)(x + (size_t)m * D) + lane; f32x4 v[4]; float s = 0.f;
#pragma unroll
          for (int j = 0; j < 4; ++j) { v[j] = xr[64 * j]; s += (v[j][0] * v[j][0] + v[j][1] * v[j][1]) + (v[j][2] * v[j][2] + v[j][3] * v[j][3]); }
          s = wave_sum(s); if (lane < 16) SSQ[(size_t)m * 16 + lane] = (lane == 0) ? s : 0.f;
          u32x2* o = (u32x2*)(xb + (size_t)m * D) + lane;
#pragma unroll
          for (int j = 0; j < 4; ++j) { u32x2 w; w.x = cvt_pk_bf16(v[j][0], v[j][1]); w.y = cvt_pk_bf16(v[j][2], v[j][3]); o[64 * j] = w; } } }
    { const float* p = inp(F, 1); bf16_t* pb = (bf16_t*)(ws + WS_PB); const size_t n8 = (size_t)DEPTH * T * PLED / 8;
        for (size_t i = (size_t)F.bid * 512 + F.tid; i < n8; i += (size_t)F.G * 512) { const f32x4 a = *(const f32x4*)(p + i * 8), b = *(const f32x4*)(p + i * 8 + 4);
            u32x4 w; w.x = cvt_pk_bf16(a[0], a[1]); w.y = cvt_pk_bf16(a[2], a[3]); w.z = cvt_pk_bf16(b[0], b[1]); w.w = cvt_pk_bf16(b[2], b[3]); *(u32x4*)(pb + i * 8) = w; } }
}
__device__ __forceinline__ void tr_decode(const Frame& F, int L, int it, TrDesc& d) {
    unsigned char* ws = F.ws; int r = it;
    d.kofs = 0; d.nbase = 0; d.mode = 0; d.rowoff = 0; d.gsel = 0;
    int nblk;
    if (r < I_IN) { d.W = inp(F, 3) + (size_t)L * D * NIN; d.N = NIN; d.WT = (bf16_t*)(ws + WOFF(L) + WS_WIN); d.ldt = D; d.gsel = 1; nblk = 144; }
    else if ((r -= I_IN) < I_AO) { d.W = inp(F, 11) + (size_t)L * DA * D; d.N = D; d.WT = (bf16_t*)(ws + WOFF(L) + WS_WAO); d.ldt = D; nblk = 32; }
    else if ((r -= I_AO) < I_AO) { d.W = inp(F, 12) + (size_t)L * DR * D; d.N = D; d.WT = (bf16_t*)(ws + WOFF(L) + WS_WAO); d.ldt = D; d.kofs = DA; nblk = 32; }
    else if ((r -= I_AO) < I_OUT) { d.W = inp(F, 13) + (size_t)L * D * D; d.N = D; d.WT = (bf16_t*)(ws + WOFF(L) + WS_WOUT); d.ldt = D; nblk = 32; }
    else if ((r -= I_OUT) < I_OUT) { d.W = inp(F, 23) + (size_t)L * D * D; d.N = D; d.WT = (bf16_t*)(ws + WS_WPGL) + (size_t)L * D * D; d.ldt = D; d.gsel = 3; nblk = 32; }
    else if ((r -= I_OUT) < I_EG) { const int e = r >> 8; r &= 255; d.W = inp(F, 19) + ((size_t)L * NE + e) * D * DE; d.N = DE; d.WT = (bf16_t*)(ws + WOFF(L) + WS_WGU) + (size_t)e * 1024 * 1024; d.ldt = D; d.mode = 1; d.gsel = 2; nblk = 16; }
    else if ((r -= I_EG) < I_EG) { const int e = r >> 8; r &= 255; d.W = inp(F, 20) + ((size_t)L * NE + e) * D * DE; d.N = DE; d.WT = (bf16_t*)(ws + WOFF(L) + WS_WGU) + (size_t)e * 1024 * 1024; d.ldt = D; d.mode = 1; d.rowoff = 128; d.gsel = 2; nblk = 16; }
    else if ((r -= I_EG) < I_ED) { const int e = r >> 8; r &= 255; d.W = inp(F, 21) + ((size_t)L * NE + e) * DE * D; d.N = D; d.WT = (bf16_t*)(ws + WOFF(L) + WS_WDN) + (size_t)e * 1024 * 512; d.ldt = DE; nblk = 32; }
    else if ((r -= I_ED) < I_RG) { const int g = r >> 1; r &= 1; d.W = inp(F, 6) + ((size_t)L * 8 + g) * 4096; d.N = 64; d.WT = (bf16_t*)(ws + WOFF(L) + WS_WGT); d.ldt = DR; d.kofs = 64 * g; d.nbase = 64 * g; d.mode = 1; nblk = 2; }
    else if ((r -= I_RG) < I_RG) { const int g = r >> 1; r &= 1; d.W = inp(F, 8) + ((size_t)L * 8 + g) * 4096; d.N = 64; d.WT = (bf16_t*)(ws + WOFF(L) + WS_WGT); d.ldt = DR; d.kofs = 64 * g; d.nbase = 64 * g; d.mode = 1; d.rowoff = 128; nblk = 2; }
    else { r -= I_RG; const int l = r / I_PP; r -= l * I_PP; d.W = inp(F, 24) + (size_t)l * PLED * D; d.N = D; d.WT = (bf16_t*)(ws + WS_WPP) + (size_t)l * 1024 * PLED; d.ldt = PLED; nblk = 32; }
    d.k0 = 64 * (r / nblk); d.n0 = 32 * (r % nblk);
}

__device__ __forceinline__ void conv_phase(Frame& F, int L) {
    const bf16_t* XR = (const bf16_t*)(F.ws + WS_XR); bf16_t* XC = (bf16_t*)(F.ws + WS_XC);
    const float* cw = inp(F, 4) + (size_t)L * 4 * DR; const float* cb = inp(F, 5) + L * DR;
    const int c0 = (F.tid & 63) * 8;
    float w[4][8], bsv[8];
#pragma unroll
    for (int q = 0; q < 8; ++q) { bsv[q] = cb[c0 + q];
#pragma unroll
        for (int j = 0; j < 4; ++j) w[j][q] = cw[j * DR + c0 + q]; }
    const XSpan sp = xspan(F.G, F.bid, T / 64);
    for (int it = sp.first; it < sp.count; it += sp.stride) { const int task = (sp.base + it) * 8 + (F.tid >> 6); const int t0 = task * 8, ts0 = t0 & (SEQ - 1);
        u32x4 xw[11];
#pragma unroll
        for (int i = 0; i < 11; ++i) xw[i] = (ts0 - 3 + i >= 0) ? *(const u32x4*)(XR + (size_t)(t0 - 3 + i) * DR + c0) : zero4();
#pragma unroll
        for (int r = 0; r < 8; ++r) { float o[8];
#pragma unroll
            for (int q = 0; q < 8; ++q) o[q] = bsv[q];
#pragma unroll
            for (int j = 0; j < 4; ++j) { const u32x4 z = xw[r + j];
                const float xv[8] = {bflo(z.x), bfhi(z.x), bflo(z.y), bfhi(z.y), bflo(z.z), bfhi(z.z), bflo(z.w), bfhi(z.w)};
#pragma unroll
                for (int q = 0; q < 8; ++q) o[q] += w[j][q] * xv[q]; }
            u32x4 ow; ow.x = cvt_pk_bf16(o[0], o[1]); ow.y = cvt_pk_bf16(o[2], o[3]); ow.z = cvt_pk_bf16(o[4], o[5]); ow.w = cvt_pk_bf16(o[6], o[7]);
            *(u32x4*)(XC + (size_t)(t0 + r) * DR + c0) = ow; } }
}

__device__ __forceinline__ void attn_unit(const bf16_t* Q, const bf16_t* K, const bf16_t* VT, bf16_t* O, int b, int h, int jb, int lane) {
    const int r32 = lane & 31, hi = lane >> 5;
    const size_t rowb = (size_t)b * SEQ; const int q0 = jb * 32;
    bf16x8 qr[4];
    const size_t hb = ((size_t)b * NHEAD + h) * SEQ;
    const bf16_t* VTh = VT + ((size_t)b * NHEAD + h) * (SEQ / 32) * 2048;
    { const bf16_t* qp = Q + (hb + q0 + r32) * 64 + hi * 8;
#pragma unroll
      for (int d0 = 0; d0 < 4; ++d0) qr[d0] = *(const bf16x8*)(qp + 16 * d0); }
    f32x16 o0, o1;
#pragma unroll
    for (int r = 0; r < 16; ++r) { o0[r] = 0.f; o1[r] = 0.f; }
    float Pc = 1.0f;
    bf16x8 kfn[4], vfn[2][2];
#define ATT_LOAD(kb_) do { const bf16_t* kp_ = K + (hb + (kb_) + r32) * 64 + hi * 8; \
        _Pragma("unroll") for (int d0 = 0; d0 < 4; ++d0) kfn[d0] = *(const bf16x8*)(kp_ + 16 * d0); \
        const bf16_t* vp_ = VTh + (size_t)((kb_) >> 5) * 2048 + r32 * 32 + 8 * hi; \
        _Pragma("unroll") for (int s = 0; s < 2; ++s) _Pragma("unroll") for (int db = 0; db < 2; ++db) vfn[s][db] = *(const bf16x8*)(vp_ + db * 1024 + 16 * s); } while (0)
    ATT_LOAD(q0);
    for (int kb = q0; kb >= 0; kb -= 32) {
        bf16x8 kf[4], vf[2][2];
#pragma unroll
        for (int d0 = 0; d0 < 4; ++d0) kf[d0] = kfn[d0];
#pragma unroll
        for (int s = 0; s < 2; ++s)
#pragma unroll
            for (int db = 0; db < 2; ++db) vf[s][db] = vfn[s][db];
        if (kb >= 32) ATT_LOAD(kb - 32);
        f32x16 p;
#pragma unroll
        for (int r = 0; r < 16; ++r) p[r] = 0.f;
#pragma unroll
        for (int d0 = 0; d0 < 4; ++d0) p = __builtin_amdgcn_mfma_f32_32x32x16_bf16(kf[d0], qr[d0], p, 0, 0, 0);
        float rr[16], be[16];
        const bool diag = (kb == q0);
#pragma unroll
        for (int r = 0; r < 16; ++r) { const int kr = (r & 3) + 8 * (r >> 2) + 4 * hi;
            const float e = fexp2(p[r]); const float t = frcp(1.0f + e);
            const bool valid = (!diag) || (kr < r32);
            rr[r] = valid ? t : 1.0f; be[r] = valid ? (1.0f - t) : 0.0f; }
        float sfx[16], Gg[4];
#pragma unroll
        for (int g = 0; g < 4; ++g) { sfx[4 * g + 3] = 1.0f; sfx[4 * g + 2] = rr[4 * g + 3]; sfx[4 * g + 1] = sfx[4 * g + 2] * rr[4 * g + 2]; sfx[4 * g] = sfx[4 * g + 1] * rr[4 * g + 1]; Gg[g] = sfx[4 * g] * rr[4 * g]; }
        float Gl[4], Gh[4];
#pragma unroll
        for (int g = 0; g < 4; ++g) { const unsigned gb = __float_as_uint(Gg[g]); auto x = __builtin_amdgcn_permlane32_swap(gb, gb, false, false); Gl[g] = __uint_as_float(x[0]); Gh[g] = __uint_as_float(x[1]); }
        float Eh[4], El[4]; float c = Pc;
#pragma unroll
        for (int g = 3; g >= 0; --g) { Eh[g] = c; c *= Gh[g]; El[g] = c; c *= Gl[g]; }
        Pc = c;
        float w[16];
#pragma unroll
        for (int g = 0; g < 4; ++g) { const float Eg = hi ? Eh[g] : El[g];
#pragma unroll
            for (int cc = 0; cc < 4; ++cc) w[4 * g + cc] = be[4 * g + cc] * (sfx[4 * g + cc] * Eg); }
        u32x4 w0, w1;
        w0.x = cvt_pk_bf16(w[0], w[1]); w0.y = cvt_pk_bf16(w[2], w[3]); w0.z = cvt_pk_bf16(w[4], w[5]); w0.w = cvt_pk_bf16(w[6], w[7]);
        w1.x = cvt_pk_bf16(w[8], w[9]); w1.y = cvt_pk_bf16(w[10], w[11]); w1.z = cvt_pk_bf16(w[12], w[13]); w1.w = cvt_pk_bf16(w[14], w[15]);
        const bf16x8 wf0 = __builtin_bit_cast(bf16x8, w0), wf1 = __builtin_bit_cast(bf16x8, w1);
        o0 = __builtin_amdgcn_mfma_f32_32x32x16_bf16(vf[0][0], wf0, o0, 0, 0, 0);
        o1 = __builtin_amdgcn_mfma_f32_32x32x16_bf16(vf[0][1], wf0, o1, 0, 0, 0);
        o0 = __builtin_amdgcn_mfma_f32_32x32x16_bf16(vf[1][0], wf1, o0, 0, 0, 0);
        o1 = __builtin_amdgcn_mfma_f32_32x32x16_bf16(vf[1][1], wf1, o1, 0, 0, 0);
        if (__all(Pc < 1e-30f)) break;
    }
#undef ATT_LOAD
    bf16_t* op = O + (rowb + q0 + r32) * D + h * 64 + 4 * hi;
#pragma unroll
    for (int g = 0; g < 4; ++g) { u32x2 a, b2; a.x = cvt_pk_bf16(o0[4 * g], o0[4 * g + 1]); a.y = cvt_pk_bf16(o0[4 * g + 2], o0[4 * g + 3]); b2.x = cvt_pk_bf16(o1[4 * g], o1[4 * g + 1]); b2.y = cvt_pk_bf16(o1[4 * g + 2], o1[4 * g + 3]);
        *(u32x2*)(op + 8 * g) = a; *(u32x2*)(op + 32 + 8 * g) = b2; }
}
__device__ __forceinline__ void attn_phase(Frame& F) {
    const bf16_t* Q = (const bf16_t*)(F.ws + WS_Q); const bf16_t* K = (const bf16_t*)(F.ws + WS_K); const bf16_t* VT = (const bf16_t*)(F.ws + WS_VT); bf16_t* O = (bf16_t*)(F.ws + WS_AO);
    const bool pl = (F.G & 7) == 0 && NB * 2 == 8;
    const int first = pl ? (F.bid >> 3) * 8 + F.wave : F.bid * 8 + F.wave, stride = pl ? (F.G >> 3) * 8 : F.G * 8, count = pl ? NHEAD * (SEQ / 64) : NB * NHEAD * (SEQ / 32);
    for (int u = first; u < count; u += stride) {
        const int jb = pl ? (F.bid & 1) * (SEQ / 64) + (u & (SEQ / 64 - 1)) : (u & 127), bh = pl ? ((F.bid & 7) >> 1) * NHEAD + u / (SEQ / 64) : (u >> 7);
        attn_unit(Q, K, VT, O, bh >> 3, bh & 7, jb, F.lane); }
}

__device__ __forceinline__ void scan1_unit(Frame& F, int b, int ck, int cg) {
    const unsigned* DB = (const unsigned*)(F.ws + WS_DB); float* SA = (float*)(F.ws + WS_SUM); float* SH = SA + NB * 64 * DR;
    const int c = cg * 64 + F.lane; const size_t r0 = (size_t)b * SEQ + ck * 64;
    unsigned w[64];
#pragma unroll
    for (int t = 0; t < 64; ++t) w[t] = DB[(r0 + t) * DR + c];
    float A = 1.f, H = 0.f;
#pragma unroll
    for (int t = 0; t < 64; ++t) { const float a = 1.0f - bflo(w[t]); A *= a; H = a * H + bfhi(w[t]); }
    SA[(size_t)(b * 64 + ck) * DR + c] = A; SH[(size_t)(b * 64 + ck) * DR + c] = H;
}
__device__ __forceinline__ void scan2_phase(Frame& F) {
    const unsigned* DB = (const unsigned*)(F.ws + WS_DB); const float* SA = (const float*)(F.ws + WS_SUM); const float* SH = SA + NB * 64 * DR;
    const bf16_t* XG = (const bf16_t*)(F.ws + WS_XG); bf16_t* RI = (bf16_t*)(F.ws + WS_AO);
    LAS bf16_t* stg = (LAS bf16_t*)(F.lds + F.wave * 9216);
    const int lane = F.lane; const XSpan sp = xspan(F.G, F.bid, NB * 64);
    for (int it = sp.first; it < sp.count; it += sp.stride) { const int u = (sp.base + it) * 8 + F.wave; const int cg = u & 7, ck = (u >> 3) & 63, b = u >> 9; const int c = cg * 64 + lane; const size_t r0 = (size_t)b * SEQ + ck * 64;
        unsigned w[64]; u32x4 xg[8]; const int tr = lane >> 3, cq = (lane & 7) * 8;
#pragma unroll
        for (int t = 0; t < 64; ++t) w[t] = DB[(r0 + t) * DR + c];
#pragma unroll
        for (int i = 0; i < 8; ++i) xg[i] = *(const u32x4*)(XG + (r0 + tr + 8 * i) * DR + cg * 64 + cq);
        float H = 0.f;
        { const float* sa = SA + (size_t)(b * 64) * DR + c; const float* sh = SH + (size_t)(b * 64) * DR + c;
          for (int j0 = 0; j0 < ck; j0 += 32) { float ta[32], th[32];
#pragma unroll
              for (int j = 0; j < 32; ++j) { const int jj = (j0 + j < ck) ? (j0 + j) : 0; ta[j] = sa[(size_t)jj * DR]; th[j] = sh[(size_t)jj * DR]; }
#pragma unroll
              for (int j = 0; j < 32; ++j) if (j0 + j < ck) H = ta[j] * H + th[j]; } }
        {
#pragma unroll
          for (int i = 0; i < 8; ++i) *(LAS u32x4*)(stg + (tr + 8 * i) * 72 + cq) = xg[i];
          LDS_WAIT(); asm volatile("" ::: "memory"); }
#pragma unroll
        for (int t = 0; t < 64; ++t) { const float a = 1.0f - bflo(w[t]); H = a * H + bfhi(w[t]);
            const float g = bf2f(stg[t * 72 + lane]); stg[t * 72 + lane] = (bf16_t)(cvt_pk_bf16(H * g, 0.f) & 0xffffu); }
        LDS_WAIT(); asm volatile("" ::: "memory");
        {
#pragma unroll
          for (int i = 0; i < 8; ++i) { const u32x4 o = *(const LAS u32x4*)(stg + (tr + 8 * i) * 72 + cq); *(u32x4*)(RI + (r0 + tr + 8 * i) * D + DA + cg * 64 + cq) = o; }
          LDS_WAIT(); asm volatile("" ::: "memory"); } }
}

__device__ __forceinline__ void route_load_tables(Frame& F, int L) {
    const int tid = F.tid;
    const u32x4* srcp = (const u32x4*)(F.ws + WS_RTAB + (size_t)(L & 1) * 81920); u32x4 tv[10];
#pragma unroll
    for (int i = 0; i < 10; ++i) tv[i] = srcp[tid + 512 * i];
#pragma unroll
    for (int i = 0; i < 10; ++i) *(LAS u32x4*)(F.lds + (tid + 512 * i) * 16) = tv[i];
}
__device__ __forceinline__ void route_phase(Frame& F, int L, int CL) {
    LAS unsigned char* T0h = F.lds;
    LAS unsigned char* T0l = F.lds + 32768;
    LAS unsigned char* T1h = F.lds + 65536;
    LAS unsigned char* T1l = F.lds + 65536 + 8192;
    LAS int* cnt = (LAS int*)(F.lds + 81920); LAS int* bas = cnt + 16; LAS float* tinfo = (LAS float*)(F.lds + 81920 + 128);
    LAS float* lgs0 = (LAS float*)(F.lds + 86016); LAS float* lgs = lgs0 + F.wave * 528;
    const float* wrg = inp(F, 15) + (size_t)L * D * 4; const float* brg = inp(F, 16) + L * 4; const float* wre = inp(F, 17) + (size_t)L * D * 16; const float* bre = inp(F, 18) + L * 16;
    const bf16_t* xb = (const bf16_t*)(F.ws + WS_XB); unsigned* TOK = (unsigned*)(F.ws + WS_TOK); float* WLs = (float*)(F.ws + WS_WL); float* RS = (float*)(F.ws + WS_RS);
    unsigned* gcnt = F.ctl + CW_CNT + CL * 16 * 64;
    const int lane = F.lane, tid = F.tid;
    const int row = lane & 15, kg = lane >> 4;
    const XSpan sp = xspan(F.G, F.bid, T / 64);
    for (int it = sp.first; it < sp.count; it += sp.stride) { const int blk = sp.base + it;
        if (tid < 16) cnt[tid] = 0;
        __syncthreads();
        const int t0 = blk * 64 + (F.wave & 3) * 16;
        const bf16_t* xbp = xb + (size_t)(t0 + row) * D + 8 * kg;
        f32x4 acc0 = {0.f, 0.f, 0.f, 0.f}, acc1 = {0.f, 0.f, 0.f, 0.f}; float ss = 0.f;
        { const int ks0 = (F.wave >> 2) * 16;
            u32x4 xv[16];
#pragma unroll
            for (int i = 0; i < 16; ++i) xv[i] = *(const u32x4*)(xbp + 32 * (ks0 + i));
#pragma unroll
            for (int i = 0; i < 16; ++i) { const int ks = ks0 + i; const u32x4 h = xv[i];
                { const float a0 = bflo(h.x), a1 = bfhi(h.x), a2 = bflo(h.y), a3 = bfhi(h.y), c0 = bflo(h.z), c1 = bfhi(h.z), c2 = bflo(h.w), c3 = bfhi(h.w);
                  ss += ((a0 * a0 + a1 * a1) + (a2 * a2 + a3 * a3)) + ((c0 * c0 + c1 * c1) + (c2 * c2 + c3 * c3)); }
                const bf16x8 ah = __builtin_bit_cast(bf16x8, h);
                const bf16x8 b0h = *(const LAS bf16x8*)(T0h + (ks * 64 + lane) * 16), b0l = *(const LAS bf16x8*)(T0l + (ks * 64 + lane) * 16);
                const int o1 = (ks * 16 + kg * 4 + (row & 3)) * 16;
                const bf16x8 b1h = *(const LAS bf16x8*)(T1h + o1), b1l = *(const LAS bf16x8*)(T1l + o1);
                acc0 = __builtin_amdgcn_mfma_f32_16x16x32_bf16(ah, b0h, acc0, 0, 0, 0); acc0 = __builtin_amdgcn_mfma_f32_16x16x32_bf16(ah, b0l, acc0, 0, 0, 0);
                acc1 = __builtin_amdgcn_mfma_f32_16x16x32_bf16(ah, b1h, acc1, 0, 0, 0); acc1 = __builtin_amdgcn_mfma_f32_16x16x32_bf16(ah, b1l, acc1, 0, 0, 0); }
        }
        ss += __shfl_xor(ss, 16); ss += __shfl_xor(ss, 32);
        {
#pragma unroll
            for (int i = 0; i < 4; ++i) { lgs[(4 * kg + i) * 32 + row] = acc0[i]; if (row < 4) lgs[(4 * kg + i) * 32 + 16 + row] = acc1[i]; } }
        if (lane < 16) lgs[512 + lane] = ss;
        __syncthreads();
        if (tid < 64) { const int tk = tid;
            const LAS float* lr = lgs0 + (tk >> 4) * 528 + (tk & 15) * 32; const LAS float* lr2 = lr + 4 * 528;
            const float rstd = 1.0f / sqrtf((lgs0[(tk >> 4) * 528 + 512 + (tk & 15)] + lgs0[((tk >> 4) + 4) * 528 + 512 + (tk & 15)]) * (1.0f / D) + EPS);
            float lg[4];
#pragma unroll
            for (int j = 0; j < 4; ++j) lg[j] = rstd * (lr[j] + lr2[j]) + brg[j];
            int gi = 0; float gmx = lg[0];
#pragma unroll
            for (int j = 1; j < 4; ++j) if (lg[j] > gmx) { gmx = lg[j]; gi = j; }
            float den = 0.f;
#pragma unroll
            for (int j = 0; j < 4; ++j) den += expf(lg[j] - gmx);
            const float gate_group = 1.0f / den;
            float sel[4];
#pragma unroll
            for (int i = 0; i < 4; ++i) sel[i] = rstd * (lr[4 + gi * 4 + i] + lr2[4 + gi * 4 + i]) + bre[gi * 4 + i];
            int i1 = 0; float v1 = sel[0];
#pragma unroll
            for (int i = 1; i < 4; ++i) if (sel[i] > v1) { v1 = sel[i]; i1 = i; }
            int i2 = -1; float v2 = 0.f;
#pragma unroll
            for (int i = 0; i < 4; ++i) if (i != i1 && (i2 < 0 || sel[i] > v2)) { v2 = sel[i]; i2 = i; }
            const float ex = expf(v2 - v1); const float w1 = 1.0f / (1.0f + ex), w2 = ex / (1.0f + ex);
            const int e1 = gi * 4 + i1, e2 = gi * 4 + i2;
            const int p1 = __hip_atomic_fetch_add(cnt + e1, 1, __ATOMIC_RELAXED, __HIP_MEMORY_SCOPE_WORKGROUP);
            const int p2 = __hip_atomic_fetch_add(cnt + e2, 1, __ATOMIC_RELAXED, __HIP_MEMORY_SCOPE_WORKGROUP);
            LAS float* ti = tinfo + tk * 8;
            ti[0] = __int_as_float(e1); ti[1] = __int_as_float(p1); ti[2] = gate_group * w1; ti[3] = __int_as_float(e2); ti[4] = __int_as_float(p2); ti[5] = gate_group * w2; ti[6] = rstd; }
        __syncthreads();
        if (tid < 16) { const int c = cnt[tid]; int b0 = 0; if (c > 0) b0 = (int)__hip_atomic_fetch_add(gcnt + tid * 64, (unsigned)c, __ATOMIC_RELAXED, __HIP_MEMORY_SCOPE_AGENT); bas[tid] = b0; }
        __syncthreads();
        if (tid < 64) { const LAS float* ti = tinfo + tid * 8; const int t = blk * 64 + tid;
            const int e1 = __float_as_int(ti[0]), p1 = __float_as_int(ti[1]), e2 = __float_as_int(ti[3]), p2 = __float_as_int(ti[4]);
            const size_t i1 = (size_t)e1 * LCAP + bas[e1] + p1, i2 = (size_t)e2 * LCAP + bas[e2] + p2;
            TOK[i1] = (unsigned)t; WLs[i1] = ti[2]; RS[i1] = ti[6];
            TOK[i2] = (unsigned)t | 0x80000000u; WLs[i2] = ti[5]; RS[i2] = ti[6]; }
        __syncthreads();
    }
}
__device__ __forceinline__ void group_table(Frame& F, int L) {
    LAS int* tab = (LAS int*)(F.lds + TSTART_OFF);
    if (F.tid < 16) tab[17 + F.tid] = (int)__hip_atomic_load(F.ctl + CW_CNT + (L * 16 + F.tid) * 64, __ATOMIC_RELAXED, __HIP_MEMORY_SCOPE_AGENT);
    __syncthreads();
    if (F.tid == 0) { int a = 0;
        for (int e = 0; e < 16; ++e) { tab[e] = a; a += (tab[17 + e] + 255) >> 8; }
        tab[16] = a; }
    __syncthreads();
}
__device__ __forceinline__ void s3_phase(Frame& F) {
    bf16_t* xb = (bf16_t*)(F.ws + WS_XB); const bf16_t* Y0 = (const bf16_t*)(F.ws + WS_Y0); const bf16_t* Y1 = (const bf16_t*)(F.ws + WS_Y1); float* rstd3 = (float*)(F.ws + WS_MISC + 131072);
    const int lane = F.lane; const XSpan sp = xspan(F.G, F.bid, T / 64);
    for (int it2 = 2 * sp.first; it2 < 2 * sp.count; it2 += ((it2 & 1) ? 2 * sp.stride - 1 : 1)) {
        const int m0 = (sp.base + (it2 >> 1)) * 64 + F.wave * 8 + (it2 & 1) * 4;
        u32x2 xv[4][4], ya[4][4], yb[4][4];
#pragma unroll
        for (int r = 0; r < 4; ++r) { const int m = m0 + r;
#pragma unroll
            for (int j = 0; j < 4; ++j) { xv[r][j] = ((const u32x2*)(xb + (size_t)m * D) + lane)[64 * j]; ya[r][j] = ((const u32x2*)(Y0 + (size_t)m * D) + lane)[64 * j]; yb[r][j] = ((const u32x2*)(Y1 + (size_t)m * D) + lane)[64 * j]; } }
#pragma unroll
        for (int r = 0; r < 4; ++r) { const int m = m0 + r; float s = 0.f; u32x2* o = (u32x2*)(xb + (size_t)m * D) + lane;
#pragma unroll
            for (int j = 0; j < 4; ++j) { const u32x2 z = xv[r][j], a = ya[r][j], b = yb[r][j];
                const float t0 = bflo(z.x) + (bflo(a.x) + bflo(b.x)), t1 = bfhi(z.x) + (bfhi(a.x) + bfhi(b.x)), t2 = bflo(z.y) + (bflo(a.y) + bflo(b.y)), t3 = bfhi(z.y) + (bfhi(a.y) + bfhi(b.y));
                s += (t0 * t0 + t1 * t1) + (t2 * t2 + t3 * t3);
                u32x2 w; w.x = cvt_pk_bf16(t0, t1); w.y = cvt_pk_bf16(t2, t3); o[64 * j] = w; }
            s = wave_sum(s); if (lane == 0) rstd3[m] = 1.0f / sqrtf(s * (1.0f / D) + EPS); } }
}
__device__ __forceinline__ void final_phase(Frame& F) {
    const bf16_t* xb = (const bf16_t*)(F.ws + WS_XBW); float* out = F.out; const float* g = inp(F, 25);
    const int lane = F.lane;
    f32x4 gg[4];
#pragma unroll
    for (int j = 0; j < 4; ++j) gg[j] = *((const f32x4*)g + lane + 64 * j);
    const XSpan sp = xspan(F.G, F.bid, T / 64);
    for (int it2 = 2 * sp.first; it2 < 2 * sp.count; it2 += ((it2 & 1) ? 2 * sp.stride - 1 : 1)) { u32x2 v[4][4];
        const int m0 = (sp.base + (it2 >> 1)) * 64 + F.wave * 8 + (it2 & 1) * 4;
#pragma unroll
        for (int r = 0; r < 4; ++r) { const int m = m0 + r;
#pragma unroll
            for (int j = 0; j < 4; ++j) v[r][j] = ((const u32x2*)(xb + (size_t)m * D) + lane)[64 * j]; }
#pragma unroll
        for (int r = 0; r < 4; ++r) { const int m = m0 + r; float s = 0.f; f32x4 t[4];
#pragma unroll
            for (int j = 0; j < 4; ++j) { t[j] = (f32x4){bflo(v[r][j].x), bfhi(v[r][j].x), bflo(v[r][j].y), bfhi(v[r][j].y)}; s += (t[j][0] * t[j][0] + t[j][1] * t[j][1]) + (t[j][2] * t[j][2] + t[j][3] * t[j][3]); }
            const float rs = 1.0f / sqrtf(wave_sum(s) * (1.0f / D) + EPS); f32x4* xr = (f32x4*)(out + (size_t)m * D) + lane;
#pragma unroll
            for (int j = 0; j < 4; ++j) xr[64 * j] = t[j] * rs * gg[j]; } }
}

constexpr int NPH = 13;
constexpr int PH_TOTAL = DEPTH * NPH + 1;
__global__ void __launch_bounds__(512, 2) trunk_fwd(Args args) {
    extern __shared__ __attribute__((aligned(16))) unsigned char lds[];
    Frame F;
    F.lds = (LAS unsigned char*)lds; F.ws = args.ws; F.ctl = (unsigned*)(args.ws + WS_CTL); F.out = args.out;
    F.tid = threadIdx.x; F.lane = F.tid & 63; F.wave = __builtin_amdgcn_readfirstlane(F.tid >> 6); F.G = gridDim.x;
    F.bid = blockIdx.x;
    const int wave0 = F.wave, grid0 = gridDim.x; int bid0 = blockIdx.x; bool xloc = false;
    for (int u = F.tid; u < (LDS_BYTES - LDSCTL_OFF) / 4; u += 512) ((LAS unsigned*)(F.lds + LDSCTL_OFF))[u] = 0u;
    __syncthreads();
    if (F.tid < 26) ((LAS unsigned long long*)(F.lds + PTAB_OFF))[F.tid] = (unsigned long long)args.in[F.tid];
    __syncthreads();
    XcdBarrier bar; bar.bar = F.ctl + CW_BAR; bar.x = 0; bar.st = nullptr;
#if MK_N_LAUNCHES == 1
    { volatile LAS unsigned* st = (volatile LAS unsigned*)(F.lds + MISC_OFF) + 8; unsigned* bw = F.ctl + CW_BAR;
      bar.bar = bw; bar.x = xb_xcc_id(); bar.st = st;
      if (F.tid == 0) { const unsigned rank = xb_add(&bw[XB_XCNT(bar.x)], 1u); unsigned nloc, nx; xcd_barrier_complete(bw, bar.x, nloc, nx); st[0] = nloc; st[1] = nx;
          bool eq = (grid0 % 8 == 0) && (nx == 8u); unsigned pre = 0u;
          for (unsigned j = 0; j < 16; ++j) { const unsigned c = xb_ld(&bw[XB_XCNT(j)]); if (j < 8) eq = eq && (c == (unsigned)grid0 / 8u); else eq = eq && (c == 0u); if (j < bar.x) pre += c; }
          st[2] = eq ? rank * 8u + bar.x : pre + rank; st[3] = eq ? 1u : 0u; }
      __syncthreads();
      bid0 = (int)__builtin_amdgcn_readfirstlane(st[2]); xloc = __builtin_amdgcn_readfirstlane(st[3]) != 0u; F.bid = bid0; }
#endif
    const int lo = args.ph_lo, hi = args.ph_hi;
#define IN(k) (lo <= (k) && (k) < hi)
#if MK_N_LAUNCHES == 1
#define SEAM(k) do { if (IN(k) && IN((k) + 1)) { xcd_barrier(bar); if (REP_PHASE == 99) xcd_barrier(bar); } } while (0)
#define SEAML(k) do { if (IN(k) && IN((k) + 1)) { xcd_barrier(bar, xloc ? 1 : 0); } } while (0)
#define SEAMP(k) do { if (IN(k) && IN((k) + 1)) { xcd_barrier(bar, xloc ? 2 : 0); } } while (0)
#else
#define SEAM(k) do { } while (0)
#define SEAML(k) do { } while (0)
#define SEAMP(k) do { } while (0)
#endif
    unsigned char* const ws0 = args.ws;
    for (int L = 0; L < DEPTH; ++L) {
        const int P = L * NPH;
        unsigned char* ws;
#define OPQ() do { unsigned long long wq_ = (unsigned long long)ws0; asm volatile("" : "+s"(wq_) :: "memory"); ws = (unsigned char*)(GAS unsigned char*)wq_; int l_; asm volatile("v_mbcnt_lo_u32_b32 %0, -1, 0\n\tv_mbcnt_hi_u32_b32 %0, -1, %0" : "=v"(l_)); int w_ = wave0, b_ = bid0, g_ = grid0; asm volatile("" : "+s"(w_), "+s"(b_), "+s"(g_)); F.lane = l_; F.wave = w_; F.tid = w_ * 64 + l_; F.bid = b_; F.G = g_; } while (0)
#define BG_PREP(nun_, lo_, hi_) do { const int nun__ = (nun_), maxu__ = (nun__ + F.G - 1) / F.G, nheavy__ = nun__ - (maxu__ - 1) * F.G; int nl__ = F.G - nheavy__, li__ = F.bid - nheavy__; \
            if (nl__ < 64) { nl__ = F.G; li__ = F.bid; } if (REP_PHASE != 77 && li__ >= 0) { OPQ(); F.ws = ws; prep_weights(F, L + 1, (lo_), (hi_), li__ * 8 + F.wave, nl__ * 8); } } while (0)
        if (IN(P + 0) && L == 0) { OPQ(); F.ws = ws; prep_phase(F); SEAM(P + 0); }
        if (REP_PHASE == 77 && IN(P + 0) && L > 0) { OPQ(); F.ws = ws; prep_weights(F, L, 0, TR_NITEMS, F.bid * 8 + F.wave, F.G * 8); xcd_barrier(bar); }
        if (IN(P + 1)) { OPQ();
            pg8::Gemm g{(const bf16_t*)(ws + WS_XBW), (const bf16_t*)(ws + WOFF(L) + WS_WIN), D, D, D}; pg8::StaticOrder S; S.init(T, NIN, F.G, F.bid);
            { LAS float* rl = (LAS float*)(F.lds + RSTD_OFF); const float* SSQ = (const float*)(ws + WS_SSQ); Unit u; float rv[RSTD_UNITS];
              if (F.tid < 256) {
#pragma unroll
                  for (int i = 0; i < RSTD_UNITS; ++i) rv[i] = S.next(i, u) ? row_rstd(SSQ, u.pm * 256 + F.tid) : 0.f;
#pragma unroll
                  for (int i = 0; i < RSTD_UNITS; ++i) rl[i * 256 + F.tid] = rv[i]; }
              __syncthreads(); }
            EpiWin E{(const float*)(ws + WS_SSQ), (const LAS float*)(F.lds + RSTD_OFF), (bf16_t*)(ws + WS_Q), (bf16_t*)(ws + WS_K), (bf16_t*)(ws + WS_VT), (bf16_t*)(ws + WS_XR), (bf16_t*)(ws + WS_XG), (bf16_t*)(ws + WS_GA), (bf16_t*)(ws + WS_GR)};
            for (int rep = 0; rep < REPN(1); ++rep) pg8::gemm_phase(F.lds, g, S, E, F.tid);
            if (L + 1 < DEPTH) { for (int rep = 0; rep < REPN(93); ++rep) BG_PREP(T / 256 * (NIN / 256), 0, TR_S1); }
            if (L == 0) { OPQ();
                pg8::Gemm g2{(const bf16_t*)(ws + WS_PB), (const bf16_t*)(ws + WS_WPP), PLED, PLED, PLED}; PPOrder S2; S2.init(DEPTH * T, D, F.G, F.bid);
                EpiBf16 E2{(bf16_t*)(ws + WS_PP), D};
                pg8::gemm_phase(F.lds, g2, S2, E2, F.tid); }
            SEAMP(P + 1); }
        if (IN(P + 2)) { for (int rep = 0; rep < REPN(2); ++rep) { OPQ(); F.ws = ws; conv_phase(F, L); } for (int rep = 0; rep < REPN(20); ++rep) { OPQ(); F.ws = ws; attn_phase(F); } SEAML(P + 2); }
        if (IN(P + 3)) { OPQ();
            pg8::Gemm g{(const bf16_t*)(ws + WS_XC), (const bf16_t*)(ws + WOFF(L) + WS_WGT), DR, DR, 256}; GateOrder S; S.init(T, 1024, F.G, F.bid);
            EpiGates E{(const bf16_t*)(ws + WS_XC), inp(F, 7) + L * DR, inp(F, 9) + L * DR, (const float*)(ws + WS_MISC + 196608 + (L & 1) * 2048), (unsigned*)(ws + WS_DB)};
            for (int rep = 0; rep < REPN(3); ++rep) pg8::gemm_phase(F.lds, g, S, E, F.tid);
            asm volatile("s_waitcnt vmcnt(0)" ::: "memory"); __syncthreads();
            { OPQ(); F.ws = ws; Unit u;
              for (int i = 0; S.next(i, u); ++i) scan1_unit(F, u.pm >> 4, (u.pm & 15) * 4 + (F.wave & 3), 2 * u.pn + (F.wave >> 2)); }
            SEAMP(P + 3); }
        if (IN(P + 5)) { for (int rep = 0; rep < REPN(5); ++rep) { OPQ(); F.ws = ws; scan2_phase(F); } SEAML(P + 5); }
        if (IN(P + 6)) { OPQ();
            pg8::Gemm g{(const bf16_t*)(ws + WS_AO), (const bf16_t*)(ws + WOFF(L) + WS_WAO), D, D, D}; pg8::StaticOrder S; S.init(T, D, F.G, F.bid);
            EpiMerge2 E{(const bf16_t*)(ws + WS_GA), (const bf16_t*)(ws + WS_GR), (bf16_t*)(ws + WS_MG)};
            for (int rep = 0; rep < REPN(6); ++rep) pg8::gemm_phase(F.lds, g, S, E, F.tid);
            SEAML(P + 6); }
        if (IN(P + 7)) { OPQ();
            pg8::Gemm g{(const bf16_t*)(ws + WS_MG), (const bf16_t*)(ws + WOFF(L) + WS_WOUT), D, D, D}; pg8::StaticOrder S; S.init(T, D, F.G, F.bid);
            EpiResid E{(const bf16_t*)(ws + WS_XBW), (bf16_t*)(ws + WS_XB)};
            pg8::gemm_phase(F.lds, g, S, E, F.tid);
            if (IN(P + 8)) { OPQ(); F.ws = ws; route_load_tables(F, L); }
            SEAML(P + 7); }
        if (IN(P + 8)) { if (!IN(P + 7)) { OPQ(); F.ws = ws; route_load_tables(F, L); __syncthreads(); }
            if (REP_PHASE == 8) { OPQ(); F.ws = ws; route_phase(F, L, L + 4); SEAM(P + 8); } OPQ(); F.ws = ws; route_phase(F, L, L); SEAM(P + 8); }
        if (IN(P + 9)) { OPQ();
            group_table(F, L);
            pg8::Gemm g{(const bf16_t*)(ws + WS_XB), (const bf16_t*)(ws + WOFF(L) + WS_WGU), D, D, D};
            GroupSched<true> S{(const LAS int*)(F.lds + TSTART_OFF), F.G, F.bid, (const unsigned*)(ws + WS_TOK)};
            EpiGU E{(const float*)(ws + WS_RS), (bf16_t*)(ws + WS_ACT)};
            for (int rep = 0; rep < REPN(9); ++rep) pg8::gemm_phase(F.lds, g, S, E, F.tid);
            if (L + 1 < DEPTH) { int nl, li; group_light(F.G, F.bid, ((const LAS int*)(F.lds + TSTART_OFF))[16], nl, li); if (li >= 0) { OPQ(); F.ws = ws; prep_weights(F, L + 1, TR_S1, TR_S2, li * 8 + F.wave, nl * 8); } }
            SEAML(P + 9); }
        if (IN(P + 10)) { OPQ();
            group_table(F, L);
            pg8::Gemm g{(const bf16_t*)(ws + WS_ACT), (const bf16_t*)(ws + WOFF(L) + WS_WDN), DE, DE, DE};
            GroupSched<false> S{(const LAS int*)(F.lds + TSTART_OFF), F.G, F.bid, (const unsigned*)(ws + WS_TOK)};
            EpiDown E{(const unsigned*)(ws + WS_TOK), (const float*)(ws + WS_WL), (bf16_t*)(ws + WS_Y0), (bf16_t*)(ws + WS_Y1)};
            for (int rep = 0; rep < REPN(10); ++rep) pg8::gemm_phase(F.lds, g, S, E, F.tid);
            if (L + 1 < DEPTH) { int nl, li; group_light(F.G, F.bid, ((const LAS int*)(F.lds + TSTART_OFF))[16], nl, li); if (li >= 0) { OPQ(); F.ws = ws; prep_weights(F, L + 1, TR_S2, TR_NITEMS, li * 8 + F.wave, nl * 8); } }
            SEAM(P + 10); }
        if (IN(P + 11)) { OPQ(); F.ws = ws; s3_phase(F); SEAML(P + 11); }
        if (IN(P + 12)) { OPQ();
            pg8::Gemm g{(const bf16_t*)(ws + WS_XB), (const bf16_t*)(ws + WS_WPGL) + (size_t)L * D * D, D, D, D}; pg8::StaticOrder S; S.init(T, D, F.G, F.bid);
            EpiPle E{(const float*)(ws + WS_MISC + 131072), (const bf16_t*)(ws + WS_PP) + (size_t)L * T * D, (const bf16_t*)(ws + WS_XB), (bf16_t*)(ws + WS_XBW), (float*)(ws + WS_SSQ)};
            pg8::gemm_phase(F.lds, g, S, E, F.tid);
            SEAML(P + 12); }
    }
    if (IN(DEPTH * NPH)) final_phase(F);
#undef IN
#undef SEAM
}

extern "C" void kernel_launch(void* const* d_in, const int* in_sizes, int n_in, void* d_out, int out_size, void* d_ws, size_t ws_size, hipStream_t stream) {
    static int grid = 0;
    if (grid == 0) {
        if (n_in != 26 || in_sizes[0] != T * D || out_size != T * D || ws_size < WS_END) { fprintf(stderr, "kernel_launch: unexpected shapes (n_in %d, in0 %d, out %d, ws %zu need %zu)\n", n_in, n_in > 0 ? in_sizes[0] : -1, out_size, ws_size, (size_t)WS_END); grid = -1; return; }
        int dev = 0, cus = 0, per_cu = 0;
        if (hipGetDevice(&dev) != hipSuccess || hipDeviceGetAttribute(&cus, hipDeviceAttributeMultiprocessorCount, dev) != hipSuccess) { grid = -1; return; }
        if (hipFuncSetAttribute((const void*)trunk_fwd, hipFuncAttributeMaxDynamicSharedMemorySize, LDS_BYTES) != hipSuccess) { fprintf(stderr, "kernel_launch: hipFuncSetAttribute failed\n"); grid = -1; return; }
        if (hipOccupancyMaxActiveBlocksPerMultiprocessor(&per_cu, (const void*)trunk_fwd, 512, LDS_BYTES) != hipSuccess || per_cu < 1) fprintf(stderr, "kernel_launch: occupancy query reports %d\n", per_cu);
        (void)hipGetLastError();
        grid = cus;
    }
    if (grid < 0) return;
    if (hipMemsetAsync((char*)d_ws + WS_CTL, 0, CTL_ZERO_BYTES, stream) != hipSuccess) return;
    Args a{};
    for (int i = 0; i < 26; ++i) a.in[i] = (const float*)d_in[i];
    a.out = (float*)d_out; a.ws = (unsigned char*)d_ws;
#if MK_N_LAUNCHES == 1
    a.ph_lo = 0; a.ph_hi = PH_TOTAL;
    hipLaunchKernelGGL(trunk_fwd, dim3(grid), dim3(512), LDS_BYTES, stream, a);
#else
    for (int ph = 0; ph < PH_TOTAL; ++ph) { a.ph_lo = ph; a.ph_hi = ph + 1; hipLaunchKernelGGL(trunk_fwd, dim3(grid), dim3(512), LDS_BYTES, stream, a); }
#endif
}
```

```cpp
#include <hip/hip_runtime.h>
#include <cstdio>
#include <cstdint>

#ifndef REP_PHASE
#define REP_PHASE -1
#endif
#define REPN(k) ((REP_PHASE == (k)) ? 2 : 1)
#ifndef MK_N_LAUNCHES
#define MK_N_LAUNCHES 1
#endif

#define LAS __attribute__((address_space(3)))
#define GAS __attribute__((address_space(1)))
typedef unsigned short bf16_t;
typedef short bf16x8 __attribute__((ext_vector_type(8)));
typedef float f32x4 __attribute__((ext_vector_type(4)));
typedef float f32x2 __attribute__((ext_vector_type(2)));
typedef float f32x16 __attribute__((ext_vector_type(16)));
typedef unsigned u32x4 __attribute__((ext_vector_type(4)));
typedef unsigned u32x2 __attribute__((ext_vector_type(2)));

constexpr int NB = 4, SEQ = 4096, T = NB * SEQ, D = 1024, DA = 512, DR = 512, NIN = 4608, NE = 16, DE = 512, PLED = 256, DEPTH = 4, NHEAD = 8;
constexpr float EPS = 1e-6f;
constexpr float LOG2E = 1.4426950408889634f;
constexpr float QSCALE = 0.125f * LOG2E;
constexpr int LCAP = 16384;

__device__ __forceinline__ unsigned cvt_pk_bf16(float lo, float hi) { unsigned r; asm volatile("v_cvt_pk_bf16_f32 %0, %1, %2" : "=v"(r) : "v"(lo), "v"(hi)); return r; }
__device__ __forceinline__ u32x4 zero4() { unsigned z; asm volatile("v_mov_b32 %0, 0" : "=v"(z)); return (u32x4){z, z, z, z}; }
__device__ __forceinline__ float bf2f(unsigned short h) { return __uint_as_float(((unsigned)h) << 16); }
__device__ __forceinline__ float bflo(unsigned w) { return __uint_as_float(w << 16); }
__device__ __forceinline__ float bfhi(unsigned w) { return __uint_as_float(w & 0xffff0000u); }
__device__ __forceinline__ float fexp2(float x) { return __builtin_amdgcn_exp2f(x); }
__device__ __forceinline__ float frcp(float x) { return __builtin_amdgcn_rcpf(x); }
__device__ __forceinline__ float sigmoidf_(float x) { return frcp(1.0f + fexp2(-LOG2E * x)); }
__device__ __forceinline__ float gelu_tanh_(float x) { const float u = 1.5957691216057308f * (x + 0.044715f * x * x * x); return x * sigmoidf_(u); }
template <int CTRL> __device__ __forceinline__ float dpp_f(float v) { return __int_as_float(__builtin_amdgcn_update_dpp(0, __float_as_int(v), CTRL, 0xF, 0xF, false)); }
__device__ __forceinline__ float wave_sum(float v) {
    v += dpp_f<0xB1>(v);
    v += dpp_f<0x4E>(v);
    v += dpp_f<0x141>(v);
    v += dpp_f<0x140>(v);
    const float a = __int_as_float(__builtin_amdgcn_readlane(__float_as_int(v), 0)), b = __int_as_float(__builtin_amdgcn_readlane(__float_as_int(v), 16));
    const float c = __int_as_float(__builtin_amdgcn_readlane(__float_as_int(v), 32)), d = __int_as_float(__builtin_amdgcn_readlane(__float_as_int(v), 48));
    return (a + b) + (c + d);
}

namespace pg8 {
constexpr int BM = 256, BK = 64, HALF = 128, HTB = HALF * BK * 2, STAGE_BYTES = 8 * HTB, NXCD = 8, WGM = 8;
__host__ __device__ __forceinline__ int lds_byte(int r, int c) { const int st = (r >> 4) * 2 + (c >> 5), rr = r & 15, cc = c & 31, ob = rr * 64 + cc * 2; return st * 1024 + (ob ^ (((ob >> 9) & 1) << 5)); }
__host__ __device__ __forceinline__ void stage_rc(int b, int& R, int& C) { const int st = b / 1024, sb = b % 1024, swz = sb ^ (((sb >> 9) & 1) << 5); R = (st >> 1) * 16 + swz / 64; C = (st & 1) * 32 + (swz % 64) / 2; }
__host__ __device__ __forceinline__ int perm32(int rho) { const int n = rho >> 4, i = rho & 15; return 8 * (i >> 2) + 4 * n + (i & 3); }

struct Unit { int pm, pn, e, pos0, ne; };
struct Gemm { const bf16_t* A; const bf16_t* Bt; int lda, ldb, K; };

struct StaticOrder {
    int nM, nN, nwg, G, c;
    __device__ __forceinline__ void init(int M, int N, int G_, int c_) { nM = M / BM; nN = N / BM; nwg = nM * nN; G = G_; c = c_; }
    __device__ __forceinline__ bool next(int i, Unit& u) const {
        const long L = (long)i * G + c; if (L >= nwg) return false;
        int wgid = (int)L; { const int q = nwg / NXCD, r = nwg % NXCD, xcd = wgid % NXCD, off = wgid / NXCD; wgid = (xcd < r ? xcd * (q + 1) : r * (q + 1) + (xcd - r) * q) + off; }
        const int nig = WGM * nN, gid = wgid / nig, fm = gid * WGM, gsz = (nM - fm) < WGM ? (nM - fm) : WGM;
        u.pm = fm + ((wgid % nig) % gsz); u.pn = (wgid % nig) / gsz; u.e = 0; u.pos0 = i; u.ne = 0; return true;
    }
    static constexpr bool GATHER = false;
    static constexpr bool SWAP = false;
    __device__ __forceinline__ bool swapped(const Unit&) const { return false; }
    __device__ __forceinline__ int arow(const Unit& u, int r) const { return u.pm * BM + r; }
    __device__ __forceinline__ int arow0(const Unit& u) const { return u.pm * BM; }
    __device__ __forceinline__ int brow(const Unit& u) const { return u.pn * BM; }
    __device__ __forceinline__ int koff(const Unit&) const { return 0; }
};

template <class E, class = void> struct EpiNst { static constexpr int V = 0; };
template <class E> struct EpiNst<E, decltype((void)E::NST)> { static constexpr int V = E::NST; };
template <class E, class = void> struct EpiPre { static constexpr bool V = false; };
template <class E> struct EpiPre<E, decltype((void)E::PRE)> { static constexpr bool V = E::PRE; };
template <class E, class = void> struct EpiF8 { static constexpr bool V = false; };
template <class E> struct EpiF8<E, decltype((void)E::F8)> { static constexpr bool V = E::F8; };
typedef int v8i32 __attribute__((ext_vector_type(8)));
typedef int v4i32 __attribute__((ext_vector_type(4)));
__device__ __forceinline__ v8i32 cat8(const bf16x8& a, const bf16x8& b) { const v4i32 x = __builtin_bit_cast(v4i32, a), y = __builtin_bit_cast(v4i32, b); return (v8i32){x[0], x[1], x[2], x[3], y[0], y[1], y[2], y[3]}; }
__device__ __forceinline__ void mfma_f8(f32x4& c, const v8i32& a, const v8i32& b) { int sc = 0x7f7f7f7f;
    asm volatile("v_mfma_scale_f32_16x16x128_f8f6f4 %0, %1, %2, %0, %3, %3 op_sel_hi:[0,0,0]" : "+v"(c) : "v"(a), "v"(b), "v"(sc)); }
template <class Epi, class Sched>
__device__ __forceinline__ void gemm_phase(LAS unsigned char* lds, const Gemm g, const Sched& S, const Epi& E, int tid_) {
    asm volatile("" : "+v"(tid_));
    const int tid = tid_, wid = __builtin_amdgcn_readfirstlane(tid >> 6), lane = tid & 63, wr = wid >> 2, wc = wid & 3, fr = lane & 15, fq = lane >> 4;
    int nt = g.K / BK; asm volatile("" : "+s"(nt));
    unsigned voffB[2];
#pragma unroll
    for (int i = 0; i < 2; ++i) { int R, C; stage_rc(tid * 16 + i * 8192, R, C); const int Rb = Epi::PERM ? ((R & ~31) + perm32(R & 31)) : R;
        voffB[i] = (unsigned)(Rb * g.ldb + C) * 2u; }
    const size_t kstep = (size_t)(BK * 2);
    const size_t hstepB = (size_t)HALF * g.ldb * 2;
    const unsigned ldsw = (unsigned)wid * 1024u;
    const int aoff = lds_byte(wr * 64 + fr, fq * 8), boff = lds_byte(wc * 32 + fr, fq * 8);
#define PG8_SA(b, h) (((b) * 2 + (h)) * HTB)
#define PG8_SB(b, h) ((4 + (b) * 2 + (h)) * HTB)
#define PG8_STAGE(bufoff, gbase, voff) do { _Pragma("unroll") for (int _i = 0; _i < 2; ++_i) \
        __builtin_amdgcn_global_load_lds((const unsigned*)((const char*)(gbase) + (voff)[_i]), (LAS unsigned*)(lds + (bufoff) + ldsw + _i * 8192), 16, 0, 0); } while (0)
#define PG8_LDA(dst, b, h) do { _Pragma("unroll") for (int m = 0; m < 4; ++m) _Pragma("unroll") for (int k = 0; k < 2; ++k) dst[m][k] = *(const LAS bf16x8*)(lds + PG8_SA(b, h) + aoff + m * 2048 + k * 1024); } while (0)
#define PG8_LDB(dst, b, h) do { _Pragma("unroll") for (int n = 0; n < 2; ++n) _Pragma("unroll") for (int k = 0; k < 2; ++k) dst[n][k] = *(const LAS bf16x8*)(lds + PG8_SB(b, h) + boff + n * 2048 + k * 1024); } while (0)
#define PG8_MMA(ai, bj, At, Bt) do { __builtin_amdgcn_s_setprio(1); \
        if constexpr (EpiF8<Epi>::V) { _Pragma("unroll") for (int m = 0; m < 4; ++m) _Pragma("unroll") for (int n = 0; n < 2; ++n) \
            mfma_f8(acc[ai][bj][m][n], cat8(Bt[n][0], Bt[n][1]), cat8(At[m][0], At[m][1])); } \
        else { _Pragma("unroll") for (int m = 0; m < 4; ++m) _Pragma("unroll") for (int n = 0; n < 2; ++n) _Pragma("unroll") for (int k = 0; k < 2; ++k) \
            acc[ai][bj][m][n] = __builtin_amdgcn_mfma_f32_16x16x32_bf16(Bt[n][k], At[m][k], acc[ai][bj][m][n], 0, 0, 0); } \
        __builtin_amdgcn_s_setprio(0); } while (0)
#define PG8_LDAH(dst, b, h, ml) do { _Pragma("unroll") for (int m = 0; m < 2; ++m) _Pragma("unroll") for (int k = 0; k < 2; ++k) dst[m][k] = *(const LAS bf16x8*)(lds + PG8_SA(b, h) + aoff + ((ml) + m) * 2048 + k * 1024); } while (0)
#define PG8_MMAH(ai, bj, A2_, Bt, ml) do { __builtin_amdgcn_s_setprio(1); _Pragma("unroll") for (int m = 0; m < 2; ++m) _Pragma("unroll") for (int n = 0; n < 2; ++n) \
        mfma_f8(acc[ai][bj][(ml) + m][n], cat8(Bt[n][0], Bt[n][1]), cat8(A2_[m][0], A2_[m][1])); \
        __builtin_amdgcn_s_setprio(0); } while (0)
#define PG8_WAIT_V(n) asm volatile("s_waitcnt vmcnt(" #n ")" ::: "memory")
#define PG8_WAIT_VR(rx) do { if constexpr (EpiNst<Epi>::V > 0) { if (rx) asm volatile("s_waitcnt vmcnt(%0)" :: "n"(8 + EpiNst<Epi>::V) : "memory"); else PG8_WAIT_V(8); } else PG8_WAIT_V(8); } while (0)
#define PG8_WAIT_L(n) asm volatile("s_waitcnt lgkmcnt(" #n ")" ::: "memory")
#define PG8_BAR __builtin_amdgcn_s_barrier()
#define PG8_SCHED __builtin_amdgcn_sched_barrier(0)
#define PG8_AOFF(dst, u) do { _Pragma("unroll") for (int _i = 0; _i < 2; ++_i) { int _R, _C; stage_rc(tid * 16 + _i * 8192, _R, _C); _Pragma("unroll") for (int _h = 0; _h < 2; ++_h) \
        dst[_h][_i] = ((unsigned)S.arow(u, _h * HALF + _R) * (unsigned)g.lda + (unsigned)_C) * 2u; } } while (0)
#define PG8_LOFF(dst) do { _Pragma("unroll") for (int _i = 0; _i < 2; ++_i) { int _R, _C; stage_rc(tid * 16 + _i * 8192, _R, _C); _Pragma("unroll") for (int _h = 0; _h < 2; ++_h) \
        dst[_h][_i] = ((unsigned)(_h * HALF + _R) * (unsigned)g.lda + (unsigned)_C) * 2u; } } while (0)
    Unit cur, nxt; int ui = 0;
    if (!S.next(0, cur)) return;
    f32x4 acc[2][2][4][2];
    if constexpr (Epi::INIT_ACC) E.init(acc, cur, wr, wc, fr, fq);
    else {
#pragma unroll
    for (int a = 0; a < 2; ++a)
#pragma unroll
        for (int b = 0; b < 2; ++b)
#pragma unroll
            for (int m = 0; m < 4; ++m)
#pragma unroll
                for (int n = 0; n < 2; ++n) acc[a][b][m][n] = (f32x4){0.f, 0.f, 0.f, 0.f};
    }
    bf16x8 At[4][2], B0[2][2], B1[2][2]; bf16x8 A2[2][2];
    constexpr bool GA = Sched::GATHER;
    unsigned ca[2][2], na[2][2];
    const char* cA = (const char*)g.A; const char* nA = cA;
    if constexpr (GA) { PG8_AOFF(ca, cur); }
    else { PG8_LOFF(ca); cA = (const char*)g.A + ((size_t)S.arow0(cur) * g.lda + S.koff(cur)) * 2; }
    const char* cB = (const char*)g.Bt + ((size_t)S.brow(cur) * g.ldb + S.koff(cur)) * 2;
    if constexpr (Sched::SWAP && !GA) { if (S.swapped(cur)) { const char* t_ = cA; cA = cB; cB = t_; } }
    PG8_STAGE(PG8_SB(0, 0), cB, voffB); PG8_STAGE(PG8_SB(0, 1), cB + hstepB, voffB); PG8_STAGE(PG8_SA(0, 0), cA, ca[0]);
    if (wr == 1) PG8_BAR;
    PG8_WAIT_V(0); PG8_BAR;
    if constexpr (EpiPre<Epi>::V) E.pre();
    PG8_STAGE(PG8_SA(0, 1), cA, ca[1]); PG8_STAGE(PG8_SB(1, 0), cB + kstep, voffB); PG8_STAGE(PG8_SA(1, 0), cA + kstep, ca[0]); PG8_STAGE(PG8_SB(1, 1), cB + hstepB + kstep, voffB);
    PG8_BAR;
    for (;;) {
        const bool has_next = S.next(ui + 1, nxt);
        const char* nB = cB; nA = cA;
        if (has_next) { nB = (const char*)g.Bt + ((size_t)S.brow(nxt) * g.ldb + S.koff(nxt)) * 2;
            if constexpr (GA) { PG8_AOFF(na, nxt); } else { nA = (const char*)g.A + ((size_t)S.arow0(nxt) * g.lda + S.koff(nxt)) * 2; }
            if constexpr (Sched::SWAP && !GA) { if (S.swapped(nxt)) { const char* t_ = nA; nA = nB; nB = t_; } } }
        else { if constexpr (GA) {
#pragma unroll
            for (int h = 0; h < 2; ++h)
#pragma unroll
                for (int i = 0; i < 2; ++i) na[h][i] = ca[h][i]; } }
        const int ntm = has_next ? nt : nt - 2;
        for (int t = 0; t < ntm; t += 2) {
            const bool last = (t == nt - 2); const bool rx = (t == 0) && (ui > 0);
            if constexpr (Epi::HAS_MID) { if (2 * t == nt) { int mfr = fr, mfq = fq; asm volatile("" : "+v"(mfr), "+v"(mfq)); E.mid(acc, cur, wr, wc, mfr, mfq); } }
            const char* a1 = cA + (size_t)(t + 1) * kstep;
            const char* a2 = last ? nA : cA + (size_t)(t + 2) * kstep; const char* b2 = last ? nB : cB + (size_t)(t + 2) * kstep;
            const char* a3 = a2 + kstep; const char* b3 = b2 + kstep;
            unsigned o2[2][2];
#pragma unroll
            for (int h = 0; h < 2; ++h)
#pragma unroll
                for (int i = 0; i < 2; ++i) { if constexpr (GA) o2[h][i] = last ? na[h][i] : ca[h][i]; else o2[h][i] = ca[h][i]; }
            PG8_LDB(B0, 0, 0); PG8_LDB(B1, 0, 1); PG8_SCHED; PG8_LDA(At, 0, 0); PG8_STAGE(PG8_SA(1, 1), a1, ca[1]);
            PG8_WAIT_VR(rx); PG8_WAIT_L(0); PG8_BAR; PG8_MMA(0, 0, At, B0); PG8_MMA(0, 1, At, B1); PG8_BAR; PG8_SCHED;
            PG8_LDA(At, 0, 1); PG8_STAGE(PG8_SB(0, 0), b2, voffB); PG8_STAGE(PG8_SB(0, 1), b2 + hstepB, voffB); PG8_STAGE(PG8_SA(0, 0), a2, o2[0]);
            PG8_WAIT_VR(rx); PG8_WAIT_L(0); PG8_BAR; PG8_MMA(1, 0, At, B0); PG8_MMA(1, 1, At, B1); PG8_BAR; PG8_SCHED;
            PG8_LDB(B0, 1, 0); PG8_LDB(B1, 1, 1); PG8_SCHED; PG8_LDA(At, 1, 0); PG8_STAGE(PG8_SA(0, 1), a2, o2[1]);
            PG8_WAIT_VR(rx); PG8_WAIT_L(0); PG8_BAR; PG8_MMA(0, 0, At, B0); PG8_MMA(0, 1, At, B1); PG8_BAR; PG8_SCHED;
            PG8_LDA(At, 1, 1); PG8_STAGE(PG8_SB(1, 0), b3, voffB); PG8_STAGE(PG8_SB(1, 1), b3 + hstepB, voffB); PG8_STAGE(PG8_SA(1, 0), a3, o2[0]);
            PG8_WAIT_V(8); PG8_WAIT_L(0); PG8_BAR; PG8_MMA(1, 0, At, B0); PG8_MMA(1, 1, At, B1); PG8_BAR; PG8_SCHED;
        }
        if (!has_next) { const int t = nt - 2;
            if constexpr (Epi::HAS_MID) { if (2 * t == nt) { int mfr = fr, mfq = fq; asm volatile("" : "+v"(mfr), "+v"(mfq)); E.mid(acc, cur, wr, wc, mfr, mfq); } }
            const char* a1 = cA + (size_t)(t + 1) * kstep;
            PG8_LDB(B0, 0, 0); PG8_LDB(B1, 0, 1); PG8_SCHED; PG8_LDA(At, 0, 0); PG8_STAGE(PG8_SA(1, 1), a1, ca[1]);
            PG8_WAIT_V(8); PG8_WAIT_L(0); PG8_BAR; PG8_MMA(0, 0, At, B0); PG8_MMA(0, 1, At, B1); PG8_BAR; PG8_SCHED;
            PG8_LDA(At, 0, 1);
            PG8_WAIT_V(2); PG8_WAIT_L(0); PG8_BAR; PG8_MMA(1, 0, At, B0); PG8_MMA(1, 1, At, B1); PG8_BAR; PG8_SCHED;
            PG8_LDB(B0, 1, 0); PG8_LDB(B1, 1, 1); PG8_SCHED; PG8_LDA(At, 1, 0);
            PG8_WAIT_V(0); PG8_WAIT_L(0); PG8_BAR; PG8_MMA(0, 0, At, B0); PG8_MMA(0, 1, At, B1); PG8_BAR; PG8_SCHED;
            PG8_LDA(At, 1, 1);
            PG8_WAIT_L(0); PG8_BAR; PG8_MMA(1, 0, At, B0); PG8_MMA(1, 1, At, B1); PG8_BAR; PG8_SCHED; }
        if (wr == 0) PG8_BAR;
        { int te = tid; asm volatile("" : "+v"(te)); int efr = (te & 63) & 15, efq = (te & 63) >> 4; asm volatile("" : "+v"(efr), "+v"(efq));
          E(acc, cur, wr, wc, efr, efq); }
        if (!has_next) break;
        if constexpr (Epi::INIT_ACC) E.init(acc, nxt, wr, wc, fr, fq);
        else {
#pragma unroll
        for (int a = 0; a < 2; ++a)
#pragma unroll
            for (int b = 0; b < 2; ++b)
#pragma unroll
                for (int m = 0; m < 4; ++m)
#pragma unroll
                    for (int n = 0; n < 2; ++n) acc[a][b][m][n] = (f32x4){0.f, 0.f, 0.f, 0.f};
        }
        cur = nxt; cB = nB; cA = nA; ++ui;
        if constexpr (GA) {
#pragma unroll
            for (int h = 0; h < 2; ++h)
#pragma unroll
                for (int i = 0; i < 2; ++i) ca[h][i] = na[h][i]; }
        if (wr == 1) PG8_BAR;
    }
    PG8_WAIT_V(0);
    PG8_BAR;
#undef PG8_SA
#undef PG8_SB
#undef PG8_STAGE
#undef PG8_LDA
#undef PG8_LDB
#undef PG8_MMA
#undef PG8_WAIT_V
#undef PG8_WAIT_L
#undef PG8_BAR
#undef PG8_SCHED
#undef PG8_AOFF
#undef PG8_LOFF
}
}
using pg8::Unit;

constexpr size_t MiB = 1u << 20;
constexpr size_t WS_CTL = 0, CTL_ZERO_BYTES = 131072;
constexpr size_t WS_RTAB = 1 * MiB + 262144;
constexpr size_t WS_MISC = 1 * MiB;
constexpr size_t WS_WIN = 2 * MiB, WS_WGT = 11 * MiB, WS_WAO = 12 * MiB, WS_WRO = 13 * MiB, WS_WOUT = 14 * MiB, WS_WPG = 16 * MiB, WS_WPP = 18 * MiB;
constexpr size_t WS_WGU = 20 * MiB, WS_WDN = 52 * MiB;
constexpr size_t WS_WPGL = 619 * MiB;
constexpr size_t WSET = 66 * MiB;
#define WOFF(L) ((size_t)((L) & 1) * WSET)
constexpr size_t WS_SSQ = 134 * MiB;
constexpr size_t WS_XB = 135 * MiB, WS_PB = 167 * MiB, WS_PP = 199 * MiB;
constexpr size_t WS_Q = 327 * MiB, WS_K = 343 * MiB, WS_VT = 359 * MiB, WS_XR = 375 * MiB, WS_XG = 391 * MiB, WS_GA = 407 * MiB, WS_GR = 439 * MiB, WS_XC = 471 * MiB;
constexpr size_t WS_DB = 487 * MiB, WS_AO = 519 * MiB, WS_RI = 535 * MiB, WS_PART = 551 * MiB, WS_MG = 583 * MiB, WS_SUM = 615 * MiB;
constexpr size_t WS_ACT = 327 * MiB, WS_Y0 = WS_DB, WS_Y1 = WS_AO, WS_TOK = 616 * MiB, WS_WL = 617 * MiB, WS_RS = 618 * MiB;
constexpr size_t WS_XBW = 551 * MiB;
constexpr size_t WS_XB8 = WS_MG;
constexpr size_t WS_END = 627 * MiB;
constexpr int CW_BAR = 4096, CW_CNT = 16384;

constexpr int RING_BYTES = 131072, LDSCTL_OFF = RING_BYTES, MISC_OFF = LDSCTL_OFF + 320, LDS_BYTES = 147456;
constexpr int TSTART_OFF = LDSCTL_OFF + 512;
constexpr int RSTD_OFF = LDSCTL_OFF + 2048, RSTD_UNITS = 5;

#define XB_TMO      128
#define XB_XCNT(j)  (256  + 64 * (j))
#define XB_XSUB(j)  (1280 + 64 * (j))
#define XB_XGEN(j)  (2304 + 64 * (j))
#define XB_TOP      3328
#define XB_TOPGEN   3392
#define XB_XSUBL(j) (3456 + 64 * (j))
#define XCD_BAR_WORDS 4480
#define XB_SPIN_CAP (1u << 18)
__device__ __forceinline__ unsigned xb_ld(unsigned* p)              { return __hip_atomic_load(p, __ATOMIC_RELAXED, __HIP_MEMORY_SCOPE_AGENT); }
__device__ __forceinline__ unsigned xb_add(unsigned* p, unsigned v) { return __hip_atomic_fetch_add(p, v, __ATOMIC_RELAXED, __HIP_MEMORY_SCOPE_AGENT); }
__device__ __forceinline__ unsigned xb_xcc_id() { return (unsigned)__builtin_amdgcn_s_getreg((3 << 11) | 20) & 0xFu; }
#define XB_SPIN(cond, bar) do { unsigned _sp = 0; while (cond) { __builtin_amdgcn_s_sleep(1); \
    if ((++_sp & 255u) == 0u) { if (xb_ld(&(bar)[XB_TMO])) break; if (_sp > XB_SPIN_CAP) { atomicAdd(&(bar)[XB_TMO], 1u); break; } } } } while (0)
struct XcdBarrier { unsigned* bar; unsigned x; volatile LAS unsigned* st; };
__device__ __forceinline__ XcdBarrier xcd_barrier_post(unsigned* bar, volatile LAS unsigned* st) {
    XcdBarrier b; b.bar = bar; b.x = xb_xcc_id(); b.st = st;
    if (threadIdx.x == 0) (void)xb_add(&bar[XB_XCNT(b.x)], 1u);
    return b;
}
__device__ __forceinline__ void xcd_barrier_complete(unsigned* bar, unsigned x, unsigned& nloc, unsigned& nx) {
    const unsigned G = gridDim.x * gridDim.y * gridDim.z;
    unsigned sum, cnt, mine, sp = 0u;
    for (;;) {
        sum = 0u; cnt = 0u; mine = 0u;
#pragma unroll
        for (unsigned j = 0; j < 16; ++j) { const unsigned c = xb_ld(&bar[XB_XCNT(j)]); sum += c; cnt += (c > 0u) ? 1u : 0u; mine = (j == x) ? c : mine; }
        if (sum == G) break;
        __builtin_amdgcn_s_sleep(1);
        if ((++sp & 255u) == 0u) { if (xb_ld(&bar[XB_TMO])) break; if (sp > XB_SPIN_CAP) { atomicAdd(&bar[XB_TMO], 1u); break; } }
    }
    nloc = mine > 0u ? mine : 1u; nx = cnt > 0u ? cnt : 1u;
}
__device__ __forceinline__ void xcd_barrier(const XcdBarrier& b, int mode = 0) {
    const bool local = mode != 0;
    asm volatile("s_waitcnt vmcnt(0)" ::: "memory");
    __syncthreads();
    if (threadIdx.x == 0) {
        unsigned* bar = b.bar;
        __builtin_amdgcn_s_waitcnt(0);
        unsigned nloc = b.st[0], nx = b.st[1];
        if (nloc == 0u) { xcd_barrier_complete(bar, b.x, nloc, nx); b.st[0] = nloc; b.st[1] = nx; }
        if (mode == 1) {
            const unsigned nl_ = b.st[4] + 1u; b.st[4] = nl_;
            __hip_atomic_fetch_add(&bar[XB_XSUBL(b.x)], 1u, __ATOMIC_RELAXED, __HIP_MEMORY_SCOPE_AGENT);
            __builtin_amdgcn_fence(__ATOMIC_ACQUIRE, "agent");
            XB_SPIN(xb_ld(&bar[XB_XSUBL(b.x)]) < nl_ * nloc, bar);
            asm volatile("s_waitcnt vmcnt(0)" ::: "memory");
        } else {
        const unsigned old = xb_add(&bar[XB_XSUB(b.x)], 1u);
        const unsigned gen = old / nloc;
        if (mode == 1) __builtin_amdgcn_fence(__ATOMIC_ACQUIRE, "agent");
        if (old + 1u == (gen + 1u) * nloc) {
            if (!local) {
            __builtin_amdgcn_fence(__ATOMIC_RELEASE, "agent");
            asm volatile("s_waitcnt vmcnt(0)" ::: "memory");
            const unsigned og = xb_add(&bar[XB_TOP], 1u);
            const unsigned tg = og / nx;
            if (og + 1u == (tg + 1u) * nx) xb_add(&bar[XB_TOPGEN], 1u);
            else XB_SPIN(xb_ld(&bar[XB_TOPGEN]) == tg, bar);
            }
            else if (mode == 2) {
                if ((b.x & 1u) == 0u) { __builtin_amdgcn_fence(__ATOMIC_RELEASE, "agent"); asm volatile("s_waitcnt vmcnt(0)" ::: "memory"); }
                else XB_SPIN(xb_ld(&bar[XB_XGEN(b.x - 1u)]) <= gen, bar);
            }
            if (mode != 1) __builtin_amdgcn_fence(__ATOMIC_ACQUIRE, "agent");
            xb_add(&bar[XB_XGEN(b.x)], 1u);
            asm volatile("s_waitcnt vmcnt(0)" ::: "memory");
        } else {
            XB_SPIN(xb_ld(&bar[XB_XGEN(b.x)]) == gen, bar);
            if (mode != 1) __builtin_amdgcn_fence(__ATOMIC_ACQUIRE, "agent");
            asm volatile("s_waitcnt vmcnt(0)" ::: "memory");
        }
    }
    }
    __syncthreads();
}

struct Args { const float* in[26]; float* out; unsigned char* ws; int ph_lo, ph_hi; };
struct Frame {
    LAS unsigned char* lds;
    unsigned* ctl;
    unsigned char* ws;
    int tid, lane, wave, G, bid;
    float* out;
};
struct XSpan { int base, first, stride, count; };
__device__ __forceinline__ XSpan xspan(int G, int bid, int n) { XSpan s; if ((G & 7) == 0) { s.base = (bid & 7) * (n >> 3); s.first = bid >> 3; s.stride = G >> 3; s.count = n >> 3; } else { s.base = 0; s.first = bid; s.stride = G; s.count = n; } return s; }
constexpr int PTAB_OFF = LDSCTL_OFF + 1024;
__device__ __forceinline__ const float* inp(const Frame& F, int k) {
    const unsigned long long v = ((const LAS unsigned long long*)(F.lds + PTAB_OFF))[k];
    const unsigned lo = __builtin_amdgcn_readfirstlane((unsigned)v), hi = __builtin_amdgcn_readfirstlane((unsigned)(v >> 32));
    return (const float*)(const GAS float*)(((unsigned long long)hi << 32) | lo);
}
#define LDS_WAIT() asm volatile("s_waitcnt lgkmcnt(0)" ::: "memory")

__device__ __forceinline__ float row_rstd(const float* SSQ, int row) {
    const f32x4* p = (const f32x4*)(SSQ + (size_t)row * 16); const f32x4 a = p[0], b = p[1], c = p[2], d = p[3];
    const float s = (((a[0] + a[1]) + (a[2] + a[3])) + ((b[0] + b[1]) + (b[2] + b[3]))) + (((c[0] + c[1]) + (c[2] + c[3])) + ((d[0] + d[1]) + (d[2] + d[3])));
    return 1.0f / sqrtf(s * (1.0f / D) + EPS);
}
typedef f32x4 AccT[2][2][4][2];

__device__ __forceinline__ unsigned pack_u8x4(float a, float b, float c, float d, unsigned lo) {
    const unsigned ua = max((unsigned)(a * 255.0f + 0.5f), lo), ub = max((unsigned)(b * 255.0f + 0.5f), lo), uc = max((unsigned)(c * 255.0f + 0.5f), lo), ud = max((unsigned)(d * 255.0f + 0.5f), lo);
    return ua | (ub << 8) | (uc << 16) | (ud << 24);
}
__device__ __forceinline__ f32x4 unpack_u8x4(unsigned w) { return (f32x4){(float)(w & 255u), (float)((w >> 8) & 255u), (float)((w >> 16) & 255u), (float)(w >> 24)} * (1.0f / 255.0f); }
__device__ __forceinline__ void store_pair16(unsigned char* addrA, unsigned char* addrB, int par, u32x2 pa, u32x2 pb) {
    const auto lo = __builtin_amdgcn_permlane16_swap(pb.x, pa.x, false, false), hi = __builtin_amdgcn_permlane16_swap(pb.y, pa.y, false, false);
    const u32x4 w = {lo[0], hi[0], lo[1], hi[1]};
    *(u32x4*)((par & 1) ? (addrA - 8) : addrB) = w;
}
constexpr float F8_YS = 32.0f;
constexpr float F8_XS = 8.0f, F8_WS = 256.0f, F8_AS = 8.0f;
__device__ __forceinline__ u32x2 pack_fp8x8(const float (&t)[8], float s) {
    unsigned w0 = 0u, w1 = 0u;
    w0 = __builtin_amdgcn_cvt_pk_fp8_f32(t[0] * s, t[1] * s, w0, false); w0 = __builtin_amdgcn_cvt_pk_fp8_f32(t[2] * s, t[3] * s, w0, true);
    w1 = __builtin_amdgcn_cvt_pk_fp8_f32(t[4] * s, t[5] * s, w1, false); w1 = __builtin_amdgcn_cvt_pk_fp8_f32(t[6] * s, t[7] * s, w1, true);
    return (u32x2){w0, w1};
}
struct EpiWin {
    static constexpr bool PERM = true, INIT_ACC = false, HAS_MID = false, F8 = true;
    static constexpr int NST = 8;
    static constexpr bool PRE = true;
    const float* SSQ; const LAS float* RL; bf16_t *Q, *K, *VT, *XR, *XG, *GA, *GR; LAS float* RLW; float rv0, rv1, rv2; int rhf;
    __device__ __forceinline__ void pre() const {
        if (rhf < RSTD_UNITS) RLW[rhf * 256] = rv0;
        if (rhf + 2 < RSTD_UNITS) RLW[(rhf + 2) * 256] = rv1;
        if (rhf + 4 < RSTD_UNITS) RLW[(rhf + 4) * 256] = rv2; }
    __device__ __forceinline__ void operator()(const AccT& acc, const Unit& u, int wr, int wc, int fr, int fq) const {
        const int pn = u.pn, row0 = u.pm * 256 + wr * 64 + fr, cl = wc * 32 + 8 * fq;
        float rsv[2][4];
        if (u.pos0 < RSTD_UNITS) {
#pragma unroll
            for (int ai = 0; ai < 2; ++ai)
#pragma unroll
                for (int m = 0; m < 4; ++m) rsv[ai][m] = RL[u.pos0 * 256 + ai * 128 + wr * 64 + m * 16 + fr] * (1.0f / (F8_XS * F8_WS));
        } else { const int l = fr + 16 * fq; const float r0 = row_rstd(SSQ, u.pm * 256 + wr * 64 + l), r1 = row_rstd(SSQ, u.pm * 256 + 128 + wr * 64 + l);
#pragma unroll
          for (int m = 0; m < 4; ++m) { rsv[0][m] = __shfl(r0, 16 * m + fr) * (1.0f / (F8_XS * F8_WS)); rsv[1][m] = __shfl(r1, 16 * m + fr) * (1.0f / (F8_XS * F8_WS)); } }
        if (pn == 4 || pn == 5) {
            float rt[2][8];
#pragma unroll
            for (int bj = 0; bj < 2; ++bj) { const int tl = bj * 128 + cl;
                if (u.pos0 < RSTD_UNITS) {
#pragma unroll
                    for (int q = 0; q < 8; ++q) rt[bj][q] = RL[u.pos0 * 256 + tl + q] * (1.0f / (F8_XS * F8_WS));
                } else {
#pragma unroll
                    for (int q = 0; q < 8; ++q) rt[bj][q] = row_rstd(SSQ, u.pm * 256 + tl + q) * (1.0f / (F8_XS * F8_WS)); } }
#pragma unroll
            for (int ai = 0; ai < 2; ++ai)
#pragma unroll
                for (int m = 0; m < 4; ++m) { const int f = (pn - 4) * 256 + ai * 128 + wr * 64 + m * 16 + fr, hh = f >> 6, dd = f & 63;
#pragma unroll
                    for (int bj = 0; bj < 2; ++bj) { const int row = u.pm * 256 + bj * 128 + cl; const int b = row >> 12, ts = row & (SEQ - 1);
                        const f32x4 v0 = acc[ai][bj][m][0], v1 = acc[ai][bj][m][1];
                        u32x2 wa, wb; wa.x = cvt_pk_bf16(v0[0] * rt[bj][0], v0[1] * rt[bj][1]); wa.y = cvt_pk_bf16(v0[2] * rt[bj][2], v0[3] * rt[bj][3]);
                        wb.x = cvt_pk_bf16(v1[0] * rt[bj][4], v1[1] * rt[bj][5]); wb.y = cvt_pk_bf16(v1[2] * rt[bj][6], v1[3] * rt[bj][7]);
                        const auto sx = __builtin_amdgcn_permlane16_swap(wa.x, wb.x, false, false), sy = __builtin_amdgcn_permlane16_swap(wa.y, wb.y, false, false);
                        const u32x4 w16 = {sx[0], sy[0], sx[1], sy[1]};
                        bf16_t* dst = VT + (((size_t)b * NHEAD + hh) * (SEQ / 32) + (ts >> 5)) * 2048 + dd * 32 + (ts & 16) + ((fq & 1) << 3);
                        *(u32x4*)dst = w16; }
                    asm volatile("" ::: "memory"); }
            return;
        }
        if (pn < 4) {
            bf16_t* base = Q + (size_t)(pn >> 1) * (size_t)((WS_K - WS_Q) / 2); const float sc = (pn < 2) ? QSCALE : 1.f; const int c0 = (pn & 1) * 256;
#pragma unroll
            for (int ai = 0; ai < 2; ++ai)
#pragma unroll
                for (int m = 0; m < 4; ++m) { const int row = row0 + ai * 128 + m * 16; const float rs = rsv[ai][m] * sc; const int b = row >> 12, ts = row & (SEQ - 1);
#pragma unroll
                    for (int bj = 0; bj < 2; ++bj) { const f32x4 v0 = acc[ai][bj][m][0] * rs, v1 = acc[ai][bj][m][1] * rs; const int c = c0 + bj * 128 + cl;
                        u32x4 w; w.x = cvt_pk_bf16(v0[0], v0[1]); w.y = cvt_pk_bf16(v0[2], v0[3]); w.z = cvt_pk_bf16(v1[0], v1[1]); w.w = cvt_pk_bf16(v1[2], v1[3]);
                        *(u32x4*)(base + (((size_t)b * NHEAD + (c >> 6)) * SEQ + ts) * 64 + (c & 63)) = w; }
                    asm volatile("" ::: "memory"); }
            return;
        }
        if (pn >= 10) {
            unsigned char* base8 = (unsigned char*)Q + ((pn < 14) ? (WS_GA - WS_Q) : (WS_GR - WS_Q)); const int c0g = (pn - ((pn < 14) ? 10 : 14)) * 256; const unsigned lo8 = (pn >= 14) ? 1u : 0u;
#pragma unroll
            for (int ai = 0; ai < 2; ++ai)
#pragma unroll
                for (int mp = 0; mp < 2; ++mp) { const int ma = 2 * mp, mb = ma + 1; const float ra = rsv[ai][ma], rb = rsv[ai][mb];
                    unsigned char* dA = base8 + (size_t)(row0 + ai * 128 + ma * 16) * 1024 + c0g + cl; unsigned char* dB = dA + (size_t)16 * 1024;
#pragma unroll
                    for (int bj = 0; bj < 2; ++bj) { const f32x4 a0 = acc[ai][bj][ma][0] * ra, a1 = acc[ai][bj][ma][1] * ra, b0 = acc[ai][bj][mb][0] * rb, b1 = acc[ai][bj][mb][1] * rb;
                        u32x2 pa, pb;
                        pa.x = pack_u8x4(sigmoidf_(a0[0]), sigmoidf_(a0[1]), sigmoidf_(a0[2]), sigmoidf_(a0[3]), lo8); pa.y = pack_u8x4(sigmoidf_(a1[0]), sigmoidf_(a1[1]), sigmoidf_(a1[2]), sigmoidf_(a1[3]), lo8);
                        pb.x = pack_u8x4(sigmoidf_(b0[0]), sigmoidf_(b0[1]), sigmoidf_(b0[2]), sigmoidf_(b0[3]), lo8); pb.y = pack_u8x4(sigmoidf_(b1[0]), sigmoidf_(b1[1]), sigmoidf_(b1[2]), sigmoidf_(b1[3]), lo8);
                        const auto lo = __builtin_amdgcn_permlane16_swap(pb.x, pa.x, false, false), hi = __builtin_amdgcn_permlane16_swap(pb.y, pa.y, false, false);
                        const u32x4 w = {lo[0], hi[0], lo[1], hi[1]};
                        *(u32x4*)(((fq & 1) ? (dA - 8) : dB) + bj * 128) = w; }
                    asm volatile("" ::: "memory"); }
            return;
        }
        int act = 0, pitch = 512, c0; float sc = 1.f; size_t boff;
        if (pn < 8) { boff = WS_XR - WS_Q; c0 = (pn - 6) * 256; }
        else if (pn < 10) { boff = WS_XG - WS_Q; c0 = (pn - 8) * 256; act = 1; }
        else if (pn < 14) { boff = WS_GA - WS_Q; c0 = (pn - 10) * 256; act = 2; pitch = 1024; }
        else { boff = WS_GR - WS_Q; c0 = (pn - 14) * 256; act = 2; pitch = 1024; }
        bf16_t* base = (bf16_t*)((unsigned char*)Q + boff);
#pragma unroll
        for (int ai = 0; ai < 2; ++ai)
#pragma unroll
            for (int m = 0; m < 4; ++m) { const int row = row0 + ai * 128 + m * 16; const float rs = rsv[ai][m] * sc;
#pragma unroll
                for (int bj = 0; bj < 2; ++bj) { f32x4 v0 = acc[ai][bj][m][0] * rs, v1 = acc[ai][bj][m][1] * rs;
                    if (act == 1) {
#pragma unroll
                        for (int q = 0; q < 4; ++q) { v0[q] = gelu_tanh_(v0[q]); v1[q] = gelu_tanh_(v1[q]); }
                    } else if (act == 2) {
#pragma unroll
                        for (int q = 0; q < 4; ++q) { v0[q] = sigmoidf_(v0[q]); v1[q] = sigmoidf_(v1[q]); }
                    }
                    u32x4 w; w.x = cvt_pk_bf16(v0[0], v0[1]); w.y = cvt_pk_bf16(v0[2], v0[3]); w.z = cvt_pk_bf16(v1[0], v1[1]); w.w = cvt_pk_bf16(v1[2], v1[3]);
                    *(u32x4*)(base + (size_t)row * pitch + c0 + bj * 128 + cl) = w; }
                asm volatile("" ::: "memory"); }
    }
};

struct EpiGates {
    static constexpr bool PERM = true, INIT_ACC = false, HAS_MID = false;
    const bf16_t* XC; const float *ba, *bx, *cA; unsigned* DB;
    __device__ __forceinline__ void operator()(const AccT& acc, const Unit& u, int wr, int wc, int fr, int fq) const {
        const int row0 = u.pm * 256 + wr * 64 + fr, ch0 = u.pn * 128 + wc * 32 + 8 * fq;
        float vba[8], vbx[8], vca[8];
#pragma unroll
        for (int q = 0; q < 8; ++q) { vba[q] = ba[ch0 + q]; vbx[q] = bx[ch0 + q]; vca[q] = cA[ch0 + q]; }
        u32x4 xwv[2][4];
#pragma unroll
        for (int ai = 0; ai < 2; ++ai)
#pragma unroll
            for (int m = 0; m < 4; ++m) xwv[ai][m] = *(const u32x4*)(XC + (size_t)(row0 + ai * 128 + m * 16) * DR + ch0);
#pragma unroll
        for (int ai = 0; ai < 2; ++ai)
#pragma unroll
            for (int m = 0; m < 4; ++m) { const int row = row0 + ai * 128 + m * 16;
                const u32x4 xw = xwv[ai][m];
                float xc[8] = {bflo(xw.x), bfhi(xw.x), bflo(xw.y), bfhi(xw.y), bflo(xw.z), bfhi(xw.z), bflo(xw.w), bfhi(xw.w)};
                unsigned od[8];
#pragma unroll
                for (int q = 0; q < 8; ++q) { const float pa = acc[ai][0][m][q >> 2][q & 3], px = acc[ai][1][m][q >> 2][q & 3];
                    const float r = sigmoidf_(pa + vba[q]), ig = sigmoidf_(px + vbx[q]);
                    const float la = vca[q] * r;
                    const float om1 = (la > -0.25f) ? (-la * (1.f + 0.5f * la * (1.f + (1.f / 3.f) * la * (1.f + 0.25f * la * (1.f + 0.2f * la))))) : (1.f - fexp2(LOG2E * la));
                    const float om2 = om1 * (2.f - om1);
                    od[q] = cvt_pk_bf16(om1, __builtin_amdgcn_sqrtf(om2) * (ig * xc[q])); }
                *(u32x4*)(DB + (size_t)row * DR + ch0) = (u32x4){od[0], od[1], od[2], od[3]}; *(u32x4*)(DB + (size_t)row * DR + ch0 + 4) = (u32x4){od[4], od[5], od[6], od[7]};
                asm volatile("" ::: "memory"); }
    }
};

struct EpiMerge {
    static constexpr bool PERM = true, INIT_ACC = false, HAS_MID = false;
    const bf16_t *GA, *GR; bf16_t *PART, *MG;
    __device__ __forceinline__ void operator()(const AccT& acc, const Unit& u, int wr, int wc, int fr, int fq) const {
        const int row0 = u.pm * 256 + wr * 64 + fr, c00 = u.pn * 256 + wc * 32 + 8 * fq;
        const bf16_t* G = GA + (size_t)u.e * (size_t)((WS_GR - WS_GA) / 2);
        bf16_t* OUT = PART + (size_t)u.e * (size_t)((WS_MG - WS_PART) / 2);
#pragma unroll
        for (int ai = 0; ai < 2; ++ai)
#pragma unroll
            for (int mp = 0; mp < 2; ++mp) {
                u32x4 gw[2][2], pw[2][2];
#pragma unroll
                for (int mm = 0; mm < 2; ++mm)
#pragma unroll
                    for (int bj = 0; bj < 2; ++bj) { const size_t o = (size_t)(row0 + ai * 128 + (2 * mp + mm) * 16) * D + c00 + bj * 128;
                        gw[mm][bj] = *(const u32x4*)(G + o); pw[mm][bj] = u.e ? *(const u32x4*)(PART + o) : zero4(); }
#pragma unroll
                for (int mm = 0; mm < 2; ++mm)
#pragma unroll
                    for (int bj = 0; bj < 2; ++bj) { const int m = 2 * mp + mm; const size_t o = (size_t)(row0 + ai * 128 + m * 16) * D + c00 + bj * 128;
                        const u32x4 g = gw[mm][bj], p = pw[mm][bj];
                        const f32x4 g0 = {bflo(g.x), bfhi(g.x), bflo(g.y), bfhi(g.y)}, g1 = {bflo(g.z), bfhi(g.z), bflo(g.w), bfhi(g.w)};
                        const f32x4 v0 = g0 * acc[ai][bj][m][0] + (f32x4){bflo(p.x), bfhi(p.x), bflo(p.y), bfhi(p.y)}, v1 = g1 * acc[ai][bj][m][1] + (f32x4){bflo(p.z), bfhi(p.z), bflo(p.w), bfhi(p.w)};
                        u32x4 w; w.x = cvt_pk_bf16(v0[0], v0[1]); w.y = cvt_pk_bf16(v0[2], v0[3]); w.z = cvt_pk_bf16(v1[0], v1[1]); w.w = cvt_pk_bf16(v1[2], v1[3]);
                        *(u32x4*)(OUT + o) = w; }
                asm volatile("" ::: "memory"); }
    }
};
struct EpiMerge2 {
    static constexpr bool PERM = true, INIT_ACC = false, HAS_MID = true;
    const unsigned char *GA, *GR; bf16_t* MG;
    __device__ __forceinline__ void mid(AccT& acc, const Unit& u, int wr, int wc, int fr, int fq) const {
        const int row0 = u.pm * 256 + wr * 64 + fr, c00 = u.pn * 256 + wc * 32 + 8 * fq;
#pragma unroll
        for (int ai = 0; ai < 2; ++ai)
#pragma unroll
            for (int mp = 0; mp < 2; ++mp) {
                u32x2 ga[2][2], gr[2][2];
#pragma unroll
                for (int mm = 0; mm < 2; ++mm)
#pragma unroll
                    for (int bj = 0; bj < 2; ++bj) { const size_t o = (size_t)(row0 + ai * 128 + (2 * mp + mm) * 16) * D + c00 + bj * 128; ga[mm][bj] = *(const u32x2*)(GA + o); gr[mm][bj] = *(const u32x2*)(GR + o); }
#pragma unroll
                for (int mm = 0; mm < 2; ++mm)
#pragma unroll
                    for (int bj = 0; bj < 2; ++bj) { const int m = 2 * mp + mm; const u32x2 a = ga[mm][bj], r = gr[mm][bj];
                        const f32x4 r0 = unpack_u8x4(r.x), r1 = unpack_u8x4(r.y);
                        acc[ai][bj][m][0] = acc[ai][bj][m][0] * (unpack_u8x4(a.x) * (f32x4){frcp(r0[0]), frcp(r0[1]), frcp(r0[2]), frcp(r0[3])});
                        acc[ai][bj][m][1] = acc[ai][bj][m][1] * (unpack_u8x4(a.y) * (f32x4){frcp(r1[0]), frcp(r1[1]), frcp(r1[2]), frcp(r1[3])}); }
                asm volatile("" ::: "memory"); }
    }
    __device__ __forceinline__ void operator()(const AccT& acc, const Unit& u, int wr, int wc, int fr, int fq) const {
        const int row0 = u.pm * 256 + wr * 64 + fr, c00 = u.pn * 256 + wc * 32 + 8 * fq;
#pragma unroll
        for (int ai = 0; ai < 2; ++ai)
#pragma unroll
            for (int mp = 0; mp < 2; ++mp) {
                u32x2 gr[2][2];
#pragma unroll
                for (int mm = 0; mm < 2; ++mm)
#pragma unroll
                    for (int bj = 0; bj < 2; ++bj) gr[mm][bj] = *(const u32x2*)(GR + (size_t)(row0 + ai * 128 + (2 * mp + mm) * 16) * D + c00 + bj * 128);
#pragma unroll
                for (int mm = 0; mm < 2; ++mm)
#pragma unroll
                    for (int bj = 0; bj < 2; ++bj) { const int m = 2 * mp + mm; const u32x2 r = gr[mm][bj];
                        const f32x4 v0 = acc[ai][bj][m][0] * unpack_u8x4(r.x), v1 = acc[ai][bj][m][1] * unpack_u8x4(r.y);
                        u32x4 w; w.x = cvt_pk_bf16(v0[0], v0[1]); w.y = cvt_pk_bf16(v0[2], v0[3]); w.z = cvt_pk_bf16(v1[0], v1[1]); w.w = cvt_pk_bf16(v1[2], v1[3]);
                        *(u32x4*)(MG + (size_t)(row0 + ai * 128 + m * 16) * D + c00 + bj * 128) = w; }
                asm volatile("" ::: "memory"); }
    }
};
struct WinOrder : pg8::StaticOrder {
    static constexpr bool SWAP = true;
    __device__ __forceinline__ bool swapped(const Unit& u) const { return (u.pn & ~1) == 4; }
};
struct GateOrder : pg8::StaticOrder {
    __device__ __forceinline__ int koff(const Unit& u) const { return 128 * u.pn; }
};
struct PairOrder : pg8::StaticOrder {
    __device__ __forceinline__ bool next(int i, Unit& u) const { const bool ok = pg8::StaticOrder::next(i >> 1, u); u.e = i & 1; return ok; }
    __device__ __forceinline__ int arow(const Unit& u, int r) const { return u.e * T + u.pm * 256 + r; }
    __device__ __forceinline__ int arow0(const Unit& u) const { return u.e * T + u.pm * 256; }
    __device__ __forceinline__ int brow(const Unit& u) const { return u.e * 1024 + u.pn * 256; }
};
struct PPOrder : pg8::StaticOrder {
    __device__ __forceinline__ int arow(const Unit& u, int r) const { return u.pm * 256 + r; }
    __device__ __forceinline__ int arow0(const Unit& u) const { return u.pm * 256; }
    __device__ __forceinline__ int brow(const Unit& u) const { return (u.pm >> 6) * 1024 + u.pn * 256; }
};
struct EpiResid {
    static constexpr bool PERM = true, INIT_ACC = true, HAS_MID = false;
    const bf16_t* XI; bf16_t* XO;
    __device__ __forceinline__ void init(AccT& acc, const Unit& u, int wr, int wc, int fr, int fq) const {
        const int row0 = u.pm * 256 + wr * 64 + fr, c00 = u.pn * 256 + wc * 32 + 8 * fq;
#pragma unroll
        for (int ai = 0; ai < 2; ++ai)
#pragma unroll
            for (int m = 0; m < 4; ++m) { const size_t ro = (size_t)(row0 + ai * 128 + m * 16) * D;
#pragma unroll
                for (int bj = 0; bj < 2; ++bj) { const u32x4 z = *(const u32x4*)(XI + ro + c00 + bj * 128);
                    acc[ai][bj][m][0] = (f32x4){bflo(z.x), bfhi(z.x), bflo(z.y), bfhi(z.y)}; acc[ai][bj][m][1] = (f32x4){bflo(z.z), bfhi(z.z), bflo(z.w), bfhi(z.w)}; } }
    }
    __device__ __forceinline__ void operator()(const AccT& acc, const Unit& u, int wr, int wc, int fr, int fq) const {
        const int row0 = u.pm * 256 + wr * 64 + fr, c00 = u.pn * 256 + wc * 32 + 8 * fq;
#pragma unroll
        for (int ai = 0; ai < 2; ++ai)
#pragma unroll
            for (int m = 0; m < 4; ++m) { const size_t ro = (size_t)(row0 + ai * 128 + m * 16) * D;
#pragma unroll
                for (int bj = 0; bj < 2; ++bj) { const f32x4 v0 = acc[ai][bj][m][0], v1 = acc[ai][bj][m][1];
                    u32x4 w; w.x = cvt_pk_bf16(v0[0], v0[1]); w.y = cvt_pk_bf16(v0[2], v0[3]); w.z = cvt_pk_bf16(v1[0], v1[1]); w.w = cvt_pk_bf16(v1[2], v1[3]);
                    *(u32x4*)(XO + ro + c00 + bj * 128) = w; }
                asm volatile("" ::: "memory"); }
    }
};
struct EpiBf16 {
    static constexpr bool PERM = true, INIT_ACC = false, HAS_MID = false;
    bf16_t* O; int ldc;
    __device__ __forceinline__ void operator()(const AccT& acc, const Unit& u, int wr, int wc, int fr, int fq) const {
        const int row0 = u.pm * 256 + wr * 64 + fr, c00 = u.pn * 256 + wc * 32 + 8 * fq;
#pragma unroll
        for (int ai = 0; ai < 2; ++ai)
#pragma unroll
            for (int m = 0; m < 4; ++m) { const int row = row0 + ai * 128 + m * 16;
#pragma unroll
                for (int bj = 0; bj < 2; ++bj) { const f32x4 v0 = acc[ai][bj][m][0], v1 = acc[ai][bj][m][1];
                    u32x4 w; w.x = cvt_pk_bf16(v0[0], v0[1]); w.y = cvt_pk_bf16(v0[2], v0[3]); w.z = cvt_pk_bf16(v1[0], v1[1]); w.w = cvt_pk_bf16(v1[2], v1[3]);
                    __builtin_nontemporal_store(w, (u32x4*)(O + (size_t)row * ldc + c00 + bj * 128)); }
                asm volatile("" ::: "memory"); }
    }
};
struct EpiGU {
    static constexpr bool PERM = true, INIT_ACC = false, HAS_MID = false, F8 = true;
    static constexpr int NST = 4;
    const float* RS; unsigned char* ACT;
    __device__ __forceinline__ void operator()(const AccT& acc, const Unit& u, int wr, int wc, int fr, int fq) const {
        const int r0 = wr * 64 + fr, c0 = u.pn * 128 + wc * 32 + 8 * fq;
        float rsv[2][4];
#pragma unroll
        for (int ai = 0; ai < 2; ++ai)
#pragma unroll
            for (int m = 0; m < 4; ++m) rsv[ai][m] = RS[(size_t)u.e * LCAP + u.pos0 + r0 + ai * 128 + m * 16] * (1.0f / (F8_XS * F8_WS));
#pragma unroll
        for (int ai = 0; ai < 2; ++ai)
#pragma unroll
            for (int mp = 0; mp < 2; ++mp) { u32x2 pk[2];
#pragma unroll
                for (int mm = 0; mm < 2; ++mm) { const int m = 2 * mp + mm; const float rs = rsv[ai][m]; float o[8];
#pragma unroll
                    for (int q = 0; q < 8; ++q) { const float gg = rs * acc[ai][0][m][q >> 2][q & 3], uu = rs * acc[ai][1][m][q >> 2][q & 3]; o[q] = gg * sigmoidf_(gg) * uu; }
                    pk[mm] = pack_fp8x8(o, F8_AS); }
                unsigned char* rowp = ACT + (size_t)(u.pm * 256 + r0 + ai * 128 + 2 * mp * 16) * DE + c0;
                store_pair16(rowp, rowp + (size_t)16 * DE, fq, pk[0], pk[1]);
                asm volatile("" ::: "memory"); }
    }
};
struct EpiDown {
    static constexpr bool PERM = true, INIT_ACC = false, HAS_MID = false, F8 = true;
    const unsigned* TOK; const float* WL; unsigned char *Y0, *Y1;
    __device__ __forceinline__ void operator()(const AccT& acc, const Unit& u, int wr, int wc, int fr, int fq) const {
        const int r0 = wr * 64 + fr, c00 = u.pn * 256 + wc * 32 + 8 * fq;
        unsigned tkv[2][4]; float wgv[2][4];
#pragma unroll
        for (int ai = 0; ai < 2; ++ai)
#pragma unroll
            for (int m = 0; m < 4; ++m) { const int p = u.pos0 + r0 + ai * 128 + m * 16; const bool ok = p < u.ne; tkv[ai][m] = ok ? TOK[(size_t)u.e * LCAP + p] : 0u; wgv[ai][m] = ok ? WL[(size_t)u.e * LCAP + p] * (F8_YS / (F8_AS * F8_WS)) : 0.f; }
#pragma unroll
        for (int ai = 0; ai < 2; ++ai)
#pragma unroll
            for (int mp = 0; mp < 2; ++mp) { const int ma = 2 * mp, mb = 2 * mp + 1;
                const int pA = u.pos0 + r0 + ai * 128 + ma * 16, pB = pA + 16; const bool okA = pA < u.ne, okB = pB < u.ne;
                const unsigned tA = tkv[ai][ma], tB = tkv[ai][mb]; const float wA = wgv[ai][ma], wB = wgv[ai][mb];
                unsigned char* dA = ((tA >> 31) ? Y1 : Y0) + (size_t)(tA & 0x7fffffffu) * 2048 + c00;
                unsigned char* dB = ((tB >> 31) ? Y1 : Y0) + (size_t)(tB & 0x7fffffffu) * 2048 + c00;
#pragma unroll
                for (int bj = 0; bj < 2; ++bj) {
                    const f32x4 a0 = acc[ai][bj][ma][0] * wA, a1 = acc[ai][bj][ma][1] * wA, b0 = acc[ai][bj][mb][0] * wB, b1 = acc[ai][bj][mb][1] * wB;
                    const float ta[8] = {a0[0], a0[1], a0[2], a0[3], a1[0], a1[1], a1[2], a1[3]}, tb[8] = {b0[0], b0[1], b0[2], b0[3], b1[0], b1[1], b1[2], b1[3]};
                    const u32x2 pa = pack_fp8x8(ta, 1.0f), pb = pack_fp8x8(tb, 1.0f);
                    const auto lo = __builtin_amdgcn_permlane16_swap(pb.x, pa.x, false, false), hi = __builtin_amdgcn_permlane16_swap(pb.y, pa.y, false, false);
                    const u32x4 w = {lo[0], hi[0], lo[1], hi[1]};
                    const bool odd = (fq & 1) != 0;
                    if (odd ? okA : okB) *(u32x4*)((odd ? (dA - 8) : dB) + bj * 128) = w; }
                asm volatile("" ::: "memory"); }
    }
};
struct EpiPle {
    static constexpr bool PERM = true, INIT_ACC = false, HAS_MID = false;
    const float* rstd; const bf16_t* PP; const bf16_t* X; bf16_t* XO; float* SSQ; unsigned char* X8;
    __device__ __forceinline__ void operator()(const AccT& acc, const Unit& u, int wr, int wc, int fr, int fq) const {
        const int row0 = u.pm * 256 + wr * 64 + fr, c00 = u.pn * 256 + wc * 32 + 8 * fq;
        u32x4 gp[2][4][2];
#pragma unroll
        for (int ai = 0; ai < 2; ++ai) {
            float rsv[4]; u32x4 ppv[4][2];
#pragma unroll
            for (int m = 0; m < 4; ++m) { const int row = row0 + ai * 128 + m * 16; rsv[m] = rstd[row];
#pragma unroll
                for (int bj = 0; bj < 2; ++bj) ppv[m][bj] = *(const u32x4*)(PP + (size_t)row * D + c00 + bj * 128); }
#pragma unroll
            for (int m = 0; m < 4; ++m)
#pragma unroll
                for (int bj = 0; bj < 2; ++bj) { const u32x4 pw = ppv[m][bj]; const f32x4 a = acc[ai][bj][m][0] * rsv[m], b = acc[ai][bj][m][1] * rsv[m];
                    gp[ai][m][bj].x = cvt_pk_bf16(sigmoidf_(a[0]) * bflo(pw.x), sigmoidf_(a[1]) * bfhi(pw.x));
                    gp[ai][m][bj].y = cvt_pk_bf16(sigmoidf_(a[2]) * bflo(pw.y), sigmoidf_(a[3]) * bfhi(pw.y));
                    gp[ai][m][bj].z = cvt_pk_bf16(sigmoidf_(b[0]) * bflo(pw.z), sigmoidf_(b[1]) * bfhi(pw.z));
                    gp[ai][m][bj].w = cvt_pk_bf16(sigmoidf_(b[2]) * bflo(pw.w), sigmoidf_(b[3]) * bfhi(pw.w)); }
            asm volatile("" ::: "memory"); }
#pragma unroll
        for (int ai = 0; ai < 2; ++ai) {
            u32x4 xv[4][2];
#pragma unroll
            for (int m = 0; m < 4; ++m)
#pragma unroll
                for (int bj = 0; bj < 2; ++bj) xv[m][bj] = *(const u32x4*)(X + (size_t)(row0 + ai * 128 + m * 16) * D + c00 + bj * 128);
            u32x2 p8[4][2];
#pragma unroll
            for (int m = 0; m < 4; ++m) { const int row = row0 + ai * 128 + m * 16; const size_t ro = (size_t)row * D; float sq = 0.f;
#pragma unroll
                for (int bj = 0; bj < 2; ++bj) { const u32x4 g = gp[ai][m][bj], z = xv[m][bj];
                    const float x0 = bflo(z.x) + bflo(g.x), x1 = bfhi(z.x) + bfhi(g.x), x2 = bflo(z.y) + bflo(g.y), x3 = bfhi(z.y) + bfhi(g.y);
                    const float x4 = bflo(z.z) + bflo(g.z), x5 = bfhi(z.z) + bfhi(g.z), x6 = bflo(z.w) + bflo(g.w), x7 = bfhi(z.w) + bfhi(g.w);
                    sq += ((x0 * x0 + x1 * x1) + (x2 * x2 + x3 * x3)) + ((x4 * x4 + x5 * x5) + (x6 * x6 + x7 * x7));
                    u32x4 w; w.x = cvt_pk_bf16(x0, x1); w.y = cvt_pk_bf16(x2, x3); w.z = cvt_pk_bf16(x4, x5); w.w = cvt_pk_bf16(x6, x7);
                    *(u32x4*)(XO + ro + c00 + bj * 128) = w;
                    { const float xe[8] = {x0, x1, x2, x3, x4, x5, x6, x7}; p8[m][bj] = pack_fp8x8(xe, F8_XS); } }
                sq += __shfl_xor(sq, 16); sq += __shfl_xor(sq, 32);
                if (fq == 0) SSQ[(size_t)row * 16 + u.pn * 4 + wc] = sq; }
#pragma unroll
            for (int mp = 0; mp < 2; ++mp)
#pragma unroll
                for (int bj = 0; bj < 2; ++bj) { unsigned char* rowp = X8 + (size_t)(row0 + ai * 128 + 2 * mp * 16) * 2048 + c00 + bj * 128;
                    store_pair16(rowp, rowp + (size_t)16 * 2048, fq, p8[2 * mp][bj], p8[2 * mp + 1][bj]); }
            asm volatile("" ::: "memory"); }
    }
};

template <bool GATHER_> struct GroupSched {
    static constexpr bool GATHER = GATHER_;
    static constexpr bool SWAP = false;
    __device__ __forceinline__ bool swapped(const Unit&) const { return false; }
    const LAS int* tab; int G, c; const unsigned* TOK;
    __device__ __forceinline__ bool next(int i, Unit& u) const {
        const int ntile = tab[16]; int j, pn;
        if ((G & 7) == 0) { const int q = i * (G >> 3) + (c >> 3), x = c & 7, per = ntile >> 3, rem = ntile & 7, ntx = per + (x < rem ? 1 : 0), jl = q >> 2;
            if (jl >= ntx) return false;
            j = x * per + (x < rem ? x : rem) + jl; pn = q & 3; }
        else { const int Lu = i * G + c; j = Lu >> 2; pn = Lu & 3; if (j >= ntile) return false; }
        int e = 0;
#pragma unroll
        for (int k = 1; k < 16; ++k) e += (j >= tab[k]) ? 1 : 0;
        e = __builtin_amdgcn_readfirstlane(e);
        u.pm = j; u.pn = pn; u.e = e; u.pos0 = __builtin_amdgcn_readfirstlane((j - tab[e]) * 256); u.ne = __builtin_amdgcn_readfirstlane(tab[17 + e]); return true;
    }
    __device__ __forceinline__ int arow0(const Unit& u) const { return u.pm * 256; }
    __device__ __forceinline__ int arow(const Unit& u, int r) const {
        const int p = u.pos0 + r;
        return (p < u.ne) ? (int)(TOK[(size_t)u.e * LCAP + p] & 0x7fffffffu) : 0;
    }
    __device__ __forceinline__ int brow(const Unit& u) const { return u.e * 1024 + u.pn * 256; }
    __device__ __forceinline__ int koff(const Unit&) const { return 0; }
};

__device__ __forceinline__ void group_light(int G, int bid, int ntile, int& nl, int& li) {
    if ((G & 7) == 0) { const int W = G >> 3, maxu = (4 * ((ntile + 7) >> 3) + W - 1) / W; int tot = 0, mine = -1;
        for (int x = 0; x < 8; ++x) { const int ntx = (ntile + 7 - x) >> 3; int h = 4 * ntx - (maxu - 1) * W; h = h < 0 ? 0 : (h > W ? W : h);
            if (x == (bid & 7)) mine = ((bid >> 3) >= h) ? tot + (bid >> 3) - h : -1;
            tot += W - h; }
        nl = tot; li = mine; }
    else { const int nun = 4 * ntile, maxu = (nun + G - 1) / G, nheavy = nun - (maxu - 1) * G; nl = G - nheavy; li = bid - nheavy; }
    if (nl < 64) { nl = G; li = bid; }
}

struct TrDesc { const float* W; bf16_t* WT; int N, ldt, kofs, nbase, mode, rowoff, k0, n0, gsel, f8; };
__device__ __forceinline__ void tr_load(const TrDesc& d, int lane, f32x4 (&v)[8]) {
    const float* p = d.W + (size_t)(d.k0 + (lane >> 3)) * d.N + d.n0 + 4 * (lane & 7);
#pragma unroll
    for (int i = 0; i < 8; ++i) v[i] = __builtin_nontemporal_load((const f32x4*)(p + (size_t)(8 * i) * d.N));
}
__device__ __forceinline__ void tr_store(const TrDesc& d, int lane, const f32x4 (&v)[8], LAS float* scr, const LAS float* gains) {
#pragma unroll
    for (int i = 0; i < 8; ++i) *(LAS f32x4*)(scr + (8 * i + (lane >> 3)) * 36 + 4 * (lane & 7)) = v[i];
    LDS_WAIT(); asm volatile("" ::: "memory");
    const int n = lane & 31;
    const LAS float* gl = gains + d.gsel * 1024 + d.k0;
    const int nn = d.nbase + d.n0 + n; const int drow = (d.mode ? (256 * (nn >> 7) + (nn & 127)) : nn) + d.rowoff;
    if (d.f8) {
#pragma unroll
        for (int jp = 0; jp < 2; ++jp) { u32x2 pk[2];
#pragma unroll
            for (int jj = 0; jj < 2; ++jj) { const int c = (lane >> 5) + 2 * (2 * jp + jj); const LAS float* s = scr + (8 * c) * 36 + n; const LAS float* gq = gl + 8 * c;
                float t[8];
#pragma unroll
                for (int q = 0; q < 8; ++q) t[q] = s[q * 36] * gq[q];
                pk[jj] = pack_fp8x8(t, F8_WS); }
            const auto sx = __builtin_amdgcn_permlane32_swap(pk[0].x, pk[1].x, false, false), sy = __builtin_amdgcn_permlane32_swap(pk[0].y, pk[1].y, false, false);
            const u32x4 w16 = {sx[0], sy[0], sx[1], sy[1]};
            *(u32x4*)((unsigned char*)d.WT + (size_t)drow * d.ldt + d.kofs + d.k0 + 32 * jp + 16 * (lane >> 5)) = w16; } }
    else {
#pragma unroll
        for (int j = 0; j < 4; ++j) { const int c = (lane >> 5) + 2 * j; const LAS float* s = scr + (8 * c) * 36 + n; const LAS float* gq = gl + 8 * c;
            float t[8];
#pragma unroll
            for (int q = 0; q < 8; ++q) t[q] = s[q * 36] * gq[q];
            u32x4 o; o.x = cvt_pk_bf16(t[0], t[1]); o.y = cvt_pk_bf16(t[2], t[3]); o.z = cvt_pk_bf16(t[4], t[5]); o.w = cvt_pk_bf16(t[6], t[7]);
            *(u32x4*)(d.WT + (size_t)drow * d.ldt + d.kofs + d.k0 + 8 * c) = o; } }
    LDS_WAIT(); asm volatile("" ::: "memory");
}
constexpr int I_IN = 16 * 144, I_AO = 8 * 32, I_OUT = 16 * 32, I_PP = 4 * 32, I_EG = 16 * 16 * 16, I_ED = 16 * 8 * 32, I_RG = 16;
constexpr int TR_NITEMS = I_IN + 2 * I_AO + 2 * I_OUT + 2 * I_EG + I_ED + 2 * I_RG;
constexpr int TR_S1 = 4096, TR_S2 = 10800;
struct Frame;
__device__ __forceinline__ void tr_decode(const Frame& F, int L, int it, TrDesc& d);

__device__ __forceinline__ void route_tables(Frame& F, int L, int first, int stride) {
    const float* wrg = inp(F, 15) + (size_t)L * D * 4; const float* wre = inp(F, 17) + (size_t)L * D * 16; const float* gm = inp(F, 14) + L * D;
    unsigned char* img = F.ws + WS_RTAB + (size_t)(L & 1) * 81920;
    for (int en = first * 64 + F.lane; en < 32 * 64 + 32 * 16; en += stride * 64) {
        int ks, kg, n; unsigned char *ph, *pl;
        if (en < 2048) { ks = en >> 6; const int l = en & 63; kg = l >> 4; n = l & 15; ph = img + en * 16; pl = img + 32768 + en * 16; }
        else { const int r = en - 2048; ks = r >> 4; kg = (r >> 2) & 3; n = 16 + (r & 3); ph = img + 65536 + r * 16; pl = img + 65536 + 8192 + r * 16; }
        const int k0 = 32 * ks + 8 * kg; float v[8];
#pragma unroll
        for (int j = 0; j < 8; ++j) { const int k = k0 + j; const float w = (n < 4) ? wrg[k * 4 + n] : wre[k * 16 + (n - 4)]; v[j] = w * gm[k]; }
        unsigned hw[4];
#pragma unroll
        for (int j = 0; j < 4; ++j) hw[j] = cvt_pk_bf16(v[2 * j], v[2 * j + 1]);
        u32x4 lo;
        lo.x = cvt_pk_bf16(v[0] - bflo(hw[0]), v[1] - bfhi(hw[0])); lo.y = cvt_pk_bf16(v[2] - bflo(hw[1]), v[3] - bfhi(hw[1]));
        lo.z = cvt_pk_bf16(v[4] - bflo(hw[2]), v[5] - bfhi(hw[2])); lo.w = cvt_pk_bf16(v[6] - bflo(hw[3]), v[7] - bfhi(hw[3]));
        *(u32x4*)ph = (u32x4){hw[0], hw[1], hw[2], hw[3]}; *(u32x4*)pl = lo; }
}
__device__ __forceinline__ void prep_weights(Frame& F, int L, int it_lo, int it_hi, int first, int stride) {
    LAS float* scr = (LAS float*)(F.lds + F.wave * 9216);
    LAS float* gains = (LAS float*)(F.lds + 8 * 9216);
    const int lane = F.lane; unsigned char* ws = F.ws;
    { const float* g1 = inp(F, 2) + L * D; const float* g2 = inp(F, 14) + L * D; const float* g3 = inp(F, 22) + L * D;
      __syncthreads();
      for (int i = F.tid; i < 1024; i += 512) { gains[i] = 1.0f; gains[1024 + i] = g1[i]; gains[2048 + i] = g2[i]; gains[3072 + i] = g3[i]; }
      __syncthreads(); }
    { int it = it_lo + first; TrDesc d, dn; f32x4 v[8], vn[8]; const int nitems = it_hi;
      if (it < nitems) { tr_decode(F, L, it, d); tr_load(d, lane, v); }
      while (it < nitems) { const int itn = it + stride;
          if (itn < nitems) { tr_decode(F, L, itn, dn); tr_load(dn, lane, vn); }
          tr_store(d, lane, v, scr, gains);
          d = dn;
#pragma unroll
          for (int i = 0; i < 8; ++i) v[i] = vn[i];
          it = itn; } }
    if (it_lo == 0) for (int row = first; row < 1024; row += stride) { const int g = (((row >> 8) * 128) + (row & 127)) >> 6;
        if ((lane >> 3) != g) *(u32x4*)((bf16_t*)(ws + WOFF(L) + WS_WGT) + (size_t)row * DR + 8 * lane) = zero4(); }
    if (it_lo == 0) route_tables(F, L, first, stride);
    if (it_lo == 0 && first == 0) { float* cA = (float*)(ws + WS_MISC + 196608 + (L & 1) * 2048); const float* lam = inp(F, 10) + L * DR;
        for (int c = lane; c < DR; c += 64) { const float l = lam[c]; const float sp = (l > 0.f) ? log1pf(expf(-l)) : (-l + log1pf(expf(l))); cA[c] = -8.0f * sp; } }
    __syncthreads();
}
__device__ __forceinline__ void prep_phase(Frame& F) {
    const int gw = F.bid * 8 + F.wave, NGW = F.G * 8, lane = F.lane;
    unsigned char* ws = F.ws;
    prep_weights(F, 0, 0, TR_NITEMS + 4 * I_PP, gw, NGW);
    { const float* x = inp(F, 0); bf16_t* xb = (bf16_t*)(ws + WS_XBW); float* SSQ = (float*)(ws + WS_SSQ);
      for (int m = gw; m < T; m += NGW) { const f32x4* xr = (const f32x4*)(x + (size_t)m * D) + lane; f32x4 v[4]; float s = 0.f;
#pragma unroll
          for (int j = 0; j < 4; ++j) { v[j] = xr[64 * j]; s += (v[j][0] * v[j][0] + v[j][1] * v[j][1]) + (v[j][2] * v[j][2] + v[j][3] * v[j][3]); }
          s = wave_sum(s); if (lane < 16) SSQ[(size_t)m * 16 + lane] = (lane == 0) ? s : 0.f;
          u32x2* o = (u32x2*)(xb + (size_t)m * D) + lane;
#pragma unroll
          for (int j = 0; j < 4; ++j) { u32x2 w; w.x = cvt_pk_bf16(v[j][0], v[j][1]); w.y = cvt_pk_bf16(v[j][2], v[j][3]); o[64 * j] = w;
              unsigned w8 = 0u; w8 = __builtin_amdgcn_cvt_pk_fp8_f32(v[j][0] * F8_XS, v[j][1] * F8_XS, w8, false); w8 = __builtin_amdgcn_cvt_pk_fp8_f32(v[j][2] * F8_XS, v[j][3] * F8_XS, w8, true);
              *(unsigned*)(ws + WS_XB8 + (size_t)m * 2048 + 4 * lane + 256 * j) = w8; } } }
    { const float* p = inp(F, 1); bf16_t* pb = (bf16_t*)(ws + WS_PB); const size_t n8 = (size_t)DEPTH * T * PLED / 8;
        for (size_t i = (size_t)F.bid * 512 + F.tid; i < n8; i += (size_t)F.G * 512) { const f32x4 a = *(const f32x4*)(p + i * 8), b = *(const f32x4*)(p + i * 8 + 4);
            u32x4 w; w.x = cvt_pk_bf16(a[0], a[1]); w.y = cvt_pk_bf16(a[2], a[3]); w.z = cvt_pk_bf16(b[0], b[1]); w.w = cvt_pk_bf16(b[2], b[3]); *(u32x4*)(pb + i * 8) = w; } }
}
__device__ __forceinline__ void tr_decode(const Frame& F, int L, int it, TrDesc& d) {
    unsigned char* ws = F.ws; int r = it;
    d.kofs = 0; d.nbase = 0; d.mode = 0; d.rowoff = 0; d.gsel = 0; d.f8 = 0;
    int nblk;
    if (r < I_IN) { d.W = inp(F, 3) + (size_t)L * D * NIN; d.N = NIN; d.WT = (bf16_t*)(ws + WOFF(L) + WS_WIN); d.ldt = 2 * D; d.f8 = 1; d.gsel = 1; nblk = 144; }
    else if ((r -= I_IN) < I_AO) { d.W = inp(F, 11) + (size_t)L * DA * D; d.N = D; d.WT = (bf16_t*)(ws + WOFF(L) + WS_WAO); d.ldt = D; nblk = 32; }
    else if ((r -= I_AO) < I_AO) { d.W = inp(F, 12) + (size_t)L * DR * D; d.N = D; d.WT = (bf16_t*)(ws + WOFF(L) + WS_WAO); d.ldt = D; d.kofs = DA; nblk = 32; }
    else if ((r -= I_AO) < I_OUT) { d.W = inp(F, 13) + (size_t)L * D * D; d.N = D; d.WT = (bf16_t*)(ws + WOFF(L) + WS_WOUT); d.ldt = D; nblk = 32; }
    else if ((r -= I_OUT) < I_OUT) { d.W = inp(F, 23) + (size_t)L * D * D; d.N = D; d.WT = (bf16_t*)(ws + WS_WPGL) + (size_t)L * D * D; d.ldt = D; d.gsel = 3; nblk = 32; }
    else if ((r -= I_OUT) < I_EG) { const int e = r >> 8; r &= 255; d.W = inp(F, 19) + ((size_t)L * NE + e) * D * DE; d.N = DE; d.WT = (bf16_t*)(ws + WOFF(L) + WS_WGU + (size_t)e * 1024 * 1024); d.ldt = D; d.f8 = 1; d.mode = 1; d.gsel = 2; nblk = 16; }
    else if ((r -= I_EG) < I_EG) { const int e = r >> 8; r &= 255; d.W = inp(F, 20) + ((size_t)L * NE + e) * D * DE; d.N = DE; d.WT = (bf16_t*)(ws + WOFF(L) + WS_WGU + (size_t)e * 1024 * 1024); d.ldt = D; d.f8 = 1; d.mode = 1; d.rowoff = 128; d.gsel = 2; nblk = 16; }
    else if ((r -= I_EG) < I_ED) { const int e = r >> 8; r &= 255; d.W = inp(F, 21) + ((size_t)L * NE + e) * DE * D; d.N = D; d.WT = (bf16_t*)(ws + WOFF(L) + WS_WDN + (size_t)e * 1024 * 512); d.ldt = DE; d.f8 = 1; nblk = 32; }
    else if ((r -= I_ED) < I_RG) { const int g = r >> 1; r &= 1; d.W = inp(F, 6) + ((size_t)L * 8 + g) * 4096; d.N = 64; d.WT = (bf16_t*)(ws + WOFF(L) + WS_WGT); d.ldt = DR; d.kofs = 64 * g; d.nbase = 64 * g; d.mode = 1; nblk = 2; }
    else if ((r -= I_RG) < I_RG) { const int g = r >> 1; r &= 1; d.W = inp(F, 8) + ((size_t)L * 8 + g) * 4096; d.N = 64; d.WT = (bf16_t*)(ws + WOFF(L) + WS_WGT); d.ldt = DR; d.kofs = 64 * g; d.nbase = 64 * g; d.mode = 1; d.rowoff = 128; nblk = 2; }
    else { r -= I_RG; const int l = r / I_PP; r -= l * I_PP; d.W = inp(F, 24) + (size_t)l * PLED * D; d.N = D; d.WT = (bf16_t*)(ws + WS_WPP) + (size_t)l * 1024 * PLED; d.ldt = PLED; nblk = 32; }
    d.k0 = 64 * (r / nblk); d.n0 = 32 * (r % nblk);
}

__device__ __forceinline__ void conv_phase(Frame& F, int L) {
    const bf16_t* XR = (const bf16_t*)(F.ws + WS_XR); bf16_t* XC = (bf16_t*)(F.ws + WS_XC);
    const float* cw = inp(F, 4) + (size_t)L * 4 * DR; const float* cb = inp(F, 5) + L * DR;
    const int c0 = (F.tid & 63) * 8;
    float w[4][8], bsv[8];
#pragma unroll
    for (int q = 0; q < 8; ++q) { bsv[q] = cb[c0 + q];
#pragma unroll
        for (int j = 0; j < 4; ++j) w[j][q] = cw[j * DR + c0 + q]; }
    const XSpan sp = xspan(F.G, F.bid, T / 64);
    for (int it = sp.first; it < sp.count; it += sp.stride) { const int task = (sp.base + it) * 8 + (F.tid >> 6); const int t0 = task * 8, ts0 = t0 & (SEQ - 1);
        u32x4 xw[11];
#pragma unroll
        for (int i = 0; i < 11; ++i) xw[i] = (ts0 - 3 + i >= 0) ? *(const u32x4*)(XR + (size_t)(t0 - 3 + i) * DR + c0) : zero4();
#pragma unroll
        for (int r = 0; r < 8; ++r) { float o[8];
#pragma unroll
            for (int q = 0; q < 8; ++q) o[q] = bsv[q];
#pragma unroll
            for (int j = 0; j < 4; ++j) { const u32x4 z = xw[r + j];
                const float xv[8] = {bflo(z.x), bfhi(z.x), bflo(z.y), bfhi(z.y), bflo(z.z), bfhi(z.z), bflo(z.w), bfhi(z.w)};
#pragma unroll
                for (int q = 0; q < 8; ++q) o[q] += w[j][q] * xv[q]; }
            u32x4 ow; ow.x = cvt_pk_bf16(o[0], o[1]); ow.y = cvt_pk_bf16(o[2], o[3]); ow.z = cvt_pk_bf16(o[4], o[5]); ow.w = cvt_pk_bf16(o[6], o[7]);
            *(u32x4*)(XC + (size_t)(t0 + r) * DR + c0) = ow; } }
}

__device__ __forceinline__ void attn_unit(const bf16_t* Q, const bf16_t* K, const bf16_t* VT, bf16_t* O, int b, int h, int jb, int lane) {
    const int r32 = lane & 31, hi = lane >> 5;
    const size_t rowb = (size_t)b * SEQ; const int q0 = jb * 32;
    bf16x8 qr[4];
    const size_t hb = ((size_t)b * NHEAD + h) * SEQ;
    const bf16_t* VTh = VT + ((size_t)b * NHEAD + h) * (SEQ / 32) * 2048;
    { const bf16_t* qp = Q + (hb + q0 + r32) * 64 + hi * 8;
#pragma unroll
      for (int d0 = 0; d0 < 4; ++d0) qr[d0] = *(const bf16x8*)(qp + 16 * d0); }
    f32x16 o0, o1;
#pragma unroll
    for (int r = 0; r < 16; ++r) { o0[r] = 0.f; o1[r] = 0.f; }
    float Pc = 1.0f;
    bf16x8 kfn[4], vfn[2][2];
#define ATT_LOAD(kb_) do { const bf16_t* kp_ = K + (hb + (kb_) + r32) * 64 + hi * 8; \
        _Pragma("unroll") for (int d0 = 0; d0 < 4; ++d0) kfn[d0] = *(const bf16x8*)(kp_ + 16 * d0); \
        const bf16_t* vp_ = VTh + (size_t)((kb_) >> 5) * 2048 + r32 * 32 + 8 * hi; \
        _Pragma("unroll") for (int s = 0; s < 2; ++s) _Pragma("unroll") for (int db = 0; db < 2; ++db) vfn[s][db] = *(const bf16x8*)(vp_ + db * 1024 + 16 * s); } while (0)
    ATT_LOAD(q0);
    for (int kb = q0; kb >= 0; kb -= 32) {
        bf16x8 kf[4], vf[2][2];
#pragma unroll
        for (int d0 = 0; d0 < 4; ++d0) kf[d0] = kfn[d0];
#pragma unroll
        for (int s = 0; s < 2; ++s)
#pragma unroll
            for (int db = 0; db < 2; ++db) vf[s][db] = vfn[s][db];
        if (kb >= 32) ATT_LOAD(kb - 32);
        f32x16 p;
#pragma unroll
        for (int r = 0; r < 16; ++r) p[r] = 0.f;
#pragma unroll
        for (int d0 = 0; d0 < 4; ++d0) p = __builtin_amdgcn_mfma_f32_32x32x16_bf16(kf[d0], qr[d0], p, 0, 0, 0);
        float rr[16], be[16];
        const bool diag = (kb == q0);
#pragma unroll
        for (int r = 0; r < 16; ++r) { const int kr = (r & 3) + 8 * (r >> 2) + 4 * hi;
            const float e = fexp2(p[r]); const float t = frcp(1.0f + e);
            const bool valid = (!diag) || (kr < r32);
            rr[r] = valid ? t : 1.0f; be[r] = valid ? (1.0f - t) : 0.0f; }
        float sfx[16], Gg[4];
#pragma unroll
        for (int g = 0; g < 4; ++g) { sfx[4 * g + 3] = 1.0f; sfx[4 * g + 2] = rr[4 * g + 3]; sfx[4 * g + 1] = sfx[4 * g + 2] * rr[4 * g + 2]; sfx[4 * g] = sfx[4 * g + 1] * rr[4 * g + 1]; Gg[g] = sfx[4 * g] * rr[4 * g]; }
        float Gl[4], Gh[4];
#pragma unroll
        for (int g = 0; g < 4; ++g) { const unsigned gb = __float_as_uint(Gg[g]); auto x = __builtin_amdgcn_permlane32_swap(gb, gb, false, false); Gl[g] = __uint_as_float(x[0]); Gh[g] = __uint_as_float(x[1]); }
        float Eh[4], El[4]; float c = Pc;
#pragma unroll
        for (int g = 3; g >= 0; --g) { Eh[g] = c; c *= Gh[g]; El[g] = c; c *= Gl[g]; }
        Pc = c;
        float w[16];
#pragma unroll
        for (int g = 0; g < 4; ++g) { const float Eg = hi ? Eh[g] : El[g];
#pragma unroll
            for (int cc = 0; cc < 4; ++cc) w[4 * g + cc] = be[4 * g + cc] * (sfx[4 * g + cc] * Eg); }
        u32x4 w0, w1;
        w0.x = cvt_pk_bf16(w[0], w[1]); w0.y = cvt_pk_bf16(w[2], w[3]); w0.z = cvt_pk_bf16(w[4], w[5]); w0.w = cvt_pk_bf16(w[6], w[7]);
        w1.x = cvt_pk_bf16(w[8], w[9]); w1.y = cvt_pk_bf16(w[10], w[11]); w1.z = cvt_pk_bf16(w[12], w[13]); w1.w = cvt_pk_bf16(w[14], w[15]);
        const bf16x8 wf0 = __builtin_bit_cast(bf16x8, w0), wf1 = __builtin_bit_cast(bf16x8, w1);
        o0 = __builtin_amdgcn_mfma_f32_32x32x16_bf16(vf[0][0], wf0, o0, 0, 0, 0);
        o1 = __builtin_amdgcn_mfma_f32_32x32x16_bf16(vf[0][1], wf0, o1, 0, 0, 0);
        o0 = __builtin_amdgcn_mfma_f32_32x32x16_bf16(vf[1][0], wf1, o0, 0, 0, 0);
        o1 = __builtin_amdgcn_mfma_f32_32x32x16_bf16(vf[1][1], wf1, o1, 0, 0, 0);
        if (__all(Pc < 1e-30f)) break;
    }
#undef ATT_LOAD
    bf16_t* op = O + (rowb + q0 + r32) * D + h * 64 + 4 * hi;
#pragma unroll
    for (int g = 0; g < 4; ++g) { u32x2 a, b2; a.x = cvt_pk_bf16(o0[4 * g], o0[4 * g + 1]); a.y = cvt_pk_bf16(o0[4 * g + 2], o0[4 * g + 3]); b2.x = cvt_pk_bf16(o1[4 * g], o1[4 * g + 1]); b2.y = cvt_pk_bf16(o1[4 * g + 2], o1[4 * g + 3]);
        *(u32x2*)(op + 8 * g) = a; *(u32x2*)(op + 32 + 8 * g) = b2; }
}
__device__ __forceinline__ void attn_phase(Frame& F) {
    const bf16_t* Q = (const bf16_t*)(F.ws + WS_Q); const bf16_t* K = (const bf16_t*)(F.ws + WS_K); const bf16_t* VT = (const bf16_t*)(F.ws + WS_VT); bf16_t* O = (bf16_t*)(F.ws + WS_AO);
    const bool pl = (F.G & 7) == 0 && NB * 2 == 8;
    const int first = pl ? (F.bid >> 3) * 8 + F.wave : F.bid * 8 + F.wave, stride = pl ? (F.G >> 3) * 8 : F.G * 8, count = pl ? NHEAD * (SEQ / 64) : NB * NHEAD * (SEQ / 32);
    for (int u = first; u < count; u += stride) {
        const int jb = pl ? (F.bid & 1) * (SEQ / 64) + (u & (SEQ / 64 - 1)) : (u & 127), bh = pl ? ((F.bid & 7) >> 1) * NHEAD + u / (SEQ / 64) : (u >> 7);
        attn_unit(Q, K, VT, O, bh >> 3, bh & 7, jb, F.lane); }
}

__device__ __forceinline__ void scan1_unit(Frame& F, int b, int ck, int cg) {
    const unsigned* DB = (const unsigned*)(F.ws + WS_DB); float* SA = (float*)(F.ws + WS_SUM); float* SH = SA + NB * 64 * DR;
    const int c = cg * 64 + F.lane; const size_t r0 = (size_t)b * SEQ + ck * 64;
    unsigned w[64];
#pragma unroll
    for (int t = 0; t < 64; ++t) w[t] = DB[(r0 + t) * DR + c];
    float A = 1.f, H = 0.f;
#pragma unroll
    for (int t = 0; t < 64; ++t) { const float a = 1.0f - bflo(w[t]); A *= a; H = a * H + bfhi(w[t]); }
    SA[(size_t)(b * 64 + ck) * DR + c] = A; SH[(size_t)(b * 64 + ck) * DR + c] = H;
}
__device__ __forceinline__ void scan2_phase(Frame& F) {
    const unsigned* DB = (const unsigned*)(F.ws + WS_DB); const float* SA = (const float*)(F.ws + WS_SUM); const float* SH = SA + NB * 64 * DR;
    const bf16_t* XG = (const bf16_t*)(F.ws + WS_XG); bf16_t* RI = (bf16_t*)(F.ws + WS_AO);
    LAS bf16_t* stg = (LAS bf16_t*)(F.lds + F.wave * 9216);
    const int lane = F.lane; const XSpan sp = xspan(F.G, F.bid, NB * 64);
    for (int it = sp.first; it < sp.count; it += sp.stride) { const int u = (sp.base + it) * 8 + F.wave; const int cg = u & 7, ck = (u >> 3) & 63, b = u >> 9; const int c = cg * 64 + lane; const size_t r0 = (size_t)b * SEQ + ck * 64;
        unsigned w[64]; u32x4 xg[8]; const int tr = lane >> 3, cq = (lane & 7) * 8;
#pragma unroll
        for (int t = 0; t < 64; ++t) w[t] = DB[(r0 + t) * DR + c];
#pragma unroll
        for (int i = 0; i < 8; ++i) xg[i] = *(const u32x4*)(XG + (r0 + tr + 8 * i) * DR + cg * 64 + cq);
        float H = 0.f;
        { const float* sa = SA + (size_t)(b * 64) * DR + c; const float* sh = SH + (size_t)(b * 64) * DR + c;
          for (int j0 = 0; j0 < ck; j0 += 32) { float ta[32], th[32];
#pragma unroll
              for (int j = 0; j < 32; ++j) { const int jj = (j0 + j < ck) ? (j0 + j) : 0; ta[j] = sa[(size_t)jj * DR]; th[j] = sh[(size_t)jj * DR]; }
#pragma unroll
              for (int j = 0; j < 32; ++j) if (j0 + j < ck) H = ta[j] * H + th[j]; } }
        {
#pragma unroll
          for (int i = 0; i < 8; ++i) *(LAS u32x4*)(stg + (tr + 8 * i) * 72 + cq) = xg[i];
          LDS_WAIT(); asm volatile("" ::: "memory"); }
#pragma unroll
        for (int t = 0; t < 64; ++t) { const float a = 1.0f - bflo(w[t]); H = a * H + bfhi(w[t]);
            const float g = bf2f(stg[t * 72 + lane]); stg[t * 72 + lane] = (bf16_t)(cvt_pk_bf16(H * g, 0.f) & 0xffffu); }
        LDS_WAIT(); asm volatile("" ::: "memory");
        {
#pragma unroll
          for (int i = 0; i < 8; ++i) { const u32x4 o = *(const LAS u32x4*)(stg + (tr + 8 * i) * 72 + cq); *(u32x4*)(RI + (r0 + tr + 8 * i) * D + DA + cg * 64 + cq) = o; }
          LDS_WAIT(); asm volatile("" ::: "memory"); } }
}

__device__ __forceinline__ void route_load_tables(Frame& F, int L) {
    const int tid = F.tid;
    const u32x4* srcp = (const u32x4*)(F.ws + WS_RTAB + (size_t)(L & 1) * 81920); u32x4 tv[10];
#pragma unroll
    for (int i = 0; i < 10; ++i) tv[i] = srcp[tid + 512 * i];
#pragma unroll
    for (int i = 0; i < 10; ++i) *(LAS u32x4*)(F.lds + (tid + 512 * i) * 16) = tv[i];
}
__device__ __forceinline__ void route_phase(Frame& F, int L, int CL) {
    LAS unsigned char* T0h = F.lds;
    LAS unsigned char* T0l = F.lds + 32768;
    LAS unsigned char* T1h = F.lds + 65536;
    LAS unsigned char* T1l = F.lds + 65536 + 8192;
    LAS int* cnt = (LAS int*)(F.lds + 81920); LAS int* bas = cnt + 16; LAS float* tinfo = (LAS float*)(F.lds + 81920 + 128);
    LAS float* lgs0 = (LAS float*)(F.lds + 86016); LAS float* lgs = lgs0 + F.wave * 528;
    const float* wrg = inp(F, 15) + (size_t)L * D * 4; const float* brg = inp(F, 16) + L * 4; const float* wre = inp(F, 17) + (size_t)L * D * 16; const float* bre = inp(F, 18) + L * 16;
    unsigned char* xb8 = F.ws + WS_XB8;
    const bf16_t* xb = (const bf16_t*)(F.ws + WS_XB); unsigned* TOK = (unsigned*)(F.ws + WS_TOK); float* WLs = (float*)(F.ws + WS_WL); float* RS = (float*)(F.ws + WS_RS);
    unsigned* gcnt = F.ctl + CW_CNT + CL * 16 * 64;
    const int lane = F.lane, tid = F.tid;
    const int row = lane & 15, kg = lane >> 4;
    const XSpan sp = xspan(F.G, F.bid, T / 64);
    for (int it = sp.first; it < sp.count; it += sp.stride) { const int blk = sp.base + it;
        if (tid < 16) cnt[tid] = 0;
        __syncthreads();
        const int t0 = blk * 64 + (F.wave & 3) * 16;
        const bf16_t* xbp = xb + (size_t)(t0 + row) * D + 8 * kg;
        f32x4 acc0 = {0.f, 0.f, 0.f, 0.f}, acc1 = {0.f, 0.f, 0.f, 0.f}; float ss = 0.f;
        { const int ks0 = (F.wave >> 2) * 16;
            u32x4 xv[16];
#pragma unroll
            for (int i = 0; i < 16; ++i) xv[i] = *(const u32x4*)(xbp + 32 * (ks0 + i));
            u32x2 pk8[2];
#pragma unroll
            for (int i = 0; i < 16; ++i) { const int ks = ks0 + i; const u32x4 h = xv[i];
                { const float xe[8] = {bflo(h.x), bfhi(h.x), bflo(h.y), bfhi(h.y), bflo(h.z), bfhi(h.z), bflo(h.w), bfhi(h.w)};
                  ss += ((xe[0] * xe[0] + xe[1] * xe[1]) + (xe[2] * xe[2] + xe[3] * xe[3])) + ((xe[4] * xe[4] + xe[5] * xe[5]) + (xe[6] * xe[6] + xe[7] * xe[7]));
                  pk8[i & 1] = pack_fp8x8(xe, F8_XS);
                  if (i & 1) { unsigned char* pa_ = xb8 + (size_t)(t0 + row) * 2048 + 32 * (ks - 1) + 8 * kg; store_pair16(pa_, pa_ + 32, kg, pk8[0], pk8[1]); } }
                const bf16x8 ah = __builtin_bit_cast(bf16x8, h);
                const bf16x8 b0h = *(const LAS bf16x8*)(T0h + (ks * 64 + lane) * 16), b0l = *(const LAS bf16x8*)(T0l + (ks * 64 + lane) * 16);
                const int o1 = (ks * 16 + kg * 4 + (row & 3)) * 16;
                const bf16x8 b1h = *(const LAS bf16x8*)(T1h + o1), b1l = *(const LAS bf16x8*)(T1l + o1);
                acc0 = __builtin_amdgcn_mfma_f32_16x16x32_bf16(ah, b0h, acc0, 0, 0, 0); acc0 = __builtin_amdgcn_mfma_f32_16x16x32_bf16(ah, b0l, acc0, 0, 0, 0);
                acc1 = __builtin_amdgcn_mfma_f32_16x16x32_bf16(ah, b1h, acc1, 0, 0, 0); acc1 = __builtin_amdgcn_mfma_f32_16x16x32_bf16(ah, b1l, acc1, 0, 0, 0); }
        }
        ss += __shfl_xor(ss, 16); ss += __shfl_xor(ss, 32);
        {
#pragma unroll
            for (int i = 0; i < 4; ++i) { lgs[(4 * kg + i) * 32 + row] = acc0[i]; if (row < 4) lgs[(4 * kg + i) * 32 + 16 + row] = acc1[i]; } }
        if (lane < 16) lgs[512 + lane] = ss;
        __syncthreads();
        if (tid < 64) { const int tk = tid;
            const LAS float* lr = lgs0 + (tk >> 4) * 528 + (tk & 15) * 32; const LAS float* lr2 = lr + 4 * 528;
            const float rstd = 1.0f / sqrtf((lgs0[(tk >> 4) * 528 + 512 + (tk & 15)] + lgs0[((tk >> 4) + 4) * 528 + 512 + (tk & 15)]) * (1.0f / D) + EPS);
            float lg[4];
#pragma unroll
            for (int j = 0; j < 4; ++j) lg[j] = rstd * (lr[j] + lr2[j]) + brg[j];
            int gi = 0; float gmx = lg[0];
#pragma unroll
            for (int j = 1; j < 4; ++j) if (lg[j] > gmx) { gmx = lg[j]; gi = j; }
            float den = 0.f;
#pragma unroll
            for (int j = 0; j < 4; ++j) den += expf(lg[j] - gmx);
            const float gate_group = 1.0f / den;
            float sel[4];
#pragma unroll
            for (int i = 0; i < 4; ++i) sel[i] = rstd * (lr[4 + gi * 4 + i] + lr2[4 + gi * 4 + i]) + bre[gi * 4 + i];
            int i1 = 0; float v1 = sel[0];
#pragma unroll
            for (int i = 1; i < 4; ++i) if (sel[i] > v1) { v1 = sel[i]; i1 = i; }
            int i2 = -1; float v2 = 0.f;
#pragma unroll
            for (int i = 0; i < 4; ++i) if (i != i1 && (i2 < 0 || sel[i] > v2)) { v2 = sel[i]; i2 = i; }
            const float ex = expf(v2 - v1); const float w1 = 1.0f / (1.0f + ex), w2 = ex / (1.0f + ex);
            const int e1 = gi * 4 + i1, e2 = gi * 4 + i2;
            const int p1 = __hip_atomic_fetch_add(cnt + e1, 1, __ATOMIC_RELAXED, __HIP_MEMORY_SCOPE_WORKGROUP);
            const int p2 = __hip_atomic_fetch_add(cnt + e2, 1, __ATOMIC_RELAXED, __HIP_MEMORY_SCOPE_WORKGROUP);
            LAS float* ti = tinfo + tk * 8;
            ti[0] = __int_as_float(e1); ti[1] = __int_as_float(p1); ti[2] = gate_group * w1; ti[3] = __int_as_float(e2); ti[4] = __int_as_float(p2); ti[5] = gate_group * w2; ti[6] = rstd; }
        __syncthreads();
        if (tid < 16) { const int c = cnt[tid]; int b0 = 0; if (c > 0) b0 = (int)__hip_atomic_fetch_add(gcnt + tid * 64, (unsigned)c, __ATOMIC_RELAXED, __HIP_MEMORY_SCOPE_AGENT); bas[tid] = b0; }
        __syncthreads();
        if (tid < 64) { const LAS float* ti = tinfo + tid * 8; const int t = blk * 64 + tid;
            const int e1 = __float_as_int(ti[0]), p1 = __float_as_int(ti[1]), e2 = __float_as_int(ti[3]), p2 = __float_as_int(ti[4]);
            const size_t i1 = (size_t)e1 * LCAP + bas[e1] + p1, i2 = (size_t)e2 * LCAP + bas[e2] + p2;
            TOK[i1] = (unsigned)t; WLs[i1] = ti[2]; RS[i1] = ti[6];
            TOK[i2] = (unsigned)t | 0x80000000u; WLs[i2] = ti[5]; RS[i2] = ti[6]; }
        __syncthreads();
    }
}
__device__ __forceinline__ void group_table(Frame& F, int L) {
    LAS int* tab = (LAS int*)(F.lds + TSTART_OFF);
    if (F.tid < 16) tab[17 + F.tid] = (int)__hip_atomic_load(F.ctl + CW_CNT + (L * 16 + F.tid) * 64, __ATOMIC_RELAXED, __HIP_MEMORY_SCOPE_AGENT);
    __syncthreads();
    if (F.tid == 0) { int a = 0;
        for (int e = 0; e < 16; ++e) { tab[e] = a; a += (tab[17 + e] + 255) >> 8; }
        tab[16] = a; }
    __syncthreads();
}
__device__ __forceinline__ void s3_phase(Frame& F) {
    bf16_t* xb = (bf16_t*)(F.ws + WS_XB); const unsigned char* Y0 = F.ws + WS_Y0; const unsigned char* Y1 = F.ws + WS_Y1; float* rstd3 = (float*)(F.ws + WS_MISC + 131072);
    const int lane = F.lane; const XSpan sp = xspan(F.G, F.bid, T / 64);
    for (int it2 = 2 * sp.first; it2 < 2 * sp.count; it2 += ((it2 & 1) ? 2 * sp.stride - 1 : 1)) {
        const int m0 = (sp.base + (it2 >> 1)) * 64 + F.wave * 8 + (it2 & 1) * 4;
        u32x2 xv[4][4]; unsigned ya[4][4], yb[4][4];
#pragma unroll
        for (int r = 0; r < 4; ++r) { const int m = m0 + r;
#pragma unroll
            for (int j = 0; j < 4; ++j) { xv[r][j] = ((const u32x2*)(xb + (size_t)m * D) + lane)[64 * j]; ya[r][j] = ((const unsigned*)(Y0 + (size_t)m * 2048) + lane)[64 * j]; yb[r][j] = ((const unsigned*)(Y1 + (size_t)m * 2048) + lane)[64 * j]; } }
#pragma unroll
        for (int r = 0; r < 4; ++r) { const int m = m0 + r; float s = 0.f; u32x2* o = (u32x2*)(xb + (size_t)m * D) + lane;
#pragma unroll
            for (int j = 0; j < 4; ++j) { const u32x2 z = xv[r][j];
                const auto a01 = __builtin_amdgcn_cvt_pk_f32_fp8(ya[r][j], false), a23 = __builtin_amdgcn_cvt_pk_f32_fp8(ya[r][j], true);
                const auto b01 = __builtin_amdgcn_cvt_pk_f32_fp8(yb[r][j], false), b23 = __builtin_amdgcn_cvt_pk_f32_fp8(yb[r][j], true);
                const float t0 = bflo(z.x) + (a01[0] + b01[0]) * (1.0f / F8_YS), t1 = bfhi(z.x) + (a01[1] + b01[1]) * (1.0f / F8_YS), t2 = bflo(z.y) + (a23[0] + b23[0]) * (1.0f / F8_YS), t3 = bfhi(z.y) + (a23[1] + b23[1]) * (1.0f / F8_YS);
                s += (t0 * t0 + t1 * t1) + (t2 * t2 + t3 * t3);
                u32x2 w; w.x = cvt_pk_bf16(t0, t1); w.y = cvt_pk_bf16(t2, t3); o[64 * j] = w; }
            s = wave_sum(s); if (lane == 0) rstd3[m] = 1.0f / sqrtf(s * (1.0f / D) + EPS); } }
}
__device__ __forceinline__ void final_phase(Frame& F) {
    const bf16_t* xb = (const bf16_t*)(F.ws + WS_XBW); float* out = F.out; const float* g = inp(F, 25);
    const int lane = F.lane;
    f32x4 gg[4];
#pragma unroll
    for (int j = 0; j < 4; ++j) gg[j] = *((const f32x4*)g + lane + 64 * j);
    const XSpan sp = xspan(F.G, F.bid, T / 64);
    for (int it2 = 2 * sp.first; it2 < 2 * sp.count; it2 += ((it2 & 1) ? 2 * sp.stride - 1 : 1)) { u32x2 v[4][4];
        const int m0 = (sp.base + (it2 >> 1)) * 64 + F.wave * 8 + (it2 & 1) * 4;
#pragma unroll
        for (int r = 0; r < 4; ++r) { const int m = m0 + r;
#pragma unroll
            for (int j = 0; j < 4; ++j) v[r][j] = ((const u32x2*)(xb + (size_t)m * D) + lane)[64 * j]; }
#pragma unroll
        for (int r = 0; r < 4; ++r) { const int m = m0 + r; float s = 0.f; f32x4 t[4];
#pragma unroll
            for (int j = 0; j < 4; ++j) { t[j] = (f32x4){bflo(v[r][j].x), bfhi(v[r][j].x), bflo(v[r][j].y), bfhi(v[r][j].y)}; s += (t[j][0] * t[j][0] + t[j][1] * t[j][1]) + (t[j][2] * t[j][2] + t[j][3] * t[j][3]); }
            const float rs = 1.0f / sqrtf(wave_sum(s) * (1.0f / D) + EPS); f32x4* xr = (f32x4*)(out + (size_t)m * D) + lane;
#pragma unroll
            for (int j = 0; j < 4; ++j) __builtin_nontemporal_store(t[j] * rs * gg[j], xr + 64 * j); } }
}

constexpr int NPH = 13;
constexpr int PH_TOTAL = DEPTH * NPH + 1;
__global__ void __launch_bounds__(512, 2) trunk_fwd(Args args) {
    extern __shared__ __attribute__((aligned(16))) unsigned char lds[];
    Frame F;
    F.lds = (LAS unsigned char*)lds; F.ws = args.ws; F.ctl = (unsigned*)(args.ws + WS_CTL); F.out = args.out;
    F.tid = threadIdx.x; F.lane = F.tid & 63; F.wave = __builtin_amdgcn_readfirstlane(F.tid >> 6); F.G = gridDim.x;
    F.bid = blockIdx.x;
    const int wave0 = F.wave, grid0 = gridDim.x; int bid0 = blockIdx.x; bool xloc = false;
    for (int u = F.tid; u < (LDS_BYTES - LDSCTL_OFF) / 4; u += 512) ((LAS unsigned*)(F.lds + LDSCTL_OFF))[u] = 0u;
    __syncthreads();
    if (F.tid < 26) ((LAS unsigned long long*)(F.lds + PTAB_OFF))[F.tid] = (unsigned long long)args.in[F.tid];
    __syncthreads();
    XcdBarrier bar; bar.bar = F.ctl + CW_BAR; bar.x = 0; bar.st = nullptr;
#if MK_N_LAUNCHES == 1
    { volatile LAS unsigned* st = (volatile LAS unsigned*)(F.lds + MISC_OFF) + 8; unsigned* bw = F.ctl + CW_BAR;
      bar.bar = bw; bar.x = xb_xcc_id(); bar.st = st;
      if (F.tid == 0) { const unsigned rank = xb_add(&bw[XB_XCNT(bar.x)], 1u); unsigned nloc, nx; xcd_barrier_complete(bw, bar.x, nloc, nx); st[0] = nloc; st[1] = nx;
          bool eq = (grid0 % 8 == 0) && (nx == 8u); unsigned pre = 0u;
          for (unsigned j = 0; j < 16; ++j) { const unsigned c = xb_ld(&bw[XB_XCNT(j)]); if (j < 8) eq = eq && (c == (unsigned)grid0 / 8u); else eq = eq && (c == 0u); if (j < bar.x) pre += c; }
          st[2] = eq ? rank * 8u + bar.x : pre + rank; st[3] = eq ? 1u : 0u; }
      __syncthreads();
      bid0 = (int)__builtin_amdgcn_readfirstlane(st[2]); xloc = __builtin_amdgcn_readfirstlane(st[3]) != 0u; F.bid = bid0; }
#endif
    const int lo = args.ph_lo, hi = args.ph_hi;
#define IN(k) (lo <= (k) && (k) < hi)
#if MK_N_LAUNCHES == 1
#define SEAM(k) do { if (IN(k) && IN((k) + 1)) { xcd_barrier(bar); if (REP_PHASE == 99) xcd_barrier(bar); } } while (0)
#define SEAML(k) do { if (IN(k) && IN((k) + 1)) { xcd_barrier(bar, xloc ? 1 : 0); if (REP_PHASE == 99) xcd_barrier(bar, xloc ? 1 : 0); } } while (0)
#define SEAMP(k) do { if (IN(k) && IN((k) + 1)) { xcd_barrier(bar, xloc ? 2 : 0); if (REP_PHASE == 99) xcd_barrier(bar, xloc ? 2 : 0); } } while (0)
#else
#define SEAM(k) do { } while (0)
#define SEAML(k) do { } while (0)
#define SEAMP(k) do { } while (0)
#endif
    unsigned char* const ws0 = args.ws;
    for (int L = 0; L < DEPTH; ++L) {
        const int P = L * NPH;
        unsigned char* ws;
#define OPQ() do { unsigned long long wq_ = (unsigned long long)ws0; asm volatile("" : "+s"(wq_) :: "memory"); ws = (unsigned char*)(GAS unsigned char*)wq_; int l_; asm volatile("v_mbcnt_lo_u32_b32 %0, -1, 0\n\tv_mbcnt_hi_u32_b32 %0, -1, %0" : "=v"(l_)); int w_ = wave0, b_ = bid0, g_ = grid0; asm volatile("" : "+s"(w_), "+s"(b_), "+s"(g_)); F.lane = l_; F.wave = w_; F.tid = w_ * 64 + l_; F.bid = b_; F.G = g_; } while (0)
#define BG_PREP(nun_, lo_, hi_) do { const int nun__ = (nun_), maxu__ = (nun__ + F.G - 1) / F.G, nheavy__ = nun__ - (maxu__ - 1) * F.G; int nl__ = F.G - nheavy__, li__ = F.bid - nheavy__; \
            if (nl__ < 64) { nl__ = F.G; li__ = F.bid; } if (REP_PHASE != 77 && li__ >= 0) { OPQ(); F.ws = ws; prep_weights(F, L + 1, (lo_), (hi_), li__ * 8 + F.wave, nl__ * 8); } } while (0)
        if (IN(P + 0) && L == 0) { OPQ(); F.ws = ws; prep_phase(F); SEAM(P + 0); }
        if (REP_PHASE == 77 && IN(P + 0) && L > 0) { OPQ(); F.ws = ws; prep_weights(F, L, 0, TR_NITEMS, F.bid * 8 + F.wave, F.G * 8); xcd_barrier(bar); }
        if (IN(P + 1)) { OPQ();
            pg8::Gemm g{(const bf16_t*)(ws + WS_XB8), (const bf16_t*)(ws + WOFF(L) + WS_WIN), D, D, D / 2}; WinOrder S; S.init(T, NIN, F.G, F.bid);
            const int hf = F.wave >> 2; float rv[3];
            { const float* SSQ = (const float*)(ws + WS_SSQ); Unit u; const int r = F.tid & 255;
#pragma unroll
              for (int k = 0; k < 3; ++k) { const int i = hf + 2 * k; rv[k] = (i < RSTD_UNITS && S.next(i, u)) ? row_rstd(SSQ, u.pm * 256 + r) : 0.f; } }
            EpiWin E{(const float*)(ws + WS_SSQ), (const LAS float*)(F.lds + RSTD_OFF), (bf16_t*)(ws + WS_Q), (bf16_t*)(ws + WS_K), (bf16_t*)(ws + WS_VT), (bf16_t*)(ws + WS_XR), (bf16_t*)(ws + WS_XG), (bf16_t*)(ws + WS_GA), (bf16_t*)(ws + WS_GR),
                     (LAS float*)(F.lds + RSTD_OFF) + (F.tid & 255), rv[0], rv[1], rv[2], hf};
            for (int rep = 0; rep < REPN(1); ++rep) pg8::gemm_phase(F.lds, g, S, E, F.tid);
            if (L + 1 < DEPTH) { for (int rep = 0; rep < REPN(93); ++rep) BG_PREP(T / 256 * (NIN / 256), 0, TR_S1); }
            if (L == 0) { OPQ();
                pg8::Gemm g2{(const bf16_t*)(ws + WS_PB), (const bf16_t*)(ws + WS_WPP), PLED, PLED, PLED}; PPOrder S2; S2.init(DEPTH * T, D, F.G, F.bid);
                EpiBf16 E2{(bf16_t*)(ws + WS_PP), D};
                pg8::gemm_phase(F.lds, g2, S2, E2, F.tid); }
            SEAMP(P + 1); }
        if (IN(P + 2)) { for (int rep = 0; rep < REPN(2); ++rep) { OPQ(); F.ws = ws; conv_phase(F, L); } for (int rep = 0; rep < REPN(20); ++rep) { OPQ(); F.ws = ws; attn_phase(F); } SEAML(P + 2); }
        if (IN(P + 3)) { OPQ();
            pg8::Gemm g{(const bf16_t*)(ws + WS_XC), (const bf16_t*)(ws + WOFF(L) + WS_WGT), DR, DR, 128}; GateOrder S; S.init(T, 1024, F.G, F.bid);
            EpiGates E{(const bf16_t*)(ws + WS_XC), inp(F, 7) + L * DR, inp(F, 9) + L * DR, (const float*)(ws + WS_MISC + 196608 + (L & 1) * 2048), (unsigned*)(ws + WS_DB)};
            for (int rep = 0; rep < REPN(3); ++rep) pg8::gemm_phase(F.lds, g, S, E, F.tid);
            asm volatile("s_waitcnt vmcnt(0)" ::: "memory"); __syncthreads();
            { OPQ(); F.ws = ws; Unit u;
              for (int i = 0; S.next(i, u); ++i) scan1_unit(F, u.pm >> 4, (u.pm & 15) * 4 + (F.wave & 3), 2 * u.pn + (F.wave >> 2)); }
            SEAMP(P + 3); }
        if (IN(P + 5)) { for (int rep = 0; rep < REPN(5); ++rep) { OPQ(); F.ws = ws; scan2_phase(F); } SEAML(P + 5); }
        if (IN(P + 6)) { OPQ();
            pg8::Gemm g{(const bf16_t*)(ws + WS_AO), (const bf16_t*)(ws + WOFF(L) + WS_WAO), D, D, D}; pg8::StaticOrder S; S.init(T, D, F.G, F.bid);
            EpiMerge2 E{ws + WS_GA, ws + WS_GR, (bf16_t*)(ws + WS_MG)};
            for (int rep = 0; rep < REPN(6); ++rep) pg8::gemm_phase(F.lds, g, S, E, F.tid);
            SEAML(P + 6); }
        if (IN(P + 7)) { OPQ();
            pg8::Gemm g{(const bf16_t*)(ws + WS_MG), (const bf16_t*)(ws + WOFF(L) + WS_WOUT), D, D, D}; pg8::StaticOrder S; S.init(T, D, F.G, F.bid);
            EpiResid E{(const bf16_t*)(ws + WS_XBW), (bf16_t*)(ws + WS_XB)};
            pg8::gemm_phase(F.lds, g, S, E, F.tid);
            if (IN(P + 8)) { OPQ(); F.ws = ws; route_load_tables(F, L); }
            SEAML(P + 7); }
        if (IN(P + 8)) { if (!IN(P + 7)) { OPQ(); F.ws = ws; route_load_tables(F, L); __syncthreads(); }
            if (REP_PHASE == 8) { OPQ(); F.ws = ws; route_phase(F, L, L + 4); SEAM(P + 8); } OPQ(); F.ws = ws; route_phase(F, L, L); SEAM(P + 8); }
        if (IN(P + 9)) { OPQ();
            group_table(F, L);
            pg8::Gemm g{(const bf16_t*)(ws + WS_XB8), (const bf16_t*)(ws + WOFF(L) + WS_WGU), D, D / 2, D / 2};
            GroupSched<true> S{(const LAS int*)(F.lds + TSTART_OFF), F.G, F.bid, (const unsigned*)(ws + WS_TOK)};
            EpiGU E{(const float*)(ws + WS_RS), ws + WS_ACT};
            for (int rep = 0; rep < REPN(9); ++rep) pg8::gemm_phase(F.lds, g, S, E, F.tid);
            if (L + 1 < DEPTH) { int nl, li; group_light(F.G, F.bid, ((const LAS int*)(F.lds + TSTART_OFF))[16], nl, li); if (li >= 0) { OPQ(); F.ws = ws; prep_weights(F, L + 1, TR_S1, TR_S2, li * 8 + F.wave, nl * 8); } }
            SEAML(P + 9); }
        if (IN(P + 10)) { OPQ();
            if (!IN(P + 9)) group_table(F, L);
            pg8::Gemm g{(const bf16_t*)(ws + WS_ACT), (const bf16_t*)(ws + WOFF(L) + WS_WDN), DE / 2, DE / 2, DE / 2};
            GroupSched<false> S{(const LAS int*)(F.lds + TSTART_OFF), F.G, F.bid, (const unsigned*)(ws + WS_TOK)};
            EpiDown E{(const unsigned*)(ws + WS_TOK), (const float*)(ws + WS_WL), ws + WS_Y0, ws + WS_Y1};
            for (int rep = 0; rep < REPN(10); ++rep) pg8::gemm_phase(F.lds, g, S, E, F.tid);
            if (L + 1 < DEPTH) { int nl, li; group_light(F.G, F.bid, ((const LAS int*)(F.lds + TSTART_OFF))[16], nl, li); if (li >= 0) { OPQ(); F.ws = ws; prep_weights(F, L + 1, TR_S2, TR_NITEMS, li * 8 + F.wave, nl * 8); } }
            SEAM(P + 10); }
        if (IN(P + 11)) { OPQ(); F.ws = ws; s3_phase(F); SEAML(P + 11); }
        if (IN(P + 12)) { OPQ();
            pg8::Gemm g{(const bf16_t*)(ws + WS_XB), (const bf16_t*)(ws + WS_WPGL) + (size_t)L * D * D, D, D, D}; pg8::StaticOrder S; S.init(T, D, F.G, F.bid);
            EpiPle E{(const float*)(ws + WS_MISC + 131072), (const bf16_t*)(ws + WS_PP) + (size_t)L * T * D, (const bf16_t*)(ws + WS_XB), (bf16_t*)(ws + WS_XBW), (float*)(ws + WS_SSQ), ws + WS_XB8};
            pg8::gemm_phase(F.lds, g, S, E, F.tid);
            SEAML(P + 12); }
    }
    if (IN(DEPTH * NPH)) final_phase(F);
#undef IN
#undef SEAM
}

extern "C" void kernel_launch(void* const* d_in, const int* in_sizes, int n_in, void* d_out, int out_size, void* d_ws, size_t ws_size, hipStream_t stream) {
    static int grid = 0;
    if (grid == 0) {
        if (n_in != 26 || in_sizes[0] != T * D || out_size != T * D || ws_size < WS_END) { fprintf(stderr, "kernel_launch: unexpected shapes (n_in %d, in0 %d, out %d, ws %zu need %zu)\n", n_in, n_in > 0 ? in_sizes[0] : -1, out_size, ws_size, (size_t)WS_END); grid = -1; return; }
        int dev = 0, cus = 0, per_cu = 0;
        if (hipGetDevice(&dev) != hipSuccess || hipDeviceGetAttribute(&cus, hipDeviceAttributeMultiprocessorCount, dev) != hipSuccess) { grid = -1; return; }
        if (hipFuncSetAttribute((const void*)trunk_fwd, hipFuncAttributeMaxDynamicSharedMemorySize, LDS_BYTES) != hipSuccess) { fprintf(stderr, "kernel_launch: hipFuncSetAttribute failed\n"); grid = -1; return; }
        if (hipOccupancyMaxActiveBlocksPerMultiprocessor(&per_cu, (const void*)trunk_fwd, 512, LDS_BYTES) != hipSuccess || per_cu < 1) fprintf(stderr, "kernel_launch: occupancy query reports %d\n", per_cu);
        (void)hipGetLastError();
        grid = cus;
    }
    if (grid < 0) return;
    if (hipMemsetAsync((char*)d_ws + WS_CTL, 0, CTL_ZERO_BYTES, stream) != hipSuccess) return;
    Args a{};
    for (int i = 0; i < 26; ++i) a.in[i] = (const float*)d_in[i];
    a.out = (float*)d_out; a.ws = (unsigned char*)d_ws;
#if MK_N_LAUNCHES == 1
    a.ph_lo = 0; a.ph_hi = PH_TOTAL;
    hipLaunchKernelGGL(trunk_fwd, dim3(grid), dim3(512), LDS_BYTES, stream, a);
#else
    for (int ph = 0; ph < PH_TOTAL; ++ph) { a.ph_lo = ph; a.ph_hi = ph + 1; hipLaunchKernelGGL(trunk_fwd, dim3(grid), dim3(512), LDS_BYTES, stream, a); }
#endif
}
```
